# Optimizing an MI355X kernel written in HIP

```python
import jax, jax.numpy as jnp
from jax import lax
import numpy as np

D_MODEL = 1024
BATCH = 8
SEQ = 8192
DEPTH = 2

CHUNK = 64
EPS = 1e-6
HG_HEADS = 4
HG_DK = 128
HG_DV = 128
HG_WIDTH = HG_HEADS * HG_DK
HG_VWIDTH = HG_HEADS * HG_DV
DN_HEADS = 4
DN_DK = 128
DN_DV = 128
DN_KW = DN_HEADS * DN_DK
DN_VW = DN_HEADS * DN_DV
CONV_W = 4
D_FF = -(-8 * D_MODEL // (3 * 256)) * 256
IN_SIZES = (HG_WIDTH, HG_WIDTH, HG_VWIDTH, HG_VWIDTH,
            DN_KW, DN_KW, DN_VW,
            DN_VW, DN_HEADS, DN_HEADS,
            D_MODEL, D_MODEL)
IN_WIDTH = sum(IN_SIZES)
IN_SPLITS = tuple(int(s) for s in np.cumsum(IN_SIZES)[:-1])

kernel_name = "hgrn2_gdn_parallel_hybrid"


def rms_norm(x, w):
    xf = x.astype(jnp.float32)
    y = xf * lax.rsqrt(jnp.mean(xf * xf, axis=-1, keepdims=True) + EPS)
    return (y * w.astype(jnp.float32)).astype(x.dtype)


def head_rms_norm(o, w, n_heads, d):
    b, t, _ = o.shape
    oh = o.reshape(b, t, n_heads, d)
    oh = oh * lax.rsqrt(jnp.mean(oh * oh, axis=-1, keepdims=True) + EPS) * w.astype(jnp.float32)
    return oh.reshape(b, t, n_heads * d)


def _chunk(t, n_heads, d):
    b, s, _ = t.shape
    return t.reshape(b, s // CHUNK, CHUNK, n_heads, d).transpose(1, 0, 3, 2, 4)


def _chunk_heads(t):
    b, s, h = t.shape
    return t.reshape(b, s // CHUNK, CHUNK, h).transpose(1, 0, 3, 2)


def _unchunk(o):
    n, b, h, c, d = o.shape
    return o.transpose(1, 0, 3, 2, 4).reshape(b, n * c, h * d)


def causal_short_conv(x, w):
    cc = x.shape[-1]
    return lax.conv_general_dilated(x, w[:, None, :].astype(x.dtype), window_strides=(1,),
                                    padding=[(CONV_W - 1, 0)],
                                    dimension_numbers=('NWC', 'WIO', 'NWC'),
                                    feature_group_count=cc)


def hgrn2_mix(q, f_logit, i, lb):
    q = q.astype(jnp.float32)
    f_logit = f_logit.astype(jnp.float32)
    i = i.astype(jnp.float32)
    log_f = jnp.logaddexp(jnp.log(lb), jnp.log1p(-lb) + jax.nn.log_sigmoid(f_logit))
    k = (1.0 - lb) * jax.nn.sigmoid(-f_logit)
    qc = _chunk(q, HG_HEADS, HG_DK)
    kc = _chunk(k, HG_HEADS, HG_DK)
    vc = _chunk(i, HG_HEADS, HG_DV)
    bc = jnp.cumsum(_chunk(log_f, HG_HEADS, HG_DK), axis=3)
    causal = jnp.tril(jnp.ones((CHUNK, CHUNK), dtype=bool))

    def step(S, xs):
        q_c, k_c, v_c, b_c = xs
        b_last = b_c[:, :, -1:, :]
        diff = b_c[:, :, :, None, :] - b_c[:, :, None, :, :]
        decay = jnp.exp(jnp.where(causal[:, :, None], diff, -jnp.inf))
        attn = jnp.einsum('bhid,bhjd,bhijd->bhij', q_c, k_c, decay)
        o = (jnp.einsum('bhij,bhjv->bhiv', attn, v_c)
             + jnp.einsum('bhid,bhdv->bhiv', q_c * jnp.exp(b_c), S))
        S = (S * jnp.exp(b_last[:, :, 0, :])[..., None]
             + jnp.einsum('bhjd,bhjv->bhdv', k_c * jnp.exp(b_last - b_c), v_c))
        return S, o

    S0 = jnp.zeros((q.shape[0], HG_HEADS, HG_DK, HG_DV), jnp.float32)
    _, o = lax.scan(step, S0, (qc, kc, vc, bc))
    return _unchunk(o)


def gated_deltanet_mix(q, k, v, a, b_logit, a_log, dt_bias):
    q = q.astype(jnp.float32)
    k = k.astype(jnp.float32)
    v = v.astype(jnp.float32)
    b, s, _ = q.shape
    qh = q.reshape(b, s, DN_HEADS, DN_DK)
    kh = k.reshape(b, s, DN_HEADS, DN_DK)
    qh = qh * lax.rsqrt(jnp.sum(qh * qh, -1, keepdims=True) + EPS) * (DN_DK ** -0.5)
    kh = kh * lax.rsqrt(jnp.sum(kh * kh, -1, keepdims=True) + EPS)
    beta = jax.nn.sigmoid(b_logit.astype(jnp.float32))
    g = -jnp.exp(a_log.astype(jnp.float32)) * jax.nn.softplus(
        a.astype(jnp.float32) + dt_bias.astype(jnp.float32))

    qc = _chunk(qh.reshape(b, s, DN_KW), DN_HEADS, DN_DK)
    kc = _chunk(kh.reshape(b, s, DN_KW), DN_HEADS, DN_DK)
    vc = _chunk(v, DN_HEADS, DN_DV)
    betac = _chunk_heads(beta)[..., None]
    gc = jnp.cumsum(_chunk_heads(g), axis=-1)

    causal = jnp.tril(jnp.ones((CHUNK, CHUNK), dtype=bool))
    strict = jnp.tril(jnp.ones((CHUNK, CHUNK), dtype=bool), -1)
    L = jnp.exp(jnp.where(causal, gc[..., :, None] - gc[..., None, :], -jnp.inf))
    k_beta = kc * betac
    v_beta = vc * betac
    A = jnp.where(strict, jnp.einsum('nbhid,nbhjd->nbhij', k_beta, kc) * L, 0.0)
    eye = jnp.eye(CHUNK, dtype=jnp.float32)
    M = eye + A
    T = lax.linalg.triangular_solve(M, jnp.broadcast_to(eye, M.shape), left_side=True,
                                    lower=True, unit_diagonal=True)
    u = jnp.einsum('nbhij,nbhjv->nbhiv', T, v_beta)
    w = jnp.einsum('nbhij,nbhjd->nbhid', T, k_beta * jnp.exp(gc)[..., None])
    attn_qk = jnp.einsum('nbhid,nbhjd->nbhij', qc, kc) * L
    qg = qc * jnp.exp(gc)[..., None]
    kd = kc * jnp.exp(gc[..., -1:] - gc)[..., None]
    dl = jnp.exp(gc[..., -1])

    def step(S, xs):
        u_c, w_c, a_c, qg_c, kd_c, dl_c = xs
        v_new = u_c - jnp.einsum('bhcd,bhdv->bhcv', w_c, S)
        o = jnp.einsum('bhcd,bhdv->bhcv', qg_c, S) + jnp.einsum('bhij,bhjv->bhiv', a_c, v_new)
        S = S * dl_c[..., None, None] + jnp.einsum('bhcd,bhcv->bhdv', kd_c, v_new)
        return S, o

    S0 = jnp.zeros((b, DN_HEADS, DN_DK, DN_DV), jnp.float32)
    _, o = lax.scan(step, S0, (u, w, attn_qk, qg, kd, dl))
    return _unchunk(o)


def hybrid_layer(x, lb, pre_mix_w, w_in, hg_norm_w, conv_w, dn_a_log, dn_dt_bias, dn_norm_w,
                 w_o_hg, w_o_dn, w_out, post_mix_w, pre_ffn_w, w_gate_up, w_down, post_ffn_w):
    u = rms_norm(x, pre_mix_w)
    proj = jnp.einsum('btd,de->bte', u, w_in)
    (hg_q, hg_f, hg_i, hg_g, dn_q, dn_k, dn_v, dn_g, dn_a, dn_b,
     m_a, m_b) = jnp.split(proj, IN_SPLITS, axis=-1)

    o_a = hgrn2_mix(hg_q, hg_f, hg_i, lb)
    o_a = head_rms_norm(o_a, hg_norm_w, HG_HEADS, HG_DV) * jax.nn.silu(hg_g.astype(jnp.float32))

    qkv = jax.nn.silu(causal_short_conv(jnp.concatenate([dn_q, dn_k, dn_v], axis=-1), conv_w))
    cq, ck, cv = jnp.split(qkv, (DN_KW, 2 * DN_KW), axis=-1)
    o_b = gated_deltanet_mix(cq, ck, cv, dn_a, dn_b, dn_a_log, dn_dt_bias)
    o_b = head_rms_norm(o_b, dn_norm_w, DN_HEADS, DN_DV) * jax.nn.silu(dn_g.astype(jnp.float32))

    y_a = jnp.einsum('bte,ed->btd', o_a.astype(x.dtype), w_o_hg)
    y_b = jnp.einsum('bte,ed->btd', o_b.astype(x.dtype), w_o_dn)
    merged = jax.nn.sigmoid(m_a) * y_a + jax.nn.sigmoid(m_b) * y_b
    mix_out = jnp.einsum('btd,de->bte', merged, w_out)
    h = x + rms_norm(mix_out, post_mix_w)

    v = rms_norm(h, pre_ffn_w)
    gate, up = jnp.split(jnp.einsum('btd,df->btf', v, w_gate_up), 2, axis=-1)
    f = jnp.einsum('btf,fd->btd', jax.nn.silu(gate) * up, w_down)
    return h + rms_norm(f, post_ffn_w)


def setup_inputs(seed: int = 0) -> dict:
    key = jax.random.key(seed)
    ks = jax.random.split(key, 20)
    f32 = jnp.float32

    def nrm(k, shape, scale):
        return jax.random.normal(k, shape, f32) * scale

    def gain(k, n):
        return 1.0 + 0.02 * jax.random.normal(k, (DEPTH, n), f32)

    dt = jnp.exp(jax.random.uniform(ks[6], (DEPTH, DN_HEADS), f32, np.log(1e-3), np.log(1e-1)))
    return {
        "x": jax.random.normal(ks[0], (BATCH, SEQ, D_MODEL), f32),
        "hg_lower_bounds": nrm(ks[1], (DEPTH, HG_WIDTH), 0.1),
        "pre_mix_w": gain(ks[2], D_MODEL),
        "w_in": nrm(ks[3], (DEPTH, D_MODEL, IN_WIDTH), D_MODEL ** -0.5),
        "hg_norm_w": gain(ks[4], HG_DV),
        "conv_w": nrm(ks[5], (DEPTH, CONV_W, 2 * DN_KW + DN_VW), CONV_W ** -0.5),
        "dn_a_log": jnp.log(jax.random.uniform(ks[7], (DEPTH, DN_HEADS), f32, 1.0, 16.0)),
        "dn_dt_bias": dt + jnp.log(-jnp.expm1(-dt)),
        "dn_norm_w": gain(ks[8], DN_DV),
        "w_o_hg": nrm(ks[9], (DEPTH, HG_VWIDTH, D_MODEL), HG_VWIDTH ** -0.5),
        "w_o_dn": nrm(ks[10], (DEPTH, DN_VW, D_MODEL), DN_VW ** -0.5),
        "w_out": nrm(ks[11], (DEPTH, D_MODEL, D_MODEL), D_MODEL ** -0.5),
        "post_mix_w": gain(ks[12], D_MODEL),
        "pre_ffn_w": gain(ks[13], D_MODEL),
        "w_gate_up": nrm(ks[14], (DEPTH, D_MODEL, 2 * D_FF), D_MODEL ** -0.5),
        "w_down": nrm(ks[15], (DEPTH, D_FF, D_MODEL), D_FF ** -0.5),
        "post_ffn_w": gain(ks[16], D_MODEL),
    }


def reference(x, hg_lower_bounds, pre_mix_w, w_in, hg_norm_w, conv_w, dn_a_log, dn_dt_bias,
              dn_norm_w, w_o_hg, w_o_dn, w_out, post_mix_w, pre_ffn_w, w_gate_up, w_down,
              post_ffn_w):
    lbs = jnp.cumsum(jax.nn.softmax(hg_lower_bounds.astype(jnp.float32), axis=0), axis=0)
    lbs = lbs - lbs[0]
    h = x
    for l in range(DEPTH):
        h = hybrid_layer(h, lbs[l], pre_mix_w[l], w_in[l], hg_norm_w[l], conv_w[l], dn_a_log[l],
                         dn_dt_bias[l], dn_norm_w[l], w_o_hg[l], w_o_dn[l], w_out[l],
                         post_mix_w[l], pre_ffn_w[l], w_gate_up[l], w_down[l], post_ffn_w[l])
    return h
```

```cpp
#include <hip/hip_runtime.h>
#include <cstdio>
#include <cstdint>

constexpr int DM = 1024, BATCH = 8, SEQ = 8192, MTOK = BATCH * SEQ, DEPTH = 2;
constexpr int NHEAD = 4, HDIM = 128, HWID = 512;
constexpr int DFF = 2816, INW = 6152;
constexpr int N_INA = 4096;
constexpr int N_INB = 2048;
constexpr int CONVW = 4, CONVC = 1536;
constexpr float EPSF = 1e-6f;
#define MK_ONE_LAUNCH 1
namespace pg8 {
#define PG8_LAS __attribute__((address_space(3)))
typedef unsigned short bf16_t;
typedef short bf16x8 __attribute__((ext_vector_type(8)));
typedef float f32x4 __attribute__((ext_vector_type(4)));
typedef unsigned u32x4 __attribute__((ext_vector_type(4)));
constexpr int BM = 256, BK = 64, HALF = 128, HTB = HALF * BK * 2  , STAGE_BYTES = 8 * HTB, NXCD = 8, WGM = 8;

__host__ __device__ __forceinline__ int lds_byte(int r, int c) { const int st = (r >> 4) * 2 + (c >> 5), rr = r & 15, cc = c & 31, ob = rr * 64 + cc * 2; return st * 1024 + (ob ^ (((ob >> 9) & 1) << 5)); }
__host__ __device__ __forceinline__ void stage_rc(int b, int& R, int& C) { const int st = b / 1024, sb = b % 1024, swz = sb ^ (((sb >> 9) & 1) << 5); R = (st >> 1) * 16 + swz / 64; C = (st & 1) * 32 + (swz % 64) / 2; }
__host__ __device__ __forceinline__ int perm32(int rho) { const int n = rho >> 4, i = rho & 15; return 8 * (i >> 2) + 4 * n + (i & 3); }

struct Unit { int pm, pn; };
struct Gemm { const bf16_t* A; const bf16_t* Bt; int M, N, K; };

struct StaticOrder {
    int nM, nN, nwg, G, c;
    __host__ __device__ void init(int M, int N, int G_, int c_) { nM = M / BM; nN = N / BM; nwg = nM * nN; G = G_; c = c_; }
    __host__ __device__ bool next(int i, Unit& u) const {
        const long L = (long)i * G + c; if (L >= nwg) return false;
        int wgid = (int)L; { const int q = nwg / NXCD, r = nwg % NXCD, xcd = wgid % NXCD, off = wgid / NXCD; wgid = (xcd < r ? xcd * (q + 1) : r * (q + 1) + (xcd - r) * q) + off; }
        const int nig = WGM * nN, gid = wgid / nig, fm = gid * WGM, gsz = (nM - fm) < WGM ? (nM - fm) : WGM;
        u.pm = fm + ((wgid % nig) % gsz); u.pn = (wgid % nig) / gsz; return true;
    }
    __device__ __forceinline__ void a_ready(const Unit&) const {}
    __device__ __forceinline__ void done(const Unit&) const {}
};

__device__ __forceinline__ unsigned cvt_pk_bf16(float lo, float hi) { unsigned r; asm volatile("v_cvt_pk_bf16_f32 %0, %1, %2" : "=v"(r) : "v"(lo), "v"(hi)); return r; }
typedef float f32x2 __attribute__((ext_vector_type(2)));
__device__ __forceinline__ f32x2 gelu_pk(f32x2 v) {
    const f32x2 av = __builtin_elementwise_abs(v), d = av * 0.2316418882f + 1.0f;
    f32x2 t; t.x = __builtin_amdgcn_rcpf(d.x); t.y = __builtin_amdgcn_rcpf(d.y);
    f32x2 q = t * 0.5307027145f + (-0.7265760135f); q = q * t + 0.7107068705f; q = q * t + (-0.142248368f); q = q * t + 0.127414796f; q = q * t;
    const f32x2 s = (v * v) * (-0.72134752044f);
    f32x2 e; e.x = __builtin_amdgcn_exp2f(s.x); e.y = __builtin_amdgcn_exp2f(s.y);
    const f32x2 m = v * (q * e), r = v - m;
    f32x2 o; o.x = v.x < 0.f ? m.x : r.x; o.y = v.y < 0.f ? m.y : r.y; return o;
}

template <int ACT  > struct EpiBf16 {
    static constexpr bool PERM = true, AFTER_DRAIN = false; static_assert(ACT == 0 || ACT == 1, "EpiBf16: ACT is 0 (none) or 1 (gelu_pk)");
    bf16_t* O; int ldc; const float* bias; int split_cols; size_t split_stride; float scale0;
    __device__ __forceinline__ void operator()(const f32x4 (&acc)[2][2][4][2], const Unit& u, int wr, int wc, int fr, int fq) const {
        const int row0 = u.pm * BM + wr * 64 + fr; int colt = u.pn * BM; bf16_t* base = O;
        float sc = 1.f; if (split_cols) { const int t = colt / split_cols; base += (size_t)t * split_stride; colt -= t * split_cols; if (t == 0) sc = scale0; }
        const int col0 = colt + wc * 32 + 8 * fq, bcol0 = u.pn * BM + wc * 32 + 8 * fq;
        f32x4 bv[2][2];
#pragma unroll
        for (int bj = 0; bj < 2; ++bj)
#pragma unroll
            for (int n = 0; n < 2; ++n) bv[bj][n] = bias ? *(const f32x4*)(bias + bcol0 + bj * HALF + 4 * n) : (f32x4){0.f, 0.f, 0.f, 0.f};
#pragma unroll
        for (int ai = 0; ai < 2; ++ai)
#pragma unroll
            for (int m = 0; m < 4; ++m) { bf16_t* rowp = base + (size_t)(row0 + ai * HALF + m * 16) * ldc + col0;
#pragma unroll
                for (int bj = 0; bj < 2; ++bj) { f32x4 v0 = acc[ai][bj][m][0] + bv[bj][0], v1 = acc[ai][bj][m][1] + bv[bj][1];
                    if (ACT == 1) { f32x2 a = gelu_pk((f32x2){v0[0], v0[1]}), b = gelu_pk((f32x2){v0[2], v0[3]}), c = gelu_pk((f32x2){v1[0], v1[1]}), d = gelu_pk((f32x2){v1[2], v1[3]});
                        v0 = (f32x4){a.x, a.y, b.x, b.y}; v1 = (f32x4){c.x, c.y, d.x, d.y}; }
                    v0 = v0 * sc; v1 = v1 * sc; u32x4 w; w.x = cvt_pk_bf16(v0[0], v0[1]); w.y = cvt_pk_bf16(v0[2], v0[3]); w.z = cvt_pk_bf16(v1[0], v1[1]); w.w = cvt_pk_bf16(v1[2], v1[3]);
                    *(u32x4*)(rowp + bj * HALF) = w; } }
    }
};
__device__ __forceinline__ float bf_lo(unsigned w) { return __builtin_bit_cast(float, w << 16); }
__device__ __forceinline__ float bf_hi(unsigned w) { return __builtin_bit_cast(float, w & 0xffff0000u); }
__device__ __forceinline__ float sigm(float x) { return __builtin_amdgcn_rcpf(1.f + __expf(-x)); }
typedef __bf16 bfp2 __attribute__((ext_vector_type(2)));
__device__ __forceinline__ unsigned pkv(float lo, float hi) { f32x2 v = {lo, hi}; bfp2 r = __builtin_convertvector(v, bfp2); return __builtin_bit_cast(unsigned, r); }

struct EpiProjA {
    static constexpr bool PERM = true, AFTER_DRAIN = false;
    bf16_t* planes; size_t plane_stride;
    __device__ __forceinline__ void operator()(const f32x4 (&acc)[2][2][4][2], const Unit& u, int wr, int wc, int fr, int fq) const {
        const int row0 = u.pm * BM + wr * 64 + fr;
        {
            const int pl = u.pn >> 1, slot = pl == 3 ? 6 : (pl == 6 ? 3 : pl);
            bf16_t* base = planes + (size_t)slot * plane_stride;
            const int col0 = (u.pn & 1) * 256 + wc * 32 + 8 * fq;
#pragma unroll
            for (int ai = 0; ai < 2; ++ai)
#pragma unroll
                for (int m = 0; m < 4; ++m) { const int row = row0 + ai * HALF + m * 16; bf16_t* rowp = base + (size_t)row * 512 + col0;
#pragma unroll
                    for (int bj = 0; bj < 2; ++bj) { const f32x4 v0 = acc[ai][bj][m][0], v1 = acc[ai][bj][m][1];
                        u32x4 w; w.x = pkv(v0[0], v0[1]); w.y = pkv(v0[2], v0[3]); w.z = pkv(v1[0], v1[1]); w.w = pkv(v1[2], v1[3]);
                        *(u32x4*)(rowp + bj * HALF) = w; } }
        }
    }
};
struct EpiGate {
    static constexpr bool PERM = true, AFTER_DRAIN = false;
    bf16_t* gates; size_t plane_stride;
    __device__ __forceinline__ void operator()(const f32x4 (&acc)[2][2][4][2], const Unit& u, int wr, int wc, int fr, int fq) const {
        const int row0 = u.pm * BM + wr * 64 + fr;
        bf16_t* base = gates + (size_t)(u.pn >> 2) * plane_stride;
        const int col0 = (u.pn & 3) * 256 + wc * 32 + 8 * fq;
#pragma unroll
        for (int ai = 0; ai < 2; ++ai)
#pragma unroll
            for (int m = 0; m < 4; ++m) { const int row = row0 + ai * HALF + m * 16; bf16_t* rowp = base + (size_t)row * 1024 + col0;
#pragma unroll
                for (int bj = 0; bj < 2; ++bj) { f32x4 v0 = acc[ai][bj][m][0], v1 = acc[ai][bj][m][1];
#pragma unroll
                    for (int e = 0; e < 4; ++e) { v0[e] = sigm(v0[e]); v1[e] = sigm(v1[e]); }
                    u32x4 w; w.x = pkv(v0[0], v0[1]); w.y = pkv(v0[2], v0[3]); w.z = pkv(v1[0], v1[1]); w.w = pkv(v1[2], v1[3]);
                    *(u32x4*)(rowp + bj * HALF) = w; } }
    }
};
struct EpiMerge {
    static constexpr bool PERM = true, AFTER_DRAIN = false;
    bf16_t* out; const bf16_t* gates; size_t gate_stride;
    __device__ __forceinline__ void operator()(const f32x4 (&acc)[2][2][4][2], const Unit& u, int wr, int wc, int fr, int fq) const {
        const int br = u.pm >= (MTOK / BM) ? 1 : 0;
        const int pm = u.pm - br * (MTOK / BM), pn = u.pn - br * 4;
        const int row0 = pm * BM + wr * 64 + fr, col0 = pn * 256 + wc * 32 + 8 * fq;
        const bf16_t* gb = gates + (size_t)br * gate_stride;
#pragma unroll
        for (int ai = 0; ai < 2; ++ai)
#pragma unroll
            for (int m = 0; m < 4; ++m) { const size_t off = (size_t)(row0 + ai * HALF + m * 16) * 1024 + col0;
#pragma unroll
                for (int bj = 0; bj < 2; ++bj) { const u32x4 g = *(const u32x4*)(gb + off + bj * HALF);
                    f32x4 v0 = acc[ai][bj][m][0], v1 = acc[ai][bj][m][1];
                    v0[0] *= bf_lo(g.x); v0[1] *= bf_hi(g.x); v0[2] *= bf_lo(g.y); v0[3] *= bf_hi(g.y);
                    v1[0] *= bf_lo(g.z); v1[1] *= bf_hi(g.z); v1[2] *= bf_lo(g.w); v1[3] *= bf_hi(g.w);
                    if (br) { const u32x4 p = *(const u32x4*)(out + off + bj * HALF);
                        v0[0] += bf_lo(p.x); v0[1] += bf_hi(p.x); v0[2] += bf_lo(p.y); v0[3] += bf_hi(p.y);
                        v1[0] += bf_lo(p.z); v1[1] += bf_hi(p.z); v1[2] += bf_lo(p.w); v1[3] += bf_hi(p.w); }
                    u32x4 w; w.x = pkv(v0[0], v0[1]); w.y = pkv(v0[2], v0[3]); w.z = pkv(v1[0], v1[1]); w.w = pkv(v1[2], v1[3]);
                    *(u32x4*)(out + off + bj * HALF) = w; } }
    }
};
struct PairOrder {
    StaticOrder so;
    __device__ __forceinline__ bool next(int i, Unit& u) const { Unit t; if (!so.next(i >> 1, t)) return false; const int br = i & 1; u.pm = t.pm + br * (MTOK / BM); u.pn = t.pn + br * 4; return true; }
    __device__ __forceinline__ void a_ready(const Unit&) const {}
    __device__ __forceinline__ void done(const Unit&) const {}
};
struct SplitOrder {
    StaticOrder so; int first, stride, count;
    __device__ __forceinline__ bool next(int i, Unit& u) const {
        if (i >= count) return false;
        int wgid = first + i * stride; { const int q = so.nwg / NXCD, r = so.nwg % NXCD, xcd = wgid % NXCD, off = wgid / NXCD; wgid = (xcd < r ? xcd * (q + 1) : r * (q + 1) + (xcd - r) * q) + off; }
        const int nig = WGM * so.nN, gid = wgid / nig, fm = gid * WGM, gsz = (so.nM - fm) < WGM ? (so.nM - fm) : WGM;
        u.pm = fm + ((wgid % nig) % gsz); u.pn = (wgid % nig) / gsz; return true;
    }
    __device__ __forceinline__ void a_ready(const Unit&) const {}
    __device__ __forceinline__ void done(const Unit&) const {}
};
struct PanelOrder {
    int pm;
    __device__ __forceinline__ bool next(int i, Unit& u) const { if (i >= 4) return false; u.pm = pm; u.pn = i; return true; }
    __device__ __forceinline__ void a_ready(const Unit&) const {}
    __device__ __forceinline__ void done(const Unit&) const {}
};
struct EpiSwiGLU {
    static constexpr bool PERM = true, AFTER_DRAIN = false;
    bf16_t* act;
    __device__ __forceinline__ void operator()(const f32x4 (&acc)[2][2][4][2], const Unit& u, int wr, int wc, int fr, int fq) const {
        const int row0 = u.pm * BM + wr * 64 + fr, col0 = u.pn * 128 + wc * 32 + 8 * fq;
#pragma unroll
        for (int ai = 0; ai < 2; ++ai)
#pragma unroll
            for (int m = 0; m < 4; ++m) { const int row = row0 + ai * HALF + m * 16;
                float o[8];
#pragma unroll
                for (int n = 0; n < 2; ++n)
#pragma unroll
                    for (int e = 0; e < 4; ++e) { const float g = acc[ai][0][m][n][e], uu = acc[ai][1][m][n][e]; o[n * 4 + e] = g * sigm(g) * uu; }
                u32x4 w; w.x = pkv(o[0], o[1]); w.y = pkv(o[2], o[3]); w.z = pkv(o[4], o[5]); w.w = pkv(o[6], o[7]);
                *(u32x4*)(act + (size_t)row * DFF + col0) = w; }
    }
};

template <class Epi, class Sched, bool ALIGN_EPI = false, bool SP2 = false>
__device__ __forceinline__ void gemm_phase(PG8_LAS unsigned char* lds, const Gemm g, const Sched& S, const Epi& E) {
    int tid_ = threadIdx.x; asm volatile("" : "+v"(tid_));
    const int tid = tid_, wid = __builtin_amdgcn_readfirstlane(tid >> 6), lane = tid & 63, wr = wid >> 2, wc = wid & 3, fr = lane & 15, fq = lane >> 4;
    const int K = g.K, nt = K / BK;
    unsigned voffA[2], voffB[2];
#pragma unroll
    for (int i = 0; i < 2; ++i) { int R, C; stage_rc(tid * 16 + i * 8192, R, C); const int Rb = Epi::PERM ? ((R & ~31) + perm32(R & 31)) : R;
        voffA[i] = (unsigned)(R * K + C) * 2u; voffB[i] = (unsigned)(Rb * K + C) * 2u; }
    const size_t kstep = (size_t)(BK * 2);
    const size_t hstep = (size_t)HALF * K * 2;
    const size_t tstep = 2 * hstep;
    const unsigned ldsw = (unsigned)wid * 1024u;
    const int aoff = lds_byte(wr * 64 + fr, fq * 8), boff = lds_byte(wc * 32 + fr, fq * 8);
#define PG8_SA(b, h) (((b) * 2 + (h)) * HTB)
#define PG8_SB(b, h) ((4 + (b) * 2 + (h)) * HTB)
#define PG8_STAGE(bufoff, gbase, voff) do { _Pragma("unroll") for (int _i = 0; _i < 2; ++_i) \
        __builtin_amdgcn_global_load_lds((const unsigned*)((const char*)(gbase) + (voff)[_i]), (PG8_LAS unsigned*)(lds + (bufoff) + ldsw + _i * 8192), 16, 0, 0); } while (0)
#define PG8_LDA(dst, b, h) do { _Pragma("unroll") for (int m = 0; m < 4; ++m) _Pragma("unroll") for (int k = 0; k < 2; ++k) dst[m][k] = *(const PG8_LAS bf16x8*)(lds + PG8_SA(b, h) + aoff + m * 2048 + k * 1024); } while (0)
#define PG8_LDB(dst, b, h) do { _Pragma("unroll") for (int n = 0; n < 2; ++n) _Pragma("unroll") for (int k = 0; k < 2; ++k) dst[n][k] = *(const PG8_LAS bf16x8*)(lds + PG8_SB(b, h) + boff + n * 2048 + k * 1024); } while (0)
#define PG8_MMA(ai, bj, At, Bt) do { __builtin_amdgcn_s_setprio(1); _Pragma("unroll") for (int m = 0; m < 4; ++m) _Pragma("unroll") for (int n = 0; n < 2; ++n) _Pragma("unroll") for (int k = 0; k < 2; ++k) \
        acc[ai][bj][m][n] = __builtin_amdgcn_mfma_f32_16x16x32_bf16(Bt[n][k], At[m][k], acc[ai][bj][m][n], 0, 0, 0); __builtin_amdgcn_s_setprio(0); } while (0)
#define PG8_WAIT_V(n) asm volatile("s_waitcnt vmcnt(" #n ")" ::: "memory")
#define PG8_WAIT_L(n) asm volatile("s_waitcnt lgkmcnt(" #n ")" ::: "memory")
#define PG8_BAR __builtin_amdgcn_s_barrier()
#define PG8_SCHED __builtin_amdgcn_sched_barrier(0)
    Unit cur, nxt; int ui = 0;
    if (!S.next(0, cur)) return;
    f32x4 acc[2][2][4][2];
#pragma unroll
    for (int a = 0; a < 2; ++a)
#pragma unroll
        for (int b = 0; b < 2; ++b)
#pragma unroll
            for (int m = 0; m < 4; ++m)
#pragma unroll
                for (int n = 0; n < 2; ++n) acc[a][b][m][n] = (f32x4){0.f, 0.f, 0.f, 0.f};
    bf16x8 At[4][2], B0[2][2], B1[2][2];
    const char* cA = (const char*)g.A + (size_t)cur.pm * tstep; const char* cB = (const char*)g.Bt + (size_t)cur.pn * tstep;
    S.a_ready(cur);
    if constexpr (SP2) {
        PG8_STAGE(PG8_SB(0, 0), cB, voffB); PG8_STAGE(PG8_SB(0, 1), cB + hstep, voffB); PG8_STAGE(PG8_SA(0, 0), cA, voffA); PG8_STAGE(PG8_SA(0, 1), cA + hstep, voffA);
        if (wr == 1) PG8_BAR;
        PG8_WAIT_V(2); PG8_BAR;
        PG8_STAGE(PG8_SB(1, 0), cB + kstep, voffB); PG8_STAGE(PG8_SA(1, 0), cA + kstep, voffA); PG8_STAGE(PG8_SB(1, 1), cB + hstep + kstep, voffB);
        PG8_WAIT_V(6); PG8_BAR;
    } else {
        PG8_STAGE(PG8_SB(0, 0), cB, voffB); PG8_STAGE(PG8_SA(0, 0), cA, voffA); PG8_STAGE(PG8_SB(0, 1), cB + hstep, voffB); PG8_STAGE(PG8_SA(0, 1), cA + hstep, voffA);
        if (wr == 1) PG8_BAR;
        PG8_WAIT_V(4); PG8_BAR;
        PG8_STAGE(PG8_SB(1, 0), cB + kstep, voffB); PG8_STAGE(PG8_SA(1, 0), cA + kstep, voffA); PG8_STAGE(PG8_SB(1, 1), cB + hstep + kstep, voffB);
        PG8_WAIT_V(6); PG8_BAR;
    }
    for (;;) {
        const bool has_next = S.next(ui + 1, nxt);
        const char* nA = has_next ? (const char*)g.A + (size_t)nxt.pm * tstep : cA; const char* nB = has_next ? (const char*)g.Bt + (size_t)nxt.pn * tstep : cB;
        for (int t = 0; t < nt; t += 2) {
            const bool last = (t == nt - 2);
            const char* a1 = cA + (size_t)(t + 1) * kstep;
            const char* a2 = last ? nA : cA + (size_t)(t + 2) * kstep; const char* b2 = last ? nB : cB + (size_t)(t + 2) * kstep;
            const char* a3 = a2 + kstep; const char* b3 = b2 + kstep;
            if (last && has_next) S.a_ready(nxt);
            if constexpr (SP2) {
            PG8_LDB(B0, 0, 0); PG8_LDB(B1, 0, 1); PG8_SCHED; PG8_LDA(At, 0, 0); PG8_STAGE(PG8_SA(1, 1), a1 + hstep, voffA);
            PG8_WAIT_V(8); PG8_WAIT_L(0); PG8_BAR; PG8_MMA(0, 0, At, B0); PG8_MMA(0, 1, At, B1); PG8_BAR; PG8_SCHED;
            PG8_LDA(At, 0, 1); PG8_STAGE(PG8_SB(0, 0), b2, voffB); PG8_STAGE(PG8_SB(0, 1), b2 + hstep, voffB); PG8_STAGE(PG8_SA(0, 0), a2, voffA);
            PG8_WAIT_V(8); PG8_WAIT_L(0); PG8_BAR; PG8_MMA(1, 0, At, B0); PG8_MMA(1, 1, At, B1); PG8_BAR; PG8_SCHED;
            PG8_LDB(B0, 1, 0); PG8_LDB(B1, 1, 1); PG8_SCHED; PG8_LDA(At, 1, 0); PG8_STAGE(PG8_SA(0, 1), a2 + hstep, voffA);
            PG8_WAIT_V(8); PG8_WAIT_L(0); PG8_BAR; PG8_MMA(0, 0, At, B0); PG8_MMA(0, 1, At, B1); PG8_BAR; PG8_SCHED;
            PG8_LDA(At, 1, 1); PG8_STAGE(PG8_SB(1, 0), b3, voffB); PG8_STAGE(PG8_SB(1, 1), b3 + hstep, voffB); PG8_STAGE(PG8_SA(1, 0), a3, voffA);
            PG8_WAIT_V(8); PG8_WAIT_L(0); PG8_BAR; PG8_MMA(1, 0, At, B0); PG8_MMA(1, 1, At, B1); PG8_BAR; PG8_SCHED;
            } else {
            PG8_LDB(B0, 0, 0); PG8_SCHED; PG8_LDA(At, 0, 0); PG8_STAGE(PG8_SA(1, 1), a1 + hstep, voffA);
            PG8_WAIT_L(8); PG8_BAR; PG8_WAIT_L(0); PG8_MMA(0, 0, At, B0); PG8_BAR; PG8_SCHED;
            PG8_LDB(B1, 0, 1); PG8_STAGE(PG8_SB(0, 0), b2, voffB);
            PG8_BAR; PG8_WAIT_L(0); PG8_MMA(0, 1, At, B1); PG8_BAR;
            PG8_LDA(At, 0, 1); PG8_STAGE(PG8_SA(0, 0), a2, voffA);
            PG8_BAR; PG8_WAIT_L(0); PG8_MMA(1, 0, At, B0); PG8_BAR; PG8_SCHED;
            PG8_STAGE(PG8_SB(0, 1), b2 + hstep, voffB);
            PG8_WAIT_V(6); PG8_BAR; PG8_MMA(1, 1, At, B1); PG8_BAR;
            PG8_LDB(B0, 1, 0); PG8_SCHED; PG8_LDA(At, 1, 0); PG8_STAGE(PG8_SA(0, 1), a2 + hstep, voffA);
            PG8_WAIT_L(8); PG8_BAR; PG8_WAIT_L(0); PG8_MMA(0, 0, At, B0); PG8_BAR; PG8_SCHED;
            PG8_LDB(B1, 1, 1); PG8_STAGE(PG8_SB(1, 0), b3, voffB);
            PG8_BAR; PG8_WAIT_L(0); PG8_MMA(0, 1, At, B1); PG8_BAR;
            PG8_LDA(At, 1, 1); PG8_STAGE(PG8_SA(1, 0), a3, voffA);
            PG8_BAR; PG8_WAIT_L(0); PG8_MMA(1, 0, At, B0); PG8_BAR; PG8_SCHED;
            PG8_STAGE(PG8_SB(1, 1), b3 + hstep, voffB);
            PG8_WAIT_V(6); PG8_BAR; PG8_MMA(1, 1, At, B1); PG8_BAR;
            }
        }
        if constexpr (ALIGN_EPI) { if (wr == 0) PG8_BAR; }
        if constexpr (!Epi::AFTER_DRAIN) { E(acc, cur, wr, wc, fr, fq); S.done(cur); }
        if (!has_next) break;
#pragma unroll
        for (int a = 0; a < 2; ++a)
#pragma unroll
            for (int b = 0; b < 2; ++b)
#pragma unroll
                for (int m = 0; m < 4; ++m)
#pragma unroll
                    for (int n = 0; n < 2; ++n) acc[a][b][m][n] = (f32x4){0.f, 0.f, 0.f, 0.f};
        cur = nxt; cA = nA; cB = nB; ++ui;
        if constexpr (ALIGN_EPI) { if (wr == 1) PG8_BAR; }
    }
    PG8_WAIT_V(0);
    if constexpr (!ALIGN_EPI) { if (wr == 0) PG8_BAR; }
    PG8_BAR;
    if constexpr (Epi::AFTER_DRAIN) { E.fused(acc, cur, wr, wc, fr, fq, lds, wid, lane); S.done(cur); }
#undef PG8_SA
#undef PG8_SB
#undef PG8_STAGE
#undef PG8_LDA
#undef PG8_LDB
#undef PG8_MMA
#undef PG8_WAIT_V
#undef PG8_WAIT_L
#undef PG8_BAR
#undef PG8_SCHED
}
}

#ifndef PG8_SP2
#define PG8_SP2 true
#endif
#ifndef PG8_ALIGN
#define PG8_ALIGN true
#endif
constexpr int NWAVES = 8;
#ifndef MK_ONE_LAUNCH
#define MK_ONE_LAUNCH 0
#endif
constexpr int N_PHASES = 1 + 11 * DEPTH;

constexpr size_t MiB = 1u << 20;
constexpr size_t WS_CTL = 0, CTL_ZERO_BYTES = 1 * MiB;
constexpr size_t WS_W = 1 * MiB;
constexpr size_t W_INA = 0, W_INB = W_INA + (size_t)N_INA * DM, W_O2 = W_INB + (size_t)N_INB * DM, W_OUT = W_O2 + (size_t)2048 * 512,
                 W_GU = W_OUT + (size_t)DM * DM, W_DN = W_GU + (size_t)2 * DFF * DM, W_LAYER = W_DN + (size_t)DM * DFF;
static_assert(W_LAYER * 2 <= 33 * MiB, "weights per layer");
constexpr size_t WS_RSTD = 67 * MiB;
constexpr size_t WS_AB = 68 * MiB;
constexpr size_t WS_R = 72 * MiB;
constexpr size_t WS_P = 200 * MiB;
constexpr size_t PLANE = (size_t)MTOK * 512;
constexpr size_t WS_X = 712 * MiB;
constexpr size_t WS_GATES = 200 * MiB;
constexpr size_t WS_OCAT = 456 * MiB;
constexpr size_t WS_MERGED = 584 * MiB;
constexpr size_t WS_MIX = 456 * MiB;
constexpr size_t WS_ACT = 200 * MiB;
constexpr size_t WS_F = 584 * MiB;
constexpr size_t WS_END = 1004 * MiB;
constexpr int CW_BAR = 4096;

constexpr int LDS_BYTES = 163840;
constexpr int MISC_OFF = LDS_BYTES - 512;

#define GAS __attribute__((address_space(1)))
#define LAS __attribute__((address_space(3)))
typedef unsigned short bf16;
typedef unsigned v4u __attribute__((ext_vector_type(4)));
typedef unsigned v2u __attribute__((ext_vector_type(2)));
typedef float f32x4 __attribute__((ext_vector_type(4)));
typedef GAS unsigned gu32;
#define RLX_AGENT __ATOMIC_RELAXED, __HIP_MEMORY_SCOPE_AGENT
#define LDS_WAIT() asm volatile("s_waitcnt lgkmcnt(0)" ::: "memory")
#define VM_WAIT() asm volatile("s_waitcnt vmcnt(0)" ::: "memory")
typedef __bf16 bfv2_ __attribute__((ext_vector_type(2)));
typedef float fv2_ __attribute__((ext_vector_type(2)));
__device__ __forceinline__ unsigned pk2(float lo, float hi) { fv2_ v = {lo, hi}; bfv2_ r = __builtin_convertvector(v, bfv2_); return __builtin_bit_cast(unsigned, r); }
__device__ __forceinline__ unsigned f2bf(float f) { return pk2(f, 0.f) & 0xffffu; }
__device__ __forceinline__ float bflo(unsigned w) { return __builtin_bit_cast(float, w << 16); }
__device__ __forceinline__ float bfhi(unsigned w) { return __builtin_bit_cast(float, w & 0xffff0000u); }
__device__ __forceinline__ float bf1(bf16 b) { return __builtin_bit_cast(float, (unsigned)b << 16); }
__device__ __forceinline__ float sigmf(float x) { return __builtin_amdgcn_rcpf(1.f + __expf(-x)); }
__device__ __forceinline__ float wave_sum(float v) {
    v += __builtin_bit_cast(float, __builtin_amdgcn_update_dpp(0, __builtin_bit_cast(int, v), 0xB1, 0xF, 0xF, true));
    v += __builtin_bit_cast(float, __builtin_amdgcn_update_dpp(0, __builtin_bit_cast(int, v), 0x4E, 0xF, 0xF, true));
    v += __builtin_bit_cast(float, __builtin_amdgcn_update_dpp(0, __builtin_bit_cast(int, v), 0x141, 0xF, 0xF, true));
    v += __builtin_bit_cast(float, __builtin_amdgcn_update_dpp(0, __builtin_bit_cast(int, v), 0x140, 0xF, 0xF, true));
    const int vi = __builtin_bit_cast(int, v);
    return (__builtin_bit_cast(float, __builtin_amdgcn_readlane(vi, 0)) + __builtin_bit_cast(float, __builtin_amdgcn_readlane(vi, 16))) +
           (__builtin_bit_cast(float, __builtin_amdgcn_readlane(vi, 32)) + __builtin_bit_cast(float, __builtin_amdgcn_readlane(vi, 48)));
}
#define XB_TMO      128
#define XB_XCNT(j)  (256  + 64 * (j))
#define XB_XSUB(j)  (1280 + 64 * (j))
#define XB_XGEN(j)  (2304 + 64 * (j))
#define XB_TOP      3328
#define XB_TOPGEN   3392
#define XCD_BAR_WORDS 3456
#define XB_SPIN_CAP (1u << 18)

__device__ __forceinline__ unsigned xb_ld(unsigned* p)              { return __hip_atomic_load(p, __ATOMIC_RELAXED, __HIP_MEMORY_SCOPE_AGENT); }
__device__ __forceinline__ unsigned xb_add(unsigned* p, unsigned v) { return __hip_atomic_fetch_add(p, v, __ATOMIC_RELAXED, __HIP_MEMORY_SCOPE_AGENT); }
__device__ __forceinline__ unsigned xb_xcc_id() { return (unsigned)__builtin_amdgcn_s_getreg((3 << 11) | 20) & 0xFu; }
#define XB_SPIN(cond, bar) do { unsigned _sp = 0; while (cond) { __builtin_amdgcn_s_sleep(1); \
    if ((++_sp & 255u) == 0u) { if (xb_ld(&(bar)[XB_TMO])) break; if (_sp > XB_SPIN_CAP) { atomicAdd(&(bar)[XB_TMO], 1u); break; } } } } while (0)

struct XcdBarrier {
    unsigned* bar; unsigned x;
    volatile LAS unsigned* st;
};

__device__ __forceinline__ XcdBarrier xcd_barrier_post(unsigned* bar, volatile LAS unsigned* st) {
    XcdBarrier b; b.bar = bar; b.x = xb_xcc_id(); b.st = st;
    if (threadIdx.x == 0) (void)xb_add(&bar[XB_XCNT(b.x)], 1u);
    return b;
}
__device__ __forceinline__ void xcd_barrier_complete(unsigned* bar, unsigned x, unsigned& nloc, unsigned& nx) {
    const unsigned G = gridDim.x * gridDim.y * gridDim.z;
    unsigned sum, cnt, mine, sp = 0u;
    for (;;) {
        sum = 0u; cnt = 0u; mine = 0u;
#pragma unroll
        for (unsigned j = 0; j < 16; ++j) { const unsigned c = xb_ld(&bar[XB_XCNT(j)]); sum += c; cnt += (c > 0u) ? 1u : 0u; mine = (j == x) ? c : mine; }
        if (sum == G) break;
        __builtin_amdgcn_s_sleep(1);
        if ((++sp & 255u) == 0u) { if (xb_ld(&bar[XB_TMO])) break; if (sp > XB_SPIN_CAP) { atomicAdd(&bar[XB_TMO], 1u); break; } }
    }
    nloc = mine > 0u ? mine : 1u; nx = cnt > 0u ? cnt : 1u;
}

__device__ __forceinline__ void xcd_barrier(const XcdBarrier& b) {
    asm volatile("s_waitcnt vmcnt(0)" ::: "memory");
    __syncthreads();
    if (threadIdx.x == 0) {
        unsigned* bar = b.bar;
        __builtin_amdgcn_s_waitcnt(0);
        unsigned nloc = b.st[0], nx = b.st[1];
        if (nloc == 0u) { xcd_barrier_complete(bar, b.x, nloc, nx); b.st[0] = nloc; b.st[1] = nx; }
        const unsigned old = xb_add(&bar[XB_XSUB(b.x)], 1u);
        const unsigned gen = old / nloc;
        if (old + 1u == (gen + 1u) * nloc) {
            __builtin_amdgcn_fence(__ATOMIC_RELEASE, "agent");
            asm volatile("s_waitcnt vmcnt(0)" ::: "memory");
            const unsigned og = xb_add(&bar[XB_TOP], 1u);
            const unsigned tg = og / nx;
            if (og + 1u == (tg + 1u) * nx) xb_add(&bar[XB_TOPGEN], 1u);
            else XB_SPIN(xb_ld(&bar[XB_TOPGEN]) == tg, bar);
            __builtin_amdgcn_fence(__ATOMIC_ACQUIRE, "agent");
            xb_add(&bar[XB_XGEN(b.x)], 1u);
            asm volatile("s_waitcnt vmcnt(0)" ::: "memory");
        } else {
            XB_SPIN(xb_ld(&bar[XB_XGEN(b.x)]) == gen, bar);
            __builtin_amdgcn_fence(__ATOMIC_ACQUIRE, "agent");
            asm volatile("s_waitcnt vmcnt(0)" ::: "memory");
        }
    }
    __syncthreads();
}

struct Frame {
    LAS unsigned char* lds;
    volatile LAS unsigned* MISC;
    gu32* ctl;
    int tid, lane, wave, G;
    const float* in[17];
    float* out; unsigned char* ws;
};


typedef short bf16x8 __attribute__((ext_vector_type(8)));
typedef float f32x16 __attribute__((ext_vector_type(16)));
typedef __bf16 bfv2 __attribute__((ext_vector_type(2)));
typedef float fv2 __attribute__((ext_vector_type(2)));
#define MFMA32(a, b, c) __builtin_amdgcn_mfma_f32_32x32x16_bf16((a), (b), (c), 0, 0, 0)
__device__ __forceinline__ unsigned pkc(float a, float b) { fv2 v = {a, b}; bfv2 r = __builtin_convertvector(v, bfv2); return __builtin_bit_cast(unsigned, r); }
__device__ __forceinline__ bf16x8 pack_half(const f32x16& x, int s) {
    v4u p; p.x = pkc(x[8 * s + 0], x[8 * s + 1]); p.y = pkc(x[8 * s + 2], x[8 * s + 3]); p.z = pkc(x[8 * s + 4], x[8 * s + 5]); p.w = pkc(x[8 * s + 6], x[8 * s + 7]);
    return __builtin_bit_cast(bf16x8, p);
}
__device__ __forceinline__ f32x16 zero16() { f32x16 z;
#pragma unroll
    for (int i = 0; i < 16; ++i) z[i] = 0.f; return z; }
__device__ __forceinline__ bf16x8 lds_frag(const LAS unsigned char* p) { return __builtin_bit_cast(bf16x8, *(const LAS v4u*)p); }

constexpr int NUNIT = BATCH * (SEQ / 64) * NHEAD;
constexpr size_t HG1_UNIT = 32768, HG2_UNIT = 25600;
constexpr size_t DN_UNIT = 74752;
constexpr size_t WS_DNB = 712 * MiB;
#ifdef DN_REF
constexpr size_t WS_ORAW = 712 * MiB;
#else
constexpr size_t WS_ORAW = 456 * MiB;
#endif
constexpr int PQ = 272, PT = 144;

struct HgRaw { unsigned q[8], f[8], i[8]; };
__device__ __forceinline__ void hg_raw_load(HgRaw& a, Frame& F, int unit, int lane) {
    const int h = unit & 3, n = (unit >> 2) & 127, b = unit >> 9; const size_t row0 = (size_t)b * SEQ + 64 * n;
    const bf16* P0 = (const bf16*)(F.ws + WS_P); const bf16* P1 = P0 + PLANE; const bf16* P2 = P1 + PLANE;
#pragma unroll
    for (int i = 0; i < 8; ++i) { const size_t off = (row0 + 8 * F.wave + i) * 512 + 128 * h + 2 * lane;
        a.q[i] = *(const GAS unsigned*)(P0 + off); a.f[i] = *(const GAS unsigned*)(P1 + off); a.i[i] = *(const GAS unsigned*)(P2 + off); }
}
__device__ __forceinline__ void prep_hg_unit(Frame& F, int l, int unit, const HgRaw& raw) {
    const int h = unit & 3, n = (unit >> 2) & 127, b = unit >> 9;
    const size_t row0 = (size_t)b * SEQ + 64 * n;
    LAS unsigned char* L = F.lds;
    LAS float* TOT = (LAS float*)L;
    LAS unsigned char* QT = L + 4096; LAS unsigned char* KT = QT + 64 * PQ; LAS unsigned char* QSR = KT + 64 * PQ;
    LAS unsigned char* KHT = QSR + 64 * PQ; LAS unsigned char* VI = KHT + 128 * PT; LAS unsigned char* ATT = VI + 64 * PQ;
    const bf16* P0 = (const bf16*)(F.ws + WS_P); const bf16* P1 = P0 + PLANE; const bf16* P2 = P1 + PLANE;
    unsigned char* part1 = (unsigned char*)F.out + 128 * MiB + (size_t)unit * HG1_UNIT;
    unsigned char* part2 = (unsigned char*)F.out + (size_t)unit * HG2_UNIT;
    const int w = F.wave; int lane = F.lane; asm volatile("" : "+v"(lane));
    const int d0 = 2 * lane;
    float lb[2] = {0.f, 0.f};
    if (l == 1) { lb[0] = sigmf(F.in[1][512 + 128 * h + d0] - F.in[1][128 * h + d0]); lb[1] = sigmf(F.in[1][512 + 128 * h + d0 + 1] - F.in[1][128 * h + d0 + 1]); }
    float q[8][2], kk[8][2], cs[8][2];
    {
        float run[2] = {0.f, 0.f};
#pragma unroll
        for (int i = 0; i < 8; ++i) {
            const unsigned qv = raw.q[i], fv = raw.f[i], iv = raw.i[i];
            *(LAS unsigned*)(VI + (8 * w + i) * PQ + 2 * d0) = iv;
            q[i][0] = bflo(qv); q[i][1] = bfhi(qv);
            const float fl[2] = {bflo(fv), bfhi(fv)};
#pragma unroll
            for (int e = 0; e < 2; ++e) { const float sg = sigmf(fl[e]); const float f = lb[e] + (1.f - lb[e]) * sg; kk[i][e] = (1.f - lb[e]) * (1.f - sg);
                run[e] += __logf(f); cs[i][e] = run[e]; } }
        TOT[w * 128 + d0] = run[0]; TOT[w * 128 + d0 + 1] = run[1];
    }
    __syncthreads();
    {
        float off[2] = {0.f, 0.f}, bref[2] = {0.f, 0.f}, blast[2] = {0.f, 0.f};
#pragma unroll
        for (int ww = 0; ww < 8; ++ww) { const float t0 = TOT[ww * 128 + d0], t1 = TOT[ww * 128 + d0 + 1];
            if (ww < w) { off[0] += t0; off[1] += t1; } if (ww < 4) { bref[0] += t0; bref[1] += t1; } blast[0] += t0; blast[1] += t1; }
        unsigned kh[2][4];
#pragma unroll
        for (int i = 0; i < 8; ++i) { float qt[2], kt[2], qs[2], kh_[2];
#pragma unroll
            for (int e = 0; e < 2; ++e) { const float bb = off[e] + cs[i][e];
                qt[e] = q[i][e] * __expf(fminf(bb - bref[e], 80.f)); kt[e] = kk[i][e] * __expf(fminf(bref[e] - bb, 80.f));
                qs[e] = q[i][e] * __expf(bb); kh_[e] = kk[i][e] * __expf(blast[e] - bb); }
            const int t = 8 * w + i;
            *(LAS unsigned*)(QT + t * PQ + 2 * d0) = pk2(qt[0], qt[1]); *(LAS unsigned*)(KT + t * PQ + 2 * d0) = pk2(kt[0], kt[1]); *(LAS unsigned*)(QSR + t * PQ + 2 * d0) = pk2(qs[0], qs[1]);
            if (i & 1) { kh[0][i >> 1] |= f2bf(kh_[0]) << 16; kh[1][i >> 1] |= f2bf(kh_[1]) << 16; } else { kh[0][i >> 1] = f2bf(kh_[0]); kh[1][i >> 1] = f2bf(kh_[1]); } }
        *(LAS v4u*)(KHT + d0 * PT + 16 * w) = (v4u){kh[0][0], kh[0][1], kh[0][2], kh[0][3]};
        *(LAS v4u*)(KHT + (d0 + 1) * PT + 16 * w) = (v4u){kh[1][0], kh[1][1], kh[1][2], kh[1][3]};
        if (w == 0) { *(GAS fv2*)(part2 + 8192 + 4 * d0) = (fv2){__expf(blast[0]), __expf(blast[1])}; }
    }
    __syncthreads();
    const int r = lane & 31, hg = lane >> 5;
    if (w < 3) {
        const int m = w >= 1 ? 1 : 0, mp = w == 2 ? 1 : 0;
        f32x16 acc = zero16();
#pragma unroll
        for (int ks = 0; ks < 8; ++ks) acc = MFMA32(lds_frag(QT + (32 * m + r) * PQ + 32 * ks + 16 * hg), lds_frag(KT + (32 * mp + r) * PQ + 32 * ks + 16 * hg), acc);
#pragma unroll
        for (int i = 0; i < 16; ++i) { const int ii = 32 * m + (i & 3) + 8 * (i >> 2) + 4 * hg, jj = 32 * mp + r;
            *(LAS bf16*)(ATT + ii * PT + 2 * jj) = (bf16)f2bf((jj <= ii ? 1.f : 0.f) * acc[i]); }
    } else if (w == 3) {
#pragma unroll
        for (int i = 0; i < 16; ++i) *(LAS bf16*)(ATT + (2 * i + hg) * PT + 2 * (32 + r)) = 0;
    }
    __syncthreads();
#pragma unroll
    for (int i = 0; i < 2; ++i) { const int f = w + 8 * i, m = f >> 3, kt = f & 7;
        const LAS unsigned char* src = QSR + (32 * m + r) * PQ + 2 * (16 * kt + 4 * hg);
        const v2u a = *(const LAS v2u*)src, c = *(const LAS v2u*)(src + 16);
        *(GAS v4u*)(part1 + f * 1024 + lane * 16) = (v4u){a.x, a.y, c.x, c.y}; }
#pragma unroll
    for (int i = 0; i < 2; ++i) { const int f = w + 8 * i, t4 = f >> 2, ktp = f & 3;
        *(GAS v4u*)(part1 + 16384 + f * 1024 + lane * 16) = *(const LAS v4u*)(KHT + (32 * t4 + r) * PT + 2 * (16 * ktp + 8 * hg)); }
    { const int f = w, m = f >> 2, ktp = f & 3;
        *(GAS v4u*)(part2 + f * 1024 + lane * 16) = *(const LAS v4u*)(ATT + (32 * m + r) * PT + 2 * (16 * ktp + 8 * hg)); }
#pragma unroll
    for (int i = 0; i < 2; ++i) { const int f = w + 8 * i, sl = f >> 2, ktp = f & 3;
        unsigned short e[8];
#pragma unroll
        for (int j = 0; j < 8; ++j) e[j] = *(const LAS bf16*)(VI + (16 * ktp + 8 * hg + j) * PQ + 2 * (32 * sl + r));
        *(GAS v4u*)(part2 + 9216 + f * 1024 + lane * 16) = (v4u){(unsigned)e[0] | ((unsigned)e[1] << 16), (unsigned)e[2] | ((unsigned)e[3] << 16), (unsigned)e[4] | ((unsigned)e[5] << 16), (unsigned)e[6] | ((unsigned)e[7] << 16)}; }
    __syncthreads();
}

__device__ __forceinline__ void scan_hg_chain(Frame& F, int bh, int sl0) {
    const int sl = sl0 + (F.wave & 1);
    const int b = bh >> 2, h = bh & 3;
    bf16* oraw = (bf16*)(F.ws + WS_ORAW);
    f32x16 S[4];
#pragma unroll
    for (int t = 0; t < 4; ++t) S[t] = zero16();
#define HG_ISSUE(nn, bufo) do { const int unit_ = (b * 128 + (nn)) * 4 + h; \
        const unsigned char* p1_ = (const unsigned char*)F.out + 128 * MiB + (size_t)unit_ * HG1_UNIT; const unsigned char* p2_ = (const unsigned char*)F.out + (size_t)unit_ * HG2_UNIT; \
        for (int f = F.wave - 2; f < 49; f += 6) { const unsigned char* src = f < 32 ? p1_ + f * 1024 : (f < 41 ? p2_ + (f - 32) * 1024 : p2_ + 9216 + (sl0 + ((f - 41) >> 2)) * 4096 + ((f - 41) & 3) * 1024); \
            __builtin_amdgcn_global_load_lds((const unsigned*)(src + lane * 16), (LAS unsigned*)(F.lds + (bufo) + f * 1024), 16, 0, 0); } } while (0)
    { const int lane = F.lane; if (F.wave >= 2) HG_ISSUE(0, 0); }
    for (int n = 0; n < SEQ / 64; ++n) {
        int lane = F.lane; asm volatile("" : "+v"(lane));
        const int r = lane & 31, hg = lane >> 5;
        LAS unsigned char* L = F.lds + (n & 1) * 66560;
        if (F.wave >= 2) asm volatile("s_waitcnt vmcnt(0)" ::: "memory");
        __syncthreads();
        if (F.wave >= 2 && n + 1 < SEQ / 64) HG_ISSUE(n + 1, ((n + 1) & 1) * 66560);
        if (F.wave < 2) {
            const size_t row0 = (size_t)b * SEQ + 64 * n;
            const LAS unsigned char* Lp = L + lane * 16;
            bf16x8 bs[8];
#pragma unroll
            for (int kt = 0; kt < 8; ++kt) bs[kt] = pack_half(S[kt >> 1], kt & 1);
            bf16x8 bv[4];
#pragma unroll
            for (int kt = 0; kt < 4; ++kt) bv[kt] = lds_frag(Lp + 41984 + (F.wave & 1) * 4096 + kt * 1024);
            f32x16 o[2] = {zero16(), zero16()};
#define HG_DECAY(t4) do { _Pragma("unroll") for (int g = 0; g < 4; ++g) { const f32x4 dc = *(const LAS f32x4*)(L + 40960 + 4 * (32 * (t4) + 8 * g + 4 * hg)); \
                _Pragma("unroll") for (int e = 0; e < 4; ++e) S[t4][4 * g + e] *= dc[e]; } } while (0)
            bf16x8 rg0 = lds_frag(Lp + 0);
            bf16x8 rg1 = lds_frag(Lp + 1024);
            bf16x8 rg2 = lds_frag(Lp + 2048);
            bf16x8 rg3 = lds_frag(Lp + 3072);
            bf16x8 rg4 = lds_frag(Lp + 4096);
            bf16x8 rg5 = lds_frag(Lp + 5120);
            bf16x8 rg6 = lds_frag(Lp + 6144);
            bf16x8 rg7 = lds_frag(Lp + 7168);
            { const bf16x8 a = rg0; rg0 = lds_frag(Lp + 8192);
              o[0] = MFMA32(a, bs[0], o[0]); }
            __builtin_amdgcn_sched_barrier(0);
            { const bf16x8 a = rg1; rg1 = lds_frag(Lp + 9216);
              o[0] = MFMA32(a, bs[1], o[0]); }
            __builtin_amdgcn_sched_barrier(0);
            { const bf16x8 a = rg2; rg2 = lds_frag(Lp + 10240);
              o[0] = MFMA32(a, bs[2], o[0]); }
            __builtin_amdgcn_sched_barrier(0);
            { const bf16x8 a = rg3; rg3 = lds_frag(Lp + 11264);
              o[0] = MFMA32(a, bs[3], o[0]); }
            __builtin_amdgcn_sched_barrier(0);
            { const bf16x8 a = rg4; rg4 = lds_frag(Lp + 12288);
              o[0] = MFMA32(a, bs[4], o[0]); }
            __builtin_amdgcn_sched_barrier(0);
            { const bf16x8 a = rg5; rg5 = lds_frag(Lp + 13312);
              o[0] = MFMA32(a, bs[5], o[0]); }
            __builtin_amdgcn_sched_barrier(0);
            { const bf16x8 a = rg6; rg6 = lds_frag(Lp + 14336);
              o[0] = MFMA32(a, bs[6], o[0]); }
            __builtin_amdgcn_sched_barrier(0);
            { const bf16x8 a = rg7; rg7 = lds_frag(Lp + 15360);
              o[0] = MFMA32(a, bs[7], o[0]); }
            __builtin_amdgcn_sched_barrier(0);
            { const bf16x8 a = rg0; rg0 = lds_frag(Lp + 32768);
              o[1] = MFMA32(a, bs[0], o[1]); }
            __builtin_amdgcn_sched_barrier(0);
            { const bf16x8 a = rg1; rg1 = lds_frag(Lp + 33792);
              o[1] = MFMA32(a, bs[1], o[1]); }
            __builtin_amdgcn_sched_barrier(0);
            { const bf16x8 a = rg2; rg2 = lds_frag(Lp + 36864);
              o[1] = MFMA32(a, bs[2], o[1]); }
            __builtin_amdgcn_sched_barrier(0);
            { const bf16x8 a = rg3; rg3 = lds_frag(Lp + 37888);
              o[1] = MFMA32(a, bs[3], o[1]); }
            __builtin_amdgcn_sched_barrier(0);
            { const bf16x8 a = rg4; rg4 = lds_frag(Lp + 38912);
              o[1] = MFMA32(a, bs[4], o[1]); }
            __builtin_amdgcn_sched_barrier(0);
            { const bf16x8 a = rg5; rg5 = lds_frag(Lp + 39936);
              o[1] = MFMA32(a, bs[5], o[1]); }
            __builtin_amdgcn_sched_barrier(0);
            { const bf16x8 a = rg6; rg6 = lds_frag(Lp + 16384);
              o[1] = MFMA32(a, bs[6], o[1]); }
            __builtin_amdgcn_sched_barrier(0);
            { const bf16x8 a = rg7; rg7 = lds_frag(Lp + 17408);
              o[1] = MFMA32(a, bs[7], o[1]); }
            __builtin_amdgcn_sched_barrier(0);
            { const bf16x8 a = rg0; rg0 = lds_frag(Lp + 18432);
              o[0] = MFMA32(a, bv[0], o[0]); }
            __builtin_amdgcn_sched_barrier(0);
            { const bf16x8 a = rg1; rg1 = lds_frag(Lp + 19456);
              o[0] = MFMA32(a, bv[1], o[0]); }
            __builtin_amdgcn_sched_barrier(0);
            { const bf16x8 a = rg2; rg2 = lds_frag(Lp + 20480);
              o[1] = MFMA32(a, bv[0], o[1]); }
            __builtin_amdgcn_sched_barrier(0);
            { const bf16x8 a = rg3; rg3 = lds_frag(Lp + 21504);
              o[1] = MFMA32(a, bv[1], o[1]); }
            __builtin_amdgcn_sched_barrier(0);
            { const bf16x8 a = rg4; rg4 = lds_frag(Lp + 22528);
              o[1] = MFMA32(a, bv[2], o[1]); }
            __builtin_amdgcn_sched_barrier(0);
            { const bf16x8 a = rg5; rg5 = lds_frag(Lp + 23552);
              o[1] = MFMA32(a, bv[3], o[1]); }
            __builtin_amdgcn_sched_barrier(0);
            { const bf16x8 a = rg6; rg6 = lds_frag(Lp + 24576);
              HG_DECAY(0);
              S[0] = MFMA32(a, bv[0], S[0]); }
            __builtin_amdgcn_sched_barrier(0);
            { const bf16x8 a = rg7; rg7 = lds_frag(Lp + 25600);
              S[0] = MFMA32(a, bv[1], S[0]); }
            __builtin_amdgcn_sched_barrier(0);
            { const bf16x8 a = rg0; rg0 = lds_frag(Lp + 26624);
              S[0] = MFMA32(a, bv[2], S[0]); }
            __builtin_amdgcn_sched_barrier(0);
            { const bf16x8 a = rg1; rg1 = lds_frag(Lp + 27648);
              S[0] = MFMA32(a, bv[3], S[0]); }
            __builtin_amdgcn_sched_barrier(0);
            { const bf16x8 a = rg2; rg2 = lds_frag(Lp + 28672);
              HG_DECAY(1);
              S[1] = MFMA32(a, bv[0], S[1]); }
            __builtin_amdgcn_sched_barrier(0);
            { const bf16x8 a = rg3; rg3 = lds_frag(Lp + 29696);
              S[1] = MFMA32(a, bv[1], S[1]); }
            __builtin_amdgcn_sched_barrier(0);
            { const bf16x8 a = rg4; rg4 = lds_frag(Lp + 30720);
              S[1] = MFMA32(a, bv[2], S[1]); }
            __builtin_amdgcn_sched_barrier(0);
            { const bf16x8 a = rg5; rg5 = lds_frag(Lp + 31744);
              S[1] = MFMA32(a, bv[3], S[1]); }
            __builtin_amdgcn_sched_barrier(0);
            { const bf16x8 a = rg6;
              HG_DECAY(2);
              S[2] = MFMA32(a, bv[0], S[2]); }
            __builtin_amdgcn_sched_barrier(0);
            { const bf16x8 a = rg7;
              S[2] = MFMA32(a, bv[1], S[2]); }
            __builtin_amdgcn_sched_barrier(0);
            { const bf16x8 a = rg0;
              S[2] = MFMA32(a, bv[2], S[2]); }
            __builtin_amdgcn_sched_barrier(0);
            { const bf16x8 a = rg1;
              S[2] = MFMA32(a, bv[3], S[2]); }
            __builtin_amdgcn_sched_barrier(0);
            { const bf16x8 a = rg2;
              HG_DECAY(3);
              S[3] = MFMA32(a, bv[0], S[3]); }
            __builtin_amdgcn_sched_barrier(0);
            { const bf16x8 a = rg3;
              S[3] = MFMA32(a, bv[1], S[3]); }
            __builtin_amdgcn_sched_barrier(0);
            { const bf16x8 a = rg4;
              S[3] = MFMA32(a, bv[2], S[3]); }
            __builtin_amdgcn_sched_barrier(0);
            { const bf16x8 a = rg5;
              S[3] = MFMA32(a, bv[3], S[3]); }
            __builtin_amdgcn_sched_barrier(0);
#undef HG_DECAY
#pragma unroll
            for (int m = 0; m < 2; ++m)
#pragma unroll
                for (int i = 0; i < 16; ++i) oraw[(row0 + 32 * m + (i & 3) + 8 * (i >> 2) + 4 * hg) * 512 + 128 * h + 32 * sl + r] = (bf16)f2bf(o[m][i]);
        }
    }
    __syncthreads();
}

__device__ __forceinline__ float softplus2(float x) { return x > 20.f ? x : log1pf(__expf(x)); }
#define MFMA16F(a, b, c) __builtin_amdgcn_mfma_f32_16x16x4f32((a), (b), (c), 0, 0, 0)
struct DnRaw { v4u q[3], k[3], v[3]; float a, bl; };
__device__ __forceinline__ void dn_raw_load(DnRaw& r, Frame& F, int unit, int tid, int lane) {
    const int h = unit & 3, n = (unit >> 2) & 127, b = unit >> 9; const size_t row0 = (size_t)b * SEQ + 64 * n;
    const bf16* P4 = (const bf16*)(F.ws + WS_P) + 4 * PLANE; const bf16* P5 = P4 + PLANE; const bf16* P6 = (const bf16*)(F.ws + WS_P) + 3 * PLANE;
#pragma unroll
    for (int i = 0; i < 3; ++i) { const int idx = tid + 512 * i, rr = idx >> 4, d8 = (idx & 15) * 8;
        v4u qv = (v4u){0u, 0u, 0u, 0u}, kv = qv, vv = qv;
        if (idx < 67 * 16 && 64 * n + rr >= 3) { const size_t off = (row0 + rr - 3) * 512 + 128 * h + d8; qv = *(const GAS v4u*)(P4 + off); kv = *(const GAS v4u*)(P5 + off); vv = *(const GAS v4u*)(P6 + off); }
        r.q[i] = qv; r.k[i] = kv; r.v[i] = vv; }
    const float* ab = (const float*)(F.ws + WS_AB);
    r.a = ab[(row0 + lane) * 8 + h]; r.bl = ab[(row0 + lane) * 8 + 4 + h];
}
__device__ __forceinline__ void prep_dn_unit(Frame& F, int l, int unit, const DnRaw& raw) {
    const int h = unit & 3, n = (unit >> 2) & 127, b = unit >> 9;
    const size_t row0 = (size_t)b * SEQ + 64 * n;
    LAS unsigned char* L = F.lds;
    LAS unsigned char* RQ = L; LAS unsigned char* RK = L + 17152; LAS unsigned char* RV = L + 34304;
    LAS float* AM = (LAS float*)L; LAS float* TM = (LAS float*)(L + 17408); LAS unsigned char* TB = L; LAS unsigned char* ATT = L + 34816;
    LAS unsigned char* QN = L + 51456; LAS unsigned char* KN = L + 68864; LAS unsigned char* QG = L + 86272; LAS unsigned char* WN = QN;
    LAS unsigned char* XT = L + 103680; LAS unsigned char* VT = L + 122112; LAS unsigned char* KDT = L + 140544;
    LAS float* GCA = (LAS float*)(L + 158976); LAS float* BEA = (LAS float*)(L + 159232);
    const bf16* P4 = (const bf16*)(F.ws + WS_P) + 4 * PLANE; const bf16* P5 = P4 + PLANE; const bf16* P6 = (const bf16*)(F.ws + WS_P) + 3 * PLANE;
    const float* ab = (const float*)(F.ws + WS_AB);
    unsigned char* ub = F.ws + WS_DNB + (size_t)unit * DN_UNIT;
    const int w = F.wave; int lane = F.lane; asm volatile("" : "+v"(lane));
    const int d0 = 2 * lane, r = lane & 31, hg = lane >> 5;
#pragma unroll
    for (int i = 0; i < 3; ++i) { const int idx = F.tid + 512 * i, rr = idx >> 4, d8 = (idx & 15) * 8;
        if (idx < 67 * 16) { *(LAS v4u*)(RQ + rr * 256 + 2 * d8) = raw.q[i]; *(LAS v4u*)(RK + rr * 256 + 2 * d8) = raw.k[i]; *(LAS v4u*)(RV + rr * 256 + 2 * d8) = raw.v[i]; } }
    float gc, beta;
    { const float a = raw.a, bl = raw.bl;
      float x = -__expf(F.in[6][l * NHEAD + h]) * softplus2(a + F.in[7][l * NHEAD + h]);
#pragma unroll
      for (int o = 1; o < 64; o <<= 1) { const float y = __shfl_up(x, o); if (lane >= o) x += y; }
      gc = x; beta = sigmf(bl);
      if (w == 0) { GCA[lane] = gc; BEA[lane] = beta; } }
    const float glast = __shfl(gc, 63);
    __syncthreads();
    {
        const float* cw = F.in[5] + (size_t)l * CONVW * CONVC + 128 * h + d0;
        float cwq[4][2], cwk[4][2], cwv[4][2];
#pragma unroll
        for (int j = 0; j < 4; ++j) { cwq[j][0] = cw[j * CONVC]; cwq[j][1] = cw[j * CONVC + 1]; cwk[j][0] = cw[j * CONVC + 512]; cwk[j][1] = cw[j * CONVC + 513]; cwv[j][0] = cw[j * CONVC + 1024]; cwv[j][1] = cw[j * CONVC + 1025]; }
        unsigned rq[11], rk[11], rv[11];
#pragma unroll
        for (int i = 0; i < 11; ++i) { rq[i] = *(const LAS unsigned*)(RQ + (8 * w + i) * 256 + 2 * d0); rk[i] = *(const LAS unsigned*)(RK + (8 * w + i) * 256 + 2 * d0); rv[i] = *(const LAS unsigned*)(RV + (8 * w + i) * 256 + 2 * d0); }
        unsigned xt[2][4], vt[2][4], kd[2][4];
#pragma unroll
        for (int i = 0; i < 8; ++i) {
            float cq[2] = {0.f, 0.f}, ck[2] = {0.f, 0.f}, cv[2] = {0.f, 0.f};
#pragma unroll
            for (int j = 0; j < 4; ++j) { cq[0] += cwq[j][0] * bflo(rq[i + j]); cq[1] += cwq[j][1] * bfhi(rq[i + j]); ck[0] += cwk[j][0] * bflo(rk[i + j]); ck[1] += cwk[j][1] * bfhi(rk[i + j]);
                cv[0] += cwv[j][0] * bflo(rv[i + j]); cv[1] += cwv[j][1] * bfhi(rv[i + j]); }
#pragma unroll
            for (int e = 0; e < 2; ++e) { cq[e] *= sigmf(cq[e]); ck[e] *= sigmf(ck[e]); cv[e] *= sigmf(cv[e]); }
            const float sq = wave_sum(cq[0] * cq[0] + cq[1] * cq[1]), sk = wave_sum(ck[0] * ck[0] + ck[1] * ck[1]);
            const float rqn = __builtin_amdgcn_rsqf(sq + EPSF) * 0.08838834764831845f, rkn = __builtin_amdgcn_rsqf(sk + EPSF);
            const int t = 8 * w + i;
            const float gci = __shfl(gc, t), bei = __shfl(beta, t);
            const float eg = __expf(gci), ed = __expf(glast - gci);
            const float q0 = cq[0] * rqn, q1 = cq[1] * rqn, k0 = ck[0] * rkn, k1 = ck[1] * rkn;
            *(LAS unsigned*)(QN + t * PQ + 2 * d0) = pk2(q0, q1); *(LAS unsigned*)(KN + t * PQ + 2 * d0) = pk2(k0, k1); *(LAS unsigned*)(QG + t * PQ + 2 * d0) = pk2(q0 * eg, q1 * eg);
            const unsigned x0 = f2bf(k0 * bei * eg), x1 = f2bf(k1 * bei * eg), v0 = f2bf(cv[0] * bei), v1 = f2bf(cv[1] * bei), e0 = f2bf(k0 * ed), e1 = f2bf(k1 * ed);
            if (i & 1) { xt[0][i >> 1] |= x0 << 16; xt[1][i >> 1] |= x1 << 16; vt[0][i >> 1] |= v0 << 16; vt[1][i >> 1] |= v1 << 16; kd[0][i >> 1] |= e0 << 16; kd[1][i >> 1] |= e1 << 16; }
            else { xt[0][i >> 1] = x0; xt[1][i >> 1] = x1; vt[0][i >> 1] = v0; vt[1][i >> 1] = v1; kd[0][i >> 1] = e0; kd[1][i >> 1] = e1; }
        }
#pragma unroll
        for (int e = 0; e < 2; ++e) {
            *(LAS v4u*)(XT + (d0 + e) * PT + 16 * w) = (v4u){xt[e][0], xt[e][1], xt[e][2], xt[e][3]};
            *(LAS v4u*)(VT + (d0 + e) * PT + 16 * w) = (v4u){vt[e][0], vt[e][1], vt[e][2], vt[e][3]};
            *(LAS v4u*)(KDT + (d0 + e) * PT + 16 * w) = (v4u){kd[e][0], kd[e][1], kd[e][2], kd[e][3]}; }
    }
    __syncthreads();
    if (w < 6) {
        const int tsel = w % 3, m = tsel >= 1 ? 1 : 0, mp = tsel == 2 ? 1 : 0;
        const LAS unsigned char* Asrc = w < 3 ? KN : QN;
        f32x16 acc = zero16();
#pragma unroll
        for (int ks = 0; ks < 8; ++ks) acc = MFMA32(lds_frag(Asrc + (32 * m + r) * PQ + 32 * ks + 16 * hg), lds_frag(KN + (32 * mp + r) * PQ + 32 * ks + 16 * hg), acc);
        const int jj = 32 * mp + r; const float gj = GCA[jj];
#pragma unroll
        for (int i = 0; i < 16; ++i) { const int ii = 32 * m + (i & 3) + 8 * (i >> 2) + 4 * hg; const float gi = GCA[ii];
            const float bei = BEA[ii], ex = __expf(fminf(gi - gj, 0.f));
            const float va = (jj < ii ? 1.f : 0.f) * (acc[i] * bei * ex), vq = (jj <= ii ? 1.f : 0.f) * (acc[i] * ex);
            if (w < 3) AM[ii * 68 + jj] = va; else *(LAS bf16*)(ATT + ii * PT + 2 * jj) = (bf16)f2bf(vq); }
    } else if (w == 6) {
#pragma unroll
        for (int i = 0; i < 16; ++i) *(LAS bf16*)(ATT + (2 * i + hg) * PT + 2 * (32 + r)) = 0;
    }
    __syncthreads();
    if (w == 0) {
        const int kb = lane >> 4, c = lane & 15;
        float x[16];
#pragma unroll
        for (int i = 0; i < 16; ++i) { float s = (i == c) ? 1.f : 0.f;
#pragma unroll
            for (int j4 = 0; j4 < (i + 3) / 4; ++j4) { const f32x4 a = *(const LAS f32x4*)(AM + (16 * kb + i) * 68 + 16 * kb + 4 * j4);
#pragma unroll
                for (int e = 0; e < 4; ++e) if (4 * j4 + e < i) s -= a[e] * x[4 * j4 + e]; }
            x[i] = s; }
#pragma unroll
        for (int i = 0; i < 16; ++i) TM[(16 * kb + i) * 68 + 16 * kb + c] = x[i];
    }
    __syncthreads();
#pragma unroll
    for (int lev = 1; lev <= 3; ++lev) {
        if (w < 4 - lev) { const int bi = w + lev, bk = w; const int li = lane & 15, lq = lane >> 4;
            f32x4 Mx = (f32x4){0.f, 0.f, 0.f, 0.f};
            for (int bj = bk; bj < bi; ++bj)
#pragma unroll
                for (int ks = 0; ks < 4; ++ks) Mx = MFMA16F(AM[(16 * bi + li) * 68 + 16 * bj + 4 * ks + lq], TM[(16 * bj + 4 * ks + lq) * 68 + 16 * bk + li], Mx);
            f32x4 Tx = (f32x4){0.f, 0.f, 0.f, 0.f};
#pragma unroll
            for (int e = 0; e < 4; ++e) Tx = MFMA16F(TM[(16 * bi + li) * 68 + 16 * bi + 4 * lq + e], Mx[e], Tx);
#pragma unroll
            for (int e = 0; e < 4; ++e) TM[(16 * bi + 4 * lq + e) * 68 + 16 * bk + li] = -Tx[e];
        }
        __syncthreads();
    }
    { float tv[8];
#pragma unroll
      for (int i = 0; i < 8; ++i) { const int idx = F.tid + 512 * i, ii = idx >> 6, jj = idx & 63; tv[i] = (jj >> 4) > (ii >> 4) ? 0.f : TM[ii * 68 + jj]; }
      __syncthreads();
#pragma unroll
      for (int i = 0; i < 8; ++i) { const int idx = F.tid + 512 * i, ii = idx >> 6, jj = idx & 63; *(LAS bf16*)(TB + ii * PT + 2 * jj) = (bf16)f2bf(tv[i]); } }
    __syncthreads();
    {
        const int nt = w & 3; const LAS unsigned char* Bsrc = w < 4 ? XT : VT;
        f32x16 acc[2] = {zero16(), zero16()};
#pragma unroll
        for (int ks = 0; ks < 4; ++ks) { const bf16x8 bfr = lds_frag(Bsrc + (32 * nt + r) * PT + 32 * ks + 16 * hg);
            if (ks < 2) acc[0] = MFMA32(lds_frag(TB + r * PT + 32 * ks + 16 * hg), bfr, acc[0]);
            acc[1] = MFMA32(lds_frag(TB + (32 + r) * PT + 32 * ks + 16 * hg), bfr, acc[1]); }
        if (w < 4) {
#pragma unroll
            for (int m = 0; m < 2; ++m)
#pragma unroll
                for (int i = 0; i < 16; ++i) *(LAS bf16*)(WN + (32 * m + (i & 3) + 8 * (i >> 2) + 4 * hg) * PQ + 2 * (32 * nt + r)) = (bf16)f2bf(-acc[m][i]);
        } else {
#pragma unroll
            for (int m = 0; m < 2; ++m) { v4u o0, o1;
                o0.x = pk2(acc[m][0], acc[m][1]); o0.y = pk2(acc[m][2], acc[m][3]); o0.z = pk2(acc[m][4], acc[m][5]); o0.w = pk2(acc[m][6], acc[m][7]);
                o1.x = pk2(acc[m][8], acc[m][9]); o1.y = pk2(acc[m][10], acc[m][11]); o1.z = pk2(acc[m][12], acc[m][13]); o1.w = pk2(acc[m][14], acc[m][15]);
                GAS v4u* dst = (GAS v4u*)(ub + 58368 + nt * 4096 + m * 2048 + lane * 32); dst[0] = o0; dst[1] = o1; }
        }
    }
    __syncthreads();
#pragma unroll
    for (int i = 0; i < 2; ++i) { const int f = w + 8 * i, m = f >> 3, kt = f & 7;
        { const LAS unsigned char* src = WN + (32 * m + r) * PQ + 2 * (16 * kt + 4 * hg); const v2u a = *(const LAS v2u*)src, c = *(const LAS v2u*)(src + 16);
          *(GAS v4u*)(ub + f * 1024 + lane * 16) = (v4u){a.x, a.y, c.x, c.y}; }
        { const LAS unsigned char* src = QG + (32 * m + r) * PQ + 2 * (16 * kt + 4 * hg); const v2u a = *(const LAS v2u*)src, c = *(const LAS v2u*)(src + 16);
          *(GAS v4u*)(ub + 16384 + f * 1024 + lane * 16) = (v4u){a.x, a.y, c.x, c.y}; } }
#pragma unroll
    for (int i = 0; i < 2; ++i) { const int f = w + 8 * i, t4 = f >> 2, ktp = f & 3;
        const LAS unsigned char* src = KDT + (32 * t4 + r) * PT + 2 * (16 * ktp + 4 * hg); const v2u a = *(const LAS v2u*)src, c = *(const LAS v2u*)(src + 16);
        *(GAS v4u*)(ub + 32768 + f * 1024 + lane * 16) = (v4u){a.x, a.y, c.x, c.y}; }
    { const int f = w, m = f >> 2, ktp = f & 3;
        const LAS unsigned char* src = ATT + (32 * m + r) * PT + 2 * (16 * ktp + 4 * hg); const v2u a = *(const LAS v2u*)src, c = *(const LAS v2u*)(src + 16);
        *(GAS v4u*)(ub + 49152 + f * 1024 + lane * 16) = (v4u){a.x, a.y, c.x, c.y}; }
    if (F.tid == 0) *(GAS float*)(ub + 57344) = __expf(glast);
    __syncthreads();
}

__device__ __forceinline__ void scan_dn_chain(Frame& F, int bh, int sl0) {
    const int sl = sl0 + (F.wave & 1);
    const int b = bh >> 2, h = bh & 3;
    bf16* oraw = (bf16*)(F.ws + WS_ORAW) + PLANE;
    f32x16 S[4];
#pragma unroll
    for (int t = 0; t < 4; ++t) S[t] = zero16();
#define DN_ISSUE(nn, bufo) do { const int unit_ = (b * 128 + (nn)) * 4 + h; const unsigned char* ub_ = F.ws + WS_DNB + (size_t)unit_ * DN_UNIT; \
        for (int f = F.wave - 2; f < 65; f += 6) { const unsigned char* src = f < 57 ? ub_ + f * 1024 : ub_ + 58368 + (sl0 + ((f - 57) >> 2)) * 4096 + ((f - 57) & 3) * 1024; \
            __builtin_amdgcn_global_load_lds((const unsigned*)(src + lane * 16), (LAS unsigned*)(F.lds + (bufo) + f * 1024), 16, 0, 0); } } while (0)
    { const int lane = F.lane; if (F.wave >= 2) DN_ISSUE(0, 0); }
    for (int n = 0; n < SEQ / 64; ++n) {
        int lane = F.lane; asm volatile("" : "+v"(lane));
        const int r = lane & 31, hg = lane >> 5;
        LAS unsigned char* L = F.lds + (n & 1) * 66560;
        if (F.wave >= 2) asm volatile("s_waitcnt vmcnt(0)" ::: "memory");
        __syncthreads();
        if (F.wave >= 2 && n + 1 < SEQ / 64) DN_ISSUE(n + 1, ((n + 1) & 1) * 66560);
        if (F.wave < 2) {
            const size_t row0 = (size_t)b * SEQ + 64 * n;
            const LAS unsigned char* Lp = L + lane * 16;
            bf16x8 bs[8];
#pragma unroll
            for (int kt = 0; kt < 8; ++kt) bs[kt] = pack_half(S[kt >> 1], kt & 1);
            f32x16 vn[2], o[2] = {zero16(), zero16()};
#pragma unroll
            for (int m = 0; m < 2; ++m) { const v4u u0 = *(const LAS v4u*)(L + 58368 + (F.wave & 1) * 4096 + m * 2048 + lane * 32), u1 = *(const LAS v4u*)(L + 58368 + (F.wave & 1) * 4096 + m * 2048 + lane * 32 + 16);
                vn[m][0] = bflo(u0.x); vn[m][1] = bfhi(u0.x); vn[m][2] = bflo(u0.y); vn[m][3] = bfhi(u0.y); vn[m][4] = bflo(u0.z); vn[m][5] = bfhi(u0.z); vn[m][6] = bflo(u0.w); vn[m][7] = bfhi(u0.w);
                vn[m][8] = bflo(u1.x); vn[m][9] = bfhi(u1.x); vn[m][10] = bflo(u1.y); vn[m][11] = bfhi(u1.y); vn[m][12] = bflo(u1.z); vn[m][13] = bfhi(u1.z); vn[m][14] = bflo(u1.w); vn[m][15] = bfhi(u1.w); }
            const float dl = *(const LAS float*)(L + 57344);
            bf16x8 bv[4];
            bf16x8 rg0 = lds_frag(Lp + 0);
            bf16x8 rg1 = lds_frag(Lp + 1024);
            bf16x8 rg2 = lds_frag(Lp + 2048);
            bf16x8 rg3 = lds_frag(Lp + 3072);
            bf16x8 rg4 = lds_frag(Lp + 4096);
            bf16x8 rg5 = lds_frag(Lp + 5120);
            bf16x8 rg6 = lds_frag(Lp + 6144);
            bf16x8 rg7 = lds_frag(Lp + 7168);
            { const bf16x8 a = rg0; rg0 = lds_frag(Lp + 8192);
              vn[0] = MFMA32(a, bs[0], vn[0]); }
            __builtin_amdgcn_sched_barrier(0);
            { const bf16x8 a = rg1; rg1 = lds_frag(Lp + 9216);
              vn[0] = MFMA32(a, bs[1], vn[0]); }
            __builtin_amdgcn_sched_barrier(0);
            { const bf16x8 a = rg2; rg2 = lds_frag(Lp + 10240);
              vn[0] = MFMA32(a, bs[2], vn[0]); }
            __builtin_amdgcn_sched_barrier(0);
            { const bf16x8 a = rg3; rg3 = lds_frag(Lp + 11264);
              vn[0] = MFMA32(a, bs[3], vn[0]); }
            __builtin_amdgcn_sched_barrier(0);
            { const bf16x8 a = rg4; rg4 = lds_frag(Lp + 12288);
              vn[0] = MFMA32(a, bs[4], vn[0]); }
            __builtin_amdgcn_sched_barrier(0);
            { const bf16x8 a = rg5; rg5 = lds_frag(Lp + 13312);
              vn[0] = MFMA32(a, bs[5], vn[0]); }
            __builtin_amdgcn_sched_barrier(0);
            { const bf16x8 a = rg6; rg6 = lds_frag(Lp + 14336);
              vn[0] = MFMA32(a, bs[6], vn[0]); }
            __builtin_amdgcn_sched_barrier(0);
            { const bf16x8 a = rg7; rg7 = lds_frag(Lp + 15360);
              vn[0] = MFMA32(a, bs[7], vn[0]); }
            __builtin_amdgcn_sched_barrier(0);
            { const bf16x8 a = rg0; rg0 = lds_frag(Lp + 16384);
              vn[1] = MFMA32(a, bs[0], vn[1]); }
            __builtin_amdgcn_sched_barrier(0);
            { const bf16x8 a = rg1; rg1 = lds_frag(Lp + 17408);
              vn[1] = MFMA32(a, bs[1], vn[1]); }
            __builtin_amdgcn_sched_barrier(0);
            { const bf16x8 a = rg2; rg2 = lds_frag(Lp + 18432);
              vn[1] = MFMA32(a, bs[2], vn[1]); }
            __builtin_amdgcn_sched_barrier(0);
            { const bf16x8 a = rg3; rg3 = lds_frag(Lp + 19456);
              vn[1] = MFMA32(a, bs[3], vn[1]); }
            __builtin_amdgcn_sched_barrier(0);
            { const bf16x8 a = rg4; rg4 = lds_frag(Lp + 20480);
              vn[1] = MFMA32(a, bs[4], vn[1]); }
            __builtin_amdgcn_sched_barrier(0);
            { const bf16x8 a = rg5; rg5 = lds_frag(Lp + 21504);
              vn[1] = MFMA32(a, bs[5], vn[1]); }
            __builtin_amdgcn_sched_barrier(0);
            { const bf16x8 a = rg6; rg6 = lds_frag(Lp + 22528);
              vn[1] = MFMA32(a, bs[6], vn[1]); }
            __builtin_amdgcn_sched_barrier(0);
            { const bf16x8 a = rg7; rg7 = lds_frag(Lp + 23552);
              vn[1] = MFMA32(a, bs[7], vn[1]); }
            __builtin_amdgcn_sched_barrier(0);
            { const bf16x8 a = rg0; rg0 = lds_frag(Lp + 24576);
              o[0] = MFMA32(a, bs[0], o[0]); }
            __builtin_amdgcn_sched_barrier(0);
            { const bf16x8 a = rg1; rg1 = lds_frag(Lp + 25600);
              o[0] = MFMA32(a, bs[1], o[0]); }
            __builtin_amdgcn_sched_barrier(0);
            { const bf16x8 a = rg2; rg2 = lds_frag(Lp + 26624);
              o[0] = MFMA32(a, bs[2], o[0]); }
            __builtin_amdgcn_sched_barrier(0);
            { const bf16x8 a = rg3; rg3 = lds_frag(Lp + 27648);
              o[0] = MFMA32(a, bs[3], o[0]); }
            __builtin_amdgcn_sched_barrier(0);
            { const bf16x8 a = rg4; rg4 = lds_frag(Lp + 28672);
              o[0] = MFMA32(a, bs[4], o[0]); }
            __builtin_amdgcn_sched_barrier(0);
            { const bf16x8 a = rg5; rg5 = lds_frag(Lp + 29696);
              o[0] = MFMA32(a, bs[5], o[0]); }
            __builtin_amdgcn_sched_barrier(0);
            { const bf16x8 a = rg6; rg6 = lds_frag(Lp + 30720);
              o[0] = MFMA32(a, bs[6], o[0]); }
            __builtin_amdgcn_sched_barrier(0);
            { const bf16x8 a = rg7; rg7 = lds_frag(Lp + 31744);
              o[0] = MFMA32(a, bs[7], o[0]); }
            __builtin_amdgcn_sched_barrier(0);
            { const bf16x8 a = rg0; rg0 = lds_frag(Lp + 49152);
              o[1] = MFMA32(a, bs[0], o[1]); }
            __builtin_amdgcn_sched_barrier(0);
            { const bf16x8 a = rg1; rg1 = lds_frag(Lp + 50176);
              o[1] = MFMA32(a, bs[1], o[1]); }
            __builtin_amdgcn_sched_barrier(0);
            { const bf16x8 a = rg2; rg2 = lds_frag(Lp + 53248);
              o[1] = MFMA32(a, bs[2], o[1]); }
            __builtin_amdgcn_sched_barrier(0);
            { const bf16x8 a = rg3; rg3 = lds_frag(Lp + 54272);
              o[1] = MFMA32(a, bs[3], o[1]); }
            __builtin_amdgcn_sched_barrier(0);
            { const bf16x8 a = rg4; rg4 = lds_frag(Lp + 55296);
              o[1] = MFMA32(a, bs[4], o[1]); }
            __builtin_amdgcn_sched_barrier(0);
            { const bf16x8 a = rg5; rg5 = lds_frag(Lp + 56320);
              o[1] = MFMA32(a, bs[5], o[1]); }
            __builtin_amdgcn_sched_barrier(0);
            { const bf16x8 a = rg6; rg6 = lds_frag(Lp + 32768);
              o[1] = MFMA32(a, bs[6], o[1]); }
            __builtin_amdgcn_sched_barrier(0);
            { const bf16x8 a = rg7; rg7 = lds_frag(Lp + 33792);
              o[1] = MFMA32(a, bs[7], o[1]); }
            __builtin_amdgcn_sched_barrier(0);
            { const bf16x8 a = rg0; rg0 = lds_frag(Lp + 34816);
              bv[0] = pack_half(vn[0], 0); bv[1] = pack_half(vn[0], 1); bv[2] = pack_half(vn[1], 0); bv[3] = pack_half(vn[1], 1);
              o[0] = MFMA32(a, bv[0], o[0]); }
            __builtin_amdgcn_sched_barrier(0);
            { const bf16x8 a = rg1; rg1 = lds_frag(Lp + 35840);
              o[0] = MFMA32(a, bv[1], o[0]); }
            __builtin_amdgcn_sched_barrier(0);
            { const bf16x8 a = rg2; rg2 = lds_frag(Lp + 36864);
              o[1] = MFMA32(a, bv[0], o[1]); }
            __builtin_amdgcn_sched_barrier(0);
            { const bf16x8 a = rg3; rg3 = lds_frag(Lp + 37888);
              o[1] = MFMA32(a, bv[1], o[1]); }
            __builtin_amdgcn_sched_barrier(0);
            { const bf16x8 a = rg4; rg4 = lds_frag(Lp + 38912);
              o[1] = MFMA32(a, bv[2], o[1]); }
            __builtin_amdgcn_sched_barrier(0);
            { const bf16x8 a = rg5; rg5 = lds_frag(Lp + 39936);
              o[1] = MFMA32(a, bv[3], o[1]); }
            __builtin_amdgcn_sched_barrier(0);
            { const bf16x8 a = rg6; rg6 = lds_frag(Lp + 40960);
              S[0] = S[0] * dl;
              S[0] = MFMA32(a, bv[0], S[0]); }
            __builtin_amdgcn_sched_barrier(0);
            { const bf16x8 a = rg7; rg7 = lds_frag(Lp + 41984);
              S[0] = MFMA32(a, bv[1], S[0]); }
            __builtin_amdgcn_sched_barrier(0);
            { const bf16x8 a = rg0; rg0 = lds_frag(Lp + 43008);
              S[0] = MFMA32(a, bv[2], S[0]); }
            __builtin_amdgcn_sched_barrier(0);
            { const bf16x8 a = rg1; rg1 = lds_frag(Lp + 44032);
              S[0] = MFMA32(a, bv[3], S[0]); }
            __builtin_amdgcn_sched_barrier(0);
            { const bf16x8 a = rg2; rg2 = lds_frag(Lp + 45056);
              S[1] = S[1] * dl;
              S[1] = MFMA32(a, bv[0], S[1]); }
            __builtin_amdgcn_sched_barrier(0);
            { const bf16x8 a = rg3; rg3 = lds_frag(Lp + 46080);
              S[1] = MFMA32(a, bv[1], S[1]); }
            __builtin_amdgcn_sched_barrier(0);
            { const bf16x8 a = rg4; rg4 = lds_frag(Lp + 47104);
              S[1] = MFMA32(a, bv[2], S[1]); }
            __builtin_amdgcn_sched_barrier(0);
            { const bf16x8 a = rg5; rg5 = lds_frag(Lp + 48128);
              S[1] = MFMA32(a, bv[3], S[1]); }
            __builtin_amdgcn_sched_barrier(0);
            { const bf16x8 a = rg6;
              S[2] = S[2] * dl;
              S[2] = MFMA32(a, bv[0], S[2]); }
            __builtin_amdgcn_sched_barrier(0);
            { const bf16x8 a = rg7;
              S[2] = MFMA32(a, bv[1], S[2]); }
            __builtin_amdgcn_sched_barrier(0);
            { const bf16x8 a = rg0;
              S[2] = MFMA32(a, bv[2], S[2]); }
            __builtin_amdgcn_sched_barrier(0);
            { const bf16x8 a = rg1;
              S[2] = MFMA32(a, bv[3], S[2]); }
            __builtin_amdgcn_sched_barrier(0);
            { const bf16x8 a = rg2;
              S[3] = S[3] * dl;
              S[3] = MFMA32(a, bv[0], S[3]); }
            __builtin_amdgcn_sched_barrier(0);
            { const bf16x8 a = rg3;
              S[3] = MFMA32(a, bv[1], S[3]); }
            __builtin_amdgcn_sched_barrier(0);
            { const bf16x8 a = rg4;
              S[3] = MFMA32(a, bv[2], S[3]); }
            __builtin_amdgcn_sched_barrier(0);
            { const bf16x8 a = rg5;
              S[3] = MFMA32(a, bv[3], S[3]); }
            __builtin_amdgcn_sched_barrier(0);
#pragma unroll
            for (int m = 0; m < 2; ++m)
#pragma unroll
                for (int i = 0; i < 16; ++i) oraw[(row0 + 32 * m + (i & 3) + 8 * (i >> 2) + 4 * hg) * 512 + 128 * h + 32 * sl + r] = (bf16)f2bf(o[m][i]);
        }
    }
    __syncthreads();
}

constexpr int OST4 = 145408;

__device__ __forceinline__ void post4_chunk(Frame& F, const bf16* gplane, bf16* ocat, const float* nwp, size_t row0, int h, int lane) {
    const int pw = F.wave - 6, d8 = 8 * (lane & 15);
    float nw[8];
    { const f32x4 a = *(const GAS f32x4*)(nwp + d8), c = *(const GAS f32x4*)(nwp + d8 + 4); nw[0] = a.x; nw[1] = a.y; nw[2] = a.z; nw[3] = a.w; nw[4] = c.x; nw[5] = c.y; nw[6] = c.z; nw[7] = c.w; }
#pragma unroll
    for (int hf = 0; hf < 2; ++hf) {
    v4u gv[8];
#pragma unroll
    for (int it = 4 * hf; it < 4 * hf + 4; ++it) { const int t = 8 * it + 4 * pw + (lane >> 4); gv[it] = *(const GAS v4u*)(gplane + (row0 + t) * 512 + 128 * h + d8); }
#pragma unroll
    for (int it = 4 * hf; it < 4 * hf + 4; ++it) { const int t = 8 * it + 4 * pw + (lane >> 4);
        const v4u ov = *(const LAS v4u*)(F.lds + OST4 + t * 256 + 2 * d8);
        const float o[8] = {bflo(ov.x), bfhi(ov.x), bflo(ov.y), bfhi(ov.y), bflo(ov.z), bfhi(ov.z), bflo(ov.w), bfhi(ov.w)};
        const float g[8] = {bflo(gv[it].x), bfhi(gv[it].x), bflo(gv[it].y), bfhi(gv[it].y), bflo(gv[it].z), bfhi(gv[it].z), bflo(gv[it].w), bfhi(gv[it].w)};
        float s = 0.f;
#pragma unroll
        for (int j = 0; j < 8; ++j) s += o[j] * o[j];
        s += __builtin_bit_cast(float, __builtin_amdgcn_update_dpp(0, __builtin_bit_cast(int, s), 0xB1, 0xF, 0xF, true));
        s += __builtin_bit_cast(float, __builtin_amdgcn_update_dpp(0, __builtin_bit_cast(int, s), 0x4E, 0xF, 0xF, true));
        s += __builtin_bit_cast(float, __builtin_amdgcn_update_dpp(0, __builtin_bit_cast(int, s), 0x141, 0xF, 0xF, true));
        s += __builtin_bit_cast(float, __builtin_amdgcn_update_dpp(0, __builtin_bit_cast(int, s), 0x140, 0xF, 0xF, true));
        const float rs = __builtin_amdgcn_rsqf(s * (1.f / HDIM) + EPSF);
        float q[8];
#pragma unroll
        for (int j = 0; j < 8; ++j) q[j] = o[j] * rs * nw[j] * (g[j] * sigmf(g[j]));
        *(GAS v4u*)(ocat + (row0 + t) * 512 + 128 * h + d8) = (v4u){pk2(q[0], q[1]), pk2(q[2], q[3]), pk2(q[4], q[5]), pk2(q[6], q[7])}; }
    }
}

__device__ __forceinline__ void scan4_hg(Frame& F, int l, int bh) {
    const int b = bh >> 2, h = bh & 3;
#define ISSUE4(nn, bufo) do { const int unit_ = (b * 128 + (nn)) * 4 + h; \
        const unsigned char* p1_ = (const unsigned char*)F.out + 128 * MiB + (size_t)unit_ * HG1_UNIT; const unsigned char* p2_ = (const unsigned char*)F.out + (size_t)unit_ * HG2_UNIT; \
        for (int f = F.wave - 4; f < 57; f += 2) { const unsigned char* src = f < 32 ? p1_ + f * 1024 : p2_ + (f - 32) * 1024; \
            __builtin_amdgcn_global_load_lds((const unsigned*)(src + lane * 16), (LAS unsigned*)(F.lds + (bufo) + f * 1024), 16, 0, 0); } } while (0)
#define BAR_B1() do { asm volatile("s_waitcnt lgkmcnt(0)" ::: "memory"); __builtin_amdgcn_s_barrier(); asm volatile("" ::: "memory"); } while (0)
#define BAR_B2() do { asm volatile("s_waitcnt lgkmcnt(0)" ::: "memory"); __builtin_amdgcn_s_barrier(); asm volatile("" ::: "memory"); } while (0)
    if (F.wave < 4) {
        f32x16 S[4];
#pragma unroll
        for (int t = 0; t < 4; ++t) S[t] = zero16();
        for (int n = 0; n < SEQ / 64; ++n) {
            int lane = F.lane; asm volatile("" : "+v"(lane));
            const int r = lane & 31, hg = lane >> 5;
            LAS unsigned char* L = F.lds + (n & 1) * 72704;
            BAR_B1();
            const LAS unsigned char* Lp = L + lane * 16;
            bf16x8 bs[8];
#pragma unroll
            for (int kt = 0; kt < 8; ++kt) bs[kt] = pack_half(S[kt >> 1], kt & 1);
            bf16x8 bv[4];
#pragma unroll
            for (int kt = 0; kt < 4; ++kt) bv[kt] = lds_frag(Lp + 41984 + F.wave * 4096 + kt * 1024);
            f32x16 o[2] = {zero16(), zero16()};
#define HG_DECAY(t4) do { _Pragma("unroll") for (int g = 0; g < 4; ++g) { const f32x4 dc = *(const LAS f32x4*)(L + 40960 + 4 * (32 * (t4) + 8 * g + 4 * hg)); \
                _Pragma("unroll") for (int e = 0; e < 4; ++e) S[t4][4 * g + e] *= dc[e]; } } while (0)
            bf16x8 rg0 = lds_frag(Lp + 0);
            bf16x8 rg1 = lds_frag(Lp + 1024);
            bf16x8 rg2 = lds_frag(Lp + 2048);
            bf16x8 rg3 = lds_frag(Lp + 3072);
            bf16x8 rg4 = lds_frag(Lp + 4096);
            bf16x8 rg5 = lds_frag(Lp + 5120);
            bf16x8 rg6 = lds_frag(Lp + 6144);
            bf16x8 rg7 = lds_frag(Lp + 7168);
            { const bf16x8 a = rg0; rg0 = lds_frag(Lp + 8192);
              o[0] = MFMA32(a, bs[0], o[0]);
            }
            __builtin_amdgcn_sched_barrier(0);
            { const bf16x8 a = rg1; rg1 = lds_frag(Lp + 9216);
              o[0] = MFMA32(a, bs[1], o[0]);
            }
            __builtin_amdgcn_sched_barrier(0);
            { const bf16x8 a = rg2; rg2 = lds_frag(Lp + 10240);
              o[0] = MFMA32(a, bs[2], o[0]);
            }
            __builtin_amdgcn_sched_barrier(0);
            { const bf16x8 a = rg3; rg3 = lds_frag(Lp + 11264);
              o[0] = MFMA32(a, bs[3], o[0]);
            }
            __builtin_amdgcn_sched_barrier(0);
            { const bf16x8 a = rg4; rg4 = lds_frag(Lp + 12288);
              o[0] = MFMA32(a, bs[4], o[0]);
            }
            __builtin_amdgcn_sched_barrier(0);
            { const bf16x8 a = rg5; rg5 = lds_frag(Lp + 13312);
              o[0] = MFMA32(a, bs[5], o[0]);
            }
            __builtin_amdgcn_sched_barrier(0);
            { const bf16x8 a = rg6; rg6 = lds_frag(Lp + 14336);
              o[0] = MFMA32(a, bs[6], o[0]);
            }
            __builtin_amdgcn_sched_barrier(0);
            { const bf16x8 a = rg7; rg7 = lds_frag(Lp + 15360);
              o[0] = MFMA32(a, bs[7], o[0]);
            }
            __builtin_amdgcn_sched_barrier(0);
            { const bf16x8 a = rg0; rg0 = lds_frag(Lp + 32768);
              o[1] = MFMA32(a, bs[0], o[1]);
            }
            __builtin_amdgcn_sched_barrier(0);
            { const bf16x8 a = rg1; rg1 = lds_frag(Lp + 33792);
              o[1] = MFMA32(a, bs[1], o[1]);
            }
            __builtin_amdgcn_sched_barrier(0);
            { const bf16x8 a = rg2; rg2 = lds_frag(Lp + 36864);
              o[1] = MFMA32(a, bs[2], o[1]);
            }
            __builtin_amdgcn_sched_barrier(0);
            { const bf16x8 a = rg3; rg3 = lds_frag(Lp + 37888);
              o[1] = MFMA32(a, bs[3], o[1]);
            }
            __builtin_amdgcn_sched_barrier(0);
            { const bf16x8 a = rg4; rg4 = lds_frag(Lp + 38912);
              o[1] = MFMA32(a, bs[4], o[1]);
            }
            __builtin_amdgcn_sched_barrier(0);
            { const bf16x8 a = rg5; rg5 = lds_frag(Lp + 39936);
              o[1] = MFMA32(a, bs[5], o[1]);
            }
            __builtin_amdgcn_sched_barrier(0);
            { const bf16x8 a = rg6; rg6 = lds_frag(Lp + 16384);
              o[1] = MFMA32(a, bs[6], o[1]);
            }
            __builtin_amdgcn_sched_barrier(0);
            { const bf16x8 a = rg7; rg7 = lds_frag(Lp + 17408);
              o[1] = MFMA32(a, bs[7], o[1]);
            }
            __builtin_amdgcn_sched_barrier(0);
            { const bf16x8 a = rg0; rg0 = lds_frag(Lp + 18432);
              o[0] = MFMA32(a, bv[0], o[0]);
            }
            __builtin_amdgcn_sched_barrier(0);
            { const bf16x8 a = rg1; rg1 = lds_frag(Lp + 19456);
              o[0] = MFMA32(a, bv[1], o[0]);
            }
            __builtin_amdgcn_sched_barrier(0);
            { const bf16x8 a = rg2; rg2 = lds_frag(Lp + 20480);
              o[1] = MFMA32(a, bv[0], o[1]);
            }
            __builtin_amdgcn_sched_barrier(0);
            { const bf16x8 a = rg3; rg3 = lds_frag(Lp + 21504);
              o[1] = MFMA32(a, bv[1], o[1]);
            }
            __builtin_amdgcn_sched_barrier(0);
            { const bf16x8 a = rg4; rg4 = lds_frag(Lp + 22528);
              o[1] = MFMA32(a, bv[2], o[1]);
            }
            __builtin_amdgcn_sched_barrier(0);
            { const bf16x8 a = rg5; rg5 = lds_frag(Lp + 23552);
              o[1] = MFMA32(a, bv[3], o[1]);
            }
            __builtin_amdgcn_sched_barrier(0);
            { const bf16x8 a = rg6; rg6 = lds_frag(Lp + 24576);
              HG_DECAY(0);
              S[0] = MFMA32(a, bv[0], S[0]);
            }
            __builtin_amdgcn_sched_barrier(0);
            { const bf16x8 a = rg7; rg7 = lds_frag(Lp + 25600);
              S[0] = MFMA32(a, bv[1], S[0]);
            }
            __builtin_amdgcn_sched_barrier(0);
            { const bf16x8 a = rg0; rg0 = lds_frag(Lp + 26624);
              S[0] = MFMA32(a, bv[2], S[0]);
            }
            __builtin_amdgcn_sched_barrier(0);
            { const bf16x8 a = rg1; rg1 = lds_frag(Lp + 27648);
              S[0] = MFMA32(a, bv[3], S[0]);
            }
            __builtin_amdgcn_sched_barrier(0);
            { const bf16x8 a = rg2; rg2 = lds_frag(Lp + 28672);
              HG_DECAY(1);
              S[1] = MFMA32(a, bv[0], S[1]);
            }
            __builtin_amdgcn_sched_barrier(0);
            { const bf16x8 a = rg3; rg3 = lds_frag(Lp + 29696);
              S[1] = MFMA32(a, bv[1], S[1]);
            }
            __builtin_amdgcn_sched_barrier(0);
            { const bf16x8 a = rg4; rg4 = lds_frag(Lp + 30720);
              S[1] = MFMA32(a, bv[2], S[1]);
            }
            __builtin_amdgcn_sched_barrier(0);
            { const bf16x8 a = rg5; rg5 = lds_frag(Lp + 31744);
              S[1] = MFMA32(a, bv[3], S[1]);
            }
            __builtin_amdgcn_sched_barrier(0);
            { const bf16x8 a = rg6;
              HG_DECAY(2);
              S[2] = MFMA32(a, bv[0], S[2]);
            }
            __builtin_amdgcn_sched_barrier(0);
            { const bf16x8 a = rg7;
              S[2] = MFMA32(a, bv[1], S[2]);
            }
            __builtin_amdgcn_sched_barrier(0);
            { const bf16x8 a = rg0;
              S[2] = MFMA32(a, bv[2], S[2]);
            }
            __builtin_amdgcn_sched_barrier(0);
            { const bf16x8 a = rg1;
              S[2] = MFMA32(a, bv[3], S[2]);
            }
            __builtin_amdgcn_sched_barrier(0);
            { const bf16x8 a = rg2;
              HG_DECAY(3);
              S[3] = MFMA32(a, bv[0], S[3]);
            }
            __builtin_amdgcn_sched_barrier(0);
            { const bf16x8 a = rg3;
              S[3] = MFMA32(a, bv[1], S[3]);
            }
            __builtin_amdgcn_sched_barrier(0);
            { const bf16x8 a = rg4;
              S[3] = MFMA32(a, bv[2], S[3]);
            }
            __builtin_amdgcn_sched_barrier(0);
            { const bf16x8 a = rg5;
              S[3] = MFMA32(a, bv[3], S[3]);
            }
            __builtin_amdgcn_sched_barrier(0);
#undef HG_DECAY
            BAR_B2();
#pragma unroll
            for (int m = 0; m < 2; ++m)
#pragma unroll
                for (int i = 0; i < 16; ++i) *(LAS bf16*)(F.lds + OST4 + (32 * m + (i & 3) + 8 * (i >> 2) + 4 * hg) * 256 + 2 * (32 * F.wave + r)) = (bf16)f2bf(o[m][i]);
        }
    } else if (F.wave < 6) {
        { const int lane = F.lane; ISSUE4(0, 0); }
        for (int n = 0; n < SEQ / 64; ++n) {
            int lane = F.lane; asm volatile("" : "+v"(lane));
            asm volatile("s_waitcnt vmcnt(0)" ::: "memory");
            BAR_B1();
            if (n + 1 < SEQ / 64) ISSUE4(n + 1, ((n + 1) & 1) * 72704);
            asm volatile("" ::: "memory"); __builtin_amdgcn_s_barrier(); asm volatile("" ::: "memory");
        }
    } else {
        const bf16* gplane = (const bf16*)(F.ws + WS_P) + (size_t)6 * PLANE;
        bf16* ocat = (bf16*)(F.ws + WS_OCAT) + (size_t)0 * PLANE;
        const float* nw = F.in[4] + l * HDIM;
        for (int n = 0; n < SEQ / 64; ++n) {
            int lane = F.lane; asm volatile("" : "+v"(lane));
            BAR_B1();
            if (n > 0) post4_chunk(F, gplane, ocat, nw, (size_t)b * SEQ + 64 * (n - 1), h, lane);
            BAR_B2();
        }
    }
    BAR_B1();
    if (F.wave >= 6) { const bf16* gplane = (const bf16*)(F.ws + WS_P) + (size_t)6 * PLANE; bf16* ocat = (bf16*)(F.ws + WS_OCAT) + (size_t)0 * PLANE;
        post4_chunk(F, gplane, ocat, F.in[4] + l * HDIM, (size_t)b * SEQ + 64 * (SEQ / 64 - 1), h, F.lane); }
    __syncthreads();
#undef ISSUE4
#undef BAR_B1
#undef BAR_B2
}

__device__ __forceinline__ void scan4_dn(Frame& F, int l, int bh) {
    const int b = bh >> 2, h = bh & 3;
#define ISSUE4(nn, bufo) do { const int unit_ = (b * 128 + (nn)) * 4 + h; const unsigned char* ub_ = F.ws + WS_DNB + (size_t)unit_ * DN_UNIT; \
        for (int f = F.wave - 4; f < 71; f += 2) { const unsigned char* src = f < 48 ? ub_ + f * 1024 : (f < 54 ? ub_ + 49152 + ((f - 48) < 2 ? (f - 48) : (f - 46)) * 1024 : (f == 54 ? ub_ + 57344 : ub_ + 58368 + (f - 55) * 1024)); \
            __builtin_amdgcn_global_load_lds((const unsigned*)(src + lane * 16), (LAS unsigned*)(F.lds + (bufo) + f * 1024), 16, 0, 0); } } while (0)
#define BAR_B1() do { asm volatile("s_waitcnt lgkmcnt(0)" ::: "memory"); __builtin_amdgcn_s_barrier(); asm volatile("" ::: "memory"); } while (0)
#define BAR_B2() do { asm volatile("s_waitcnt lgkmcnt(0)" ::: "memory"); __builtin_amdgcn_s_barrier(); asm volatile("" ::: "memory"); } while (0)
    if (F.wave < 4) {
        f32x16 S[4];
#pragma unroll
        for (int t = 0; t < 4; ++t) S[t] = zero16();
        for (int n = 0; n < SEQ / 64; ++n) {
            int lane = F.lane; asm volatile("" : "+v"(lane));
            const int r = lane & 31, hg = lane >> 5;
            LAS unsigned char* L = F.lds + (n & 1) * 72704;
            BAR_B1();
            const LAS unsigned char* Lp = L + lane * 16;
            bf16x8 bs[8];
#pragma unroll
            for (int kt = 0; kt < 8; ++kt) bs[kt] = pack_half(S[kt >> 1], kt & 1);
            f32x16 vn[2], o[2] = {zero16(), zero16()};
#pragma unroll
            for (int m = 0; m < 2; ++m) { const v4u u0 = *(const LAS v4u*)(L + 56320 + F.wave * 4096 + m * 2048 + lane * 32), u1 = *(const LAS v4u*)(L + 56320 + F.wave * 4096 + m * 2048 + lane * 32 + 16);
                vn[m][0] = bflo(u0.x); vn[m][1] = bfhi(u0.x); vn[m][2] = bflo(u0.y); vn[m][3] = bfhi(u0.y); vn[m][4] = bflo(u0.z); vn[m][5] = bfhi(u0.z); vn[m][6] = bflo(u0.w); vn[m][7] = bfhi(u0.w);
                vn[m][8] = bflo(u1.x); vn[m][9] = bfhi(u1.x); vn[m][10] = bflo(u1.y); vn[m][11] = bfhi(u1.y); vn[m][12] = bflo(u1.z); vn[m][13] = bfhi(u1.z); vn[m][14] = bflo(u1.w); vn[m][15] = bfhi(u1.w); }
            const float dl = *(const LAS float*)(L + 55296);
            bf16x8 bv[4];
            bf16x8 rg0 = lds_frag(Lp + 0);
            bf16x8 rg1 = lds_frag(Lp + 1024);
            bf16x8 rg2 = lds_frag(Lp + 2048);
            bf16x8 rg3 = lds_frag(Lp + 3072);
            bf16x8 rg4 = lds_frag(Lp + 4096);
            bf16x8 rg5 = lds_frag(Lp + 5120);
            bf16x8 rg6 = lds_frag(Lp + 6144);
            bf16x8 rg7 = lds_frag(Lp + 7168);
            { const bf16x8 a = rg0; rg0 = lds_frag(Lp + 8192);
              vn[0] = MFMA32(a, bs[0], vn[0]);
            }
            __builtin_amdgcn_sched_barrier(0);
            { const bf16x8 a = rg1; rg1 = lds_frag(Lp + 9216);
              vn[0] = MFMA32(a, bs[1], vn[0]);
            }
            __builtin_amdgcn_sched_barrier(0);
            { const bf16x8 a = rg2; rg2 = lds_frag(Lp + 10240);
              vn[0] = MFMA32(a, bs[2], vn[0]);
            }
            __builtin_amdgcn_sched_barrier(0);
            { const bf16x8 a = rg3; rg3 = lds_frag(Lp + 11264);
              vn[0] = MFMA32(a, bs[3], vn[0]);
            }
            __builtin_amdgcn_sched_barrier(0);
            { const bf16x8 a = rg4; rg4 = lds_frag(Lp + 12288);
              vn[0] = MFMA32(a, bs[4], vn[0]);
            }
            __builtin_amdgcn_sched_barrier(0);
            { const bf16x8 a = rg5; rg5 = lds_frag(Lp + 13312);
              vn[0] = MFMA32(a, bs[5], vn[0]);
            }
            __builtin_amdgcn_sched_barrier(0);
            { const bf16x8 a = rg6; rg6 = lds_frag(Lp + 14336);
              vn[0] = MFMA32(a, bs[6], vn[0]);
            }
            __builtin_amdgcn_sched_barrier(0);
            { const bf16x8 a = rg7; rg7 = lds_frag(Lp + 15360);
              vn[0] = MFMA32(a, bs[7], vn[0]);
            }
            __builtin_amdgcn_sched_barrier(0);
            { const bf16x8 a = rg0; rg0 = lds_frag(Lp + 16384);
              vn[1] = MFMA32(a, bs[0], vn[1]);
            }
            __builtin_amdgcn_sched_barrier(0);
            { const bf16x8 a = rg1; rg1 = lds_frag(Lp + 17408);
              vn[1] = MFMA32(a, bs[1], vn[1]);
            }
            __builtin_amdgcn_sched_barrier(0);
            { const bf16x8 a = rg2; rg2 = lds_frag(Lp + 18432);
              vn[1] = MFMA32(a, bs[2], vn[1]);
            }
            __builtin_amdgcn_sched_barrier(0);
            { const bf16x8 a = rg3; rg3 = lds_frag(Lp + 19456);
              vn[1] = MFMA32(a, bs[3], vn[1]);
            }
            __builtin_amdgcn_sched_barrier(0);
            { const bf16x8 a = rg4; rg4 = lds_frag(Lp + 20480);
              vn[1] = MFMA32(a, bs[4], vn[1]);
            }
            __builtin_amdgcn_sched_barrier(0);
            { const bf16x8 a = rg5; rg5 = lds_frag(Lp + 21504);
              vn[1] = MFMA32(a, bs[5], vn[1]);
            }
            __builtin_amdgcn_sched_barrier(0);
            { const bf16x8 a = rg6; rg6 = lds_frag(Lp + 22528);
              vn[1] = MFMA32(a, bs[6], vn[1]);
            }
            __builtin_amdgcn_sched_barrier(0);
            { const bf16x8 a = rg7; rg7 = lds_frag(Lp + 23552);
              vn[1] = MFMA32(a, bs[7], vn[1]);
            }
            __builtin_amdgcn_sched_barrier(0);
            { const bf16x8 a = rg0; rg0 = lds_frag(Lp + 24576);
              o[0] = MFMA32(a, bs[0], o[0]);
            }
            __builtin_amdgcn_sched_barrier(0);
            { const bf16x8 a = rg1; rg1 = lds_frag(Lp + 25600);
              o[0] = MFMA32(a, bs[1], o[0]);
            }
            __builtin_amdgcn_sched_barrier(0);
            { const bf16x8 a = rg2; rg2 = lds_frag(Lp + 26624);
              o[0] = MFMA32(a, bs[2], o[0]);
            }
            __builtin_amdgcn_sched_barrier(0);
            { const bf16x8 a = rg3; rg3 = lds_frag(Lp + 27648);
              o[0] = MFMA32(a, bs[3], o[0]);
            }
            __builtin_amdgcn_sched_barrier(0);
            { const bf16x8 a = rg4; rg4 = lds_frag(Lp + 28672);
              o[0] = MFMA32(a, bs[4], o[0]);
            }
            __builtin_amdgcn_sched_barrier(0);
            { const bf16x8 a = rg5; rg5 = lds_frag(Lp + 29696);
              o[0] = MFMA32(a, bs[5], o[0]);
            }
            __builtin_amdgcn_sched_barrier(0);
            { const bf16x8 a = rg6; rg6 = lds_frag(Lp + 30720);
              o[0] = MFMA32(a, bs[6], o[0]);
            }
            __builtin_amdgcn_sched_barrier(0);
            { const bf16x8 a = rg7; rg7 = lds_frag(Lp + 31744);
              o[0] = MFMA32(a, bs[7], o[0]);
            }
            __builtin_amdgcn_sched_barrier(0);
            { const bf16x8 a = rg0; rg0 = lds_frag(Lp + 49152);
              o[1] = MFMA32(a, bs[0], o[1]);
            }
            __builtin_amdgcn_sched_barrier(0);
            { const bf16x8 a = rg1; rg1 = lds_frag(Lp + 50176);
              o[1] = MFMA32(a, bs[1], o[1]);
            }
            __builtin_amdgcn_sched_barrier(0);
            { const bf16x8 a = rg2; rg2 = lds_frag(Lp + 51200);
              o[1] = MFMA32(a, bs[2], o[1]);
            }
            __builtin_amdgcn_sched_barrier(0);
            { const bf16x8 a = rg3; rg3 = lds_frag(Lp + 52224);
              o[1] = MFMA32(a, bs[3], o[1]);
            }
            __builtin_amdgcn_sched_barrier(0);
            { const bf16x8 a = rg4; rg4 = lds_frag(Lp + 53248);
              o[1] = MFMA32(a, bs[4], o[1]);
            }
            __builtin_amdgcn_sched_barrier(0);
            { const bf16x8 a = rg5; rg5 = lds_frag(Lp + 54272);
              o[1] = MFMA32(a, bs[5], o[1]);
            }
            __builtin_amdgcn_sched_barrier(0);
            { const bf16x8 a = rg6; rg6 = lds_frag(Lp + 32768);
              o[1] = MFMA32(a, bs[6], o[1]);
            }
            __builtin_amdgcn_sched_barrier(0);
            { const bf16x8 a = rg7; rg7 = lds_frag(Lp + 33792);
              o[1] = MFMA32(a, bs[7], o[1]);
            }
            __builtin_amdgcn_sched_barrier(0);
            { const bf16x8 a = rg0; rg0 = lds_frag(Lp + 34816);
              bv[0] = pack_half(vn[0], 0); bv[1] = pack_half(vn[0], 1); bv[2] = pack_half(vn[1], 0); bv[3] = pack_half(vn[1], 1);
              o[0] = MFMA32(a, bv[0], o[0]);
            }
            __builtin_amdgcn_sched_barrier(0);
            { const bf16x8 a = rg1; rg1 = lds_frag(Lp + 35840);
              o[0] = MFMA32(a, bv[1], o[0]);
            }
            __builtin_amdgcn_sched_barrier(0);
            { const bf16x8 a = rg2; rg2 = lds_frag(Lp + 36864);
              o[1] = MFMA32(a, bv[0], o[1]);
            }
            __builtin_amdgcn_sched_barrier(0);
            { const bf16x8 a = rg3; rg3 = lds_frag(Lp + 37888);
              o[1] = MFMA32(a, bv[1], o[1]);
            }
            __builtin_amdgcn_sched_barrier(0);
            { const bf16x8 a = rg4; rg4 = lds_frag(Lp + 38912);
              o[1] = MFMA32(a, bv[2], o[1]);
            }
            __builtin_amdgcn_sched_barrier(0);
            { const bf16x8 a = rg5; rg5 = lds_frag(Lp + 39936);
              o[1] = MFMA32(a, bv[3], o[1]);
            }
            __builtin_amdgcn_sched_barrier(0);
            { const bf16x8 a = rg6; rg6 = lds_frag(Lp + 40960);
              S[0] = S[0] * dl;
              S[0] = MFMA32(a, bv[0], S[0]);
            }
            __builtin_amdgcn_sched_barrier(0);
            { const bf16x8 a = rg7; rg7 = lds_frag(Lp + 41984);
              S[0] = MFMA32(a, bv[1], S[0]);
            }
            __builtin_amdgcn_sched_barrier(0);
            { const bf16x8 a = rg0; rg0 = lds_frag(Lp + 43008);
              S[0] = MFMA32(a, bv[2], S[0]);
            }
            __builtin_amdgcn_sched_barrier(0);
            { const bf16x8 a = rg1; rg1 = lds_frag(Lp + 44032);
              S[0] = MFMA32(a, bv[3], S[0]);
            }
            __builtin_amdgcn_sched_barrier(0);
            { const bf16x8 a = rg2; rg2 = lds_frag(Lp + 45056);
              S[1] = S[1] * dl;
              S[1] = MFMA32(a, bv[0], S[1]);
            }
            __builtin_amdgcn_sched_barrier(0);
            { const bf16x8 a = rg3; rg3 = lds_frag(Lp + 46080);
              S[1] = MFMA32(a, bv[1], S[1]);
            }
            __builtin_amdgcn_sched_barrier(0);
            { const bf16x8 a = rg4; rg4 = lds_frag(Lp + 47104);
              S[1] = MFMA32(a, bv[2], S[1]);
            }
            __builtin_amdgcn_sched_barrier(0);
            { const bf16x8 a = rg5; rg5 = lds_frag(Lp + 48128);
              S[1] = MFMA32(a, bv[3], S[1]);
            }
            __builtin_amdgcn_sched_barrier(0);
            { const bf16x8 a = rg6;
              S[2] = S[2] * dl;
              S[2] = MFMA32(a, bv[0], S[2]);
            }
            __builtin_amdgcn_sched_barrier(0);
            { const bf16x8 a = rg7;
              S[2] = MFMA32(a, bv[1], S[2]);
            }
            __builtin_amdgcn_sched_barrier(0);
            { const bf16x8 a = rg0;
              S[2] = MFMA32(a, bv[2], S[2]);
            }
            __builtin_amdgcn_sched_barrier(0);
            { const bf16x8 a = rg1;
              S[2] = MFMA32(a, bv[3], S[2]);
            }
            __builtin_amdgcn_sched_barrier(0);
            { const bf16x8 a = rg2;
              S[3] = S[3] * dl;
              S[3] = MFMA32(a, bv[0], S[3]);
            }
            __builtin_amdgcn_sched_barrier(0);
            { const bf16x8 a = rg3;
              S[3] = MFMA32(a, bv[1], S[3]);
            }
            __builtin_amdgcn_sched_barrier(0);
            { const bf16x8 a = rg4;
              S[3] = MFMA32(a, bv[2], S[3]);
            }
            __builtin_amdgcn_sched_barrier(0);
            { const bf16x8 a = rg5;
              S[3] = MFMA32(a, bv[3], S[3]);
            }
            __builtin_amdgcn_sched_barrier(0);
            BAR_B2();
#pragma unroll
            for (int m = 0; m < 2; ++m)
#pragma unroll
                for (int i = 0; i < 16; ++i) *(LAS bf16*)(F.lds + OST4 + (32 * m + (i & 3) + 8 * (i >> 2) + 4 * hg) * 256 + 2 * (32 * F.wave + r)) = (bf16)f2bf(o[m][i]);
        }
    } else if (F.wave < 6) {
        { const int lane = F.lane; ISSUE4(0, 0); }
        for (int n = 0; n < SEQ / 64; ++n) {
            int lane = F.lane; asm volatile("" : "+v"(lane));
            asm volatile("s_waitcnt vmcnt(0)" ::: "memory");
            BAR_B1();
            if (n + 1 < SEQ / 64) ISSUE4(n + 1, ((n + 1) & 1) * 72704);
            asm volatile("" ::: "memory"); __builtin_amdgcn_s_barrier(); asm volatile("" ::: "memory");
        }
    } else {
        const bf16* gplane = (const bf16*)(F.ws + WS_P) + (size_t)7 * PLANE;
        bf16* ocat = (bf16*)(F.ws + WS_OCAT) + (size_t)1 * PLANE;
        const float* nw = F.in[8] + l * HDIM;
        for (int n = 0; n < SEQ / 64; ++n) {
            int lane = F.lane; asm volatile("" : "+v"(lane));
            BAR_B1();
            if (n > 0) post4_chunk(F, gplane, ocat, nw, (size_t)b * SEQ + 64 * (n - 1), h, lane);
            BAR_B2();
        }
    }
    BAR_B1();
    if (F.wave >= 6) { const bf16* gplane = (const bf16*)(F.ws + WS_P) + (size_t)7 * PLANE; bf16* ocat = (bf16*)(F.ws + WS_OCAT) + (size_t)1 * PLANE;
        post4_chunk(F, gplane, ocat, F.in[8] + l * HDIM, (size_t)b * SEQ + 64 * (SEQ / 64 - 1), h, F.lane); }
    __syncthreads();
#undef ISSUE4
#undef BAR_B1
#undef BAR_B2
}
enum { MAT_INA = 0, MAT_INB, MAT_OHG, MAT_ODN, MAT_OUT, MAT_GU, MAT_DN, MAT_N };
__device__ __forceinline__ int colmap(int mat, int n) {
    switch (mat) {
        case MAT_INA: return n;
        case MAT_INB: return 4104 + n;
        case MAT_GU: { const int pn = n >> 8, r = n & 255; return r < 128 ? 128 * pn + r : DFF + 128 * pn + (r - 128); }
        default: return n;
    }
}
__device__ __forceinline__ void transpose_item(const float* W, int K, int Nsrc, bf16* WT, int mat, const float* gain, LAS float* scr, int kb, int nb, int lane) {
    const int k0 = 64 * kb, n0 = 32 * nb;
    const int sc = colmap(mat, n0 + (lane & 31));
#pragma unroll 8
    for (int i = 0; i < 32; ++i) { const int kk = 2 * i + (lane >> 5);
        float v = 0.f; if (sc >= 0) { v = W[(size_t)(k0 + kk) * Nsrc + sc]; if (gain) v *= gain[k0 + kk]; }
        scr[kk * 33 + (lane & 31)] = v; }
    LDS_WAIT(); asm volatile("" ::: "memory");
    const int c = lane & 7;
#pragma unroll
    for (int j = 0; j < 4; ++j) { const int n = (lane >> 3) + 8 * j; const LAS float* s = scr + (8 * c) * 33 + n;
        v4u o; o.x = pk2(s[0 * 33], s[1 * 33]); o.y = pk2(s[2 * 33], s[3 * 33]); o.z = pk2(s[4 * 33], s[5 * 33]); o.w = pk2(s[6 * 33], s[7 * 33]);
        *(GAS v4u*)(WT + (size_t)(n0 + n) * K + k0 + 8 * c) = o; }
    LDS_WAIT(); asm volatile("" ::: "memory");
}
__device__ __forceinline__ void p0_weights(Frame& F) {
    LAS float* scr = (LAS float*)(F.lds + F.wave * 16384);
    const int gw = blockIdx.x * NWAVES + F.wave, NGW = F.G * NWAVES;
    constexpr int I_INA = 16 * (N_INA / 32), I_INB = 16 * (N_INB / 32), I_OH = 8 * 32, I_OUT = 16 * 32, I_GU = 16 * (2 * DFF / 32), I_DN = (DFF / 64) * 32;
    constexpr int I_LAYER = I_INA + I_INB + 2 * I_OH + I_OUT + I_GU + I_DN;
    for (int it = gw; it < DEPTH * I_LAYER; it += NGW) {
        const int l = it / I_LAYER; int r = it % I_LAYER;
        bf16* wl = (bf16*)(F.ws + WS_W) + (size_t)l * W_LAYER;
        if (r < I_INA) { const int nblk = N_INA / 32; transpose_item(F.in[3] + (size_t)l * DM * INW, DM, INW, wl + W_INA, MAT_INA, F.in[2] + l * DM, scr, r / nblk, r % nblk, F.lane); continue; } r -= I_INA;
        if (r < I_INB) { const int nblk = N_INB / 32; transpose_item(F.in[3] + (size_t)l * DM * INW, DM, INW, wl + W_INB, MAT_INB, F.in[2] + l * DM, scr, r / nblk, r % nblk, F.lane); continue; } r -= I_INB;
        if (r < I_OH) { transpose_item(F.in[9] + (size_t)l * 512 * DM, 512, DM, wl + W_O2, MAT_OHG, nullptr, scr, r / 32, r % 32, F.lane); continue; } r -= I_OH;
        if (r < I_OH) { transpose_item(F.in[10] + (size_t)l * 512 * DM, 512, DM, wl + W_O2 + (size_t)1024 * 512, MAT_ODN, nullptr, scr, r / 32, r % 32, F.lane); continue; } r -= I_OH;
        if (r < I_OUT) { transpose_item(F.in[11] + (size_t)l * DM * DM, DM, DM, wl + W_OUT, MAT_OUT, nullptr, scr, r / 32, r % 32, F.lane); continue; } r -= I_OUT;
        if (r < I_GU) { const int nblk = 2 * DFF / 32; transpose_item(F.in[14] + (size_t)l * DM * 2 * DFF, DM, 2 * DFF, wl + W_GU, MAT_GU, F.in[13] + l * DM, scr, r / nblk, r % nblk, F.lane); continue; } r -= I_GU;
        transpose_item(F.in[15] + (size_t)l * DFF * DM, DFF, DM, wl + W_DN, MAT_DN, nullptr, scr, r / 32, r % 32, F.lane);
    }
}
__device__ __forceinline__ void wab_stage(Frame& F, int l) {
    __syncthreads();
    LAS float* W = (LAS float*)F.lds;
    const float* win = F.in[3] + (size_t)l * DM * INW + 4096; const float* gain = F.in[2] + l * DM;
#pragma unroll
    for (int i = 0; i < 2; ++i) { const int k = F.tid + 512 * i; const float g = gain[k];
        const f32x4 a = *(const GAS f32x4*)(win + (size_t)k * INW), c = *(const GAS f32x4*)(win + (size_t)k * INW + 4);
#pragma unroll
        for (int e = 0; e < 4; ++e) { W[e * 1024 + k] = a[e] * g; W[(4 + e) * 1024 + k] = c[e] * g; } }
    __syncthreads();
}
__device__ __forceinline__ void wab_row(Frame& F, const float* hn, int m) {
    const LAS float* W = (const LAS float*)F.lds;
    float r[8];
#pragma unroll
    for (int j = 0; j < 8; ++j) { const LAS f32x4* p = (const LAS f32x4*)(W + j * 1024) + 2 * F.lane; const f32x4 a = p[0], c = p[1], d = p[128], e = p[129];
        float s = 0.f;
#pragma unroll
        for (int t = 0; t < 4; ++t) s += hn[t] * a[t] + hn[4 + t] * c[t] + hn[8 + t] * d[t] + hn[12 + t] * e[t];
        r[j] = wave_sum(s); }
    if (F.lane == 0) { GAS f32x4* o = (GAS f32x4*)((float*)(F.ws + WS_AB) + (size_t)m * 8); o[0] = (f32x4){r[0], r[1], r[2], r[3]}; o[1] = (f32x4){r[4], r[5], r[6], r[7]}; }
}
__device__ __forceinline__ void p0_rows(Frame& F) {
    wab_stage(F, 0);
    const int gw = blockIdx.x * NWAVES + F.wave, NGW = F.G * NWAVES;
    bf16* R = (bf16*)(F.ws + WS_R); float* rstd = (float*)(F.ws + WS_RSTD);
    f32x4 cur[4], nxt[4];
    if (gw < MTOK) { const GAS f32x4* xr = (const GAS f32x4*)(F.in[0] + (size_t)gw * DM) + 2 * F.lane; cur[0] = xr[0]; cur[1] = xr[1]; cur[2] = xr[128]; cur[3] = xr[129]; }
    for (int m = gw; m < MTOK; m += NGW) {
        const int mn = m + NGW;
        if (mn < MTOK) { const GAS f32x4* xr = (const GAS f32x4*)(F.in[0] + (size_t)mn * DM) + 2 * F.lane; nxt[0] = xr[0]; nxt[1] = xr[1]; nxt[2] = xr[128]; nxt[3] = xr[129]; }
        float s = 0.f;
#pragma unroll
        for (int j = 0; j < 4; ++j) s += (cur[j].x * cur[j].x + cur[j].y * cur[j].y) + (cur[j].z * cur[j].z + cur[j].w * cur[j].w);
        const float rs = __builtin_amdgcn_rsqf(wave_sum(s) * (1.f / DM) + EPSF);
        if (F.lane == 0) rstd[m] = rs;
#pragma unroll
        for (int j = 0; j < 4; ++j) cur[j] = cur[j] * rs;
        { float hn[16];
#pragma unroll
          for (int j = 0; j < 4; ++j) { hn[4 * j] = cur[j].x; hn[4 * j + 1] = cur[j].y; hn[4 * j + 2] = cur[j].z; hn[4 * j + 3] = cur[j].w; }
          wab_row(F, hn, m); }
        GAS v4u* o8 = (GAS v4u*)(R + (size_t)m * DM) + F.lane;
        o8[0] = (v4u){pk2(cur[0].x, cur[0].y), pk2(cur[0].z, cur[0].w), pk2(cur[1].x, cur[1].y), pk2(cur[1].z, cur[1].w)};
        o8[64] = (v4u){pk2(cur[2].x, cur[2].y), pk2(cur[2].z, cur[2].w), pk2(cur[3].x, cur[3].y), pk2(cur[3].z, cur[3].w)};
#pragma unroll
        for (int j = 0; j < 4; ++j) cur[j] = nxt[j];
    }
}
struct RowRegs { v4u t[2]; v4u rb[2]; f32x4 rf[4]; float rs; };
template <bool RESID_F32>
__device__ __forceinline__ void row_load(RowRegs& a, const bf16* tin, const float* resid32, const bf16* R, const float* rs_in, int m, int lane) {
    const GAS v4u* tr = (const GAS v4u*)(tin + (size_t)m * DM) + lane; a.t[0] = tr[0]; a.t[1] = tr[64];
    if (RESID_F32) { const GAS f32x4* xr = (const GAS f32x4*)(resid32 + (size_t)m * DM) + 2 * lane; a.rf[0] = xr[0]; a.rf[1] = xr[1]; a.rf[2] = xr[128]; a.rf[3] = xr[129]; }
    else { const GAS v4u* rr = (const GAS v4u*)(R + (size_t)m * DM) + lane; a.rb[0] = rr[0]; a.rb[1] = rr[64]; int mv = m; asm volatile("" : "+v"(mv));
        a.rs = ((const GAS float*)rs_in)[mv]; }
}
__device__ __forceinline__ void unpack8(const v4u q, float* o) { o[0] = bflo(q.x); o[1] = bfhi(q.x); o[2] = bflo(q.y); o[3] = bfhi(q.y); o[4] = bflo(q.z); o[5] = bfhi(q.z); o[6] = bflo(q.w); o[7] = bfhi(q.w); }
template <bool RESID_F32, bool OUT_F32, bool WITH_AB = false>
__device__ __forceinline__ void rowpass(Frame& F, const bf16* tin, const float* resid32, const float* w, float* out32, int rs_sel, int gw, int NGW, int MEND) {
    bf16* R = (bf16*)(F.ws + WS_R); const float* rs_in = (const float*)(F.ws + WS_RSTD) + (size_t)rs_sel * MTOK; float* rstd = (float*)(F.ws + WS_RSTD) + (size_t)(rs_sel ^ 1) * MTOK;
    float wv[16];
    { const GAS f32x4* wp = (const GAS f32x4*)w + 2 * F.lane; const f32x4 a = wp[0], b = wp[1], c = wp[128], d = wp[129];
#pragma unroll
      for (int e = 0; e < 4; ++e) { wv[e] = a[e]; wv[4 + e] = b[e]; wv[8 + e] = c[e]; wv[12 + e] = d[e]; } }
    RowRegs cur, nxt;
    if (gw < MEND) row_load<RESID_F32>(cur, tin, resid32, R, rs_in, gw, F.lane);
    for (int m = gw; m < MEND; m += NGW) {
        const int mn = m + NGW;
        if (mn < MEND) row_load<RESID_F32>(nxt, tin, resid32, R, rs_in, mn, F.lane);
        float t[16], h[16];
        unpack8(cur.t[0], t); unpack8(cur.t[1], t + 8);
        if (RESID_F32) {
#pragma unroll
            for (int e = 0; e < 4; ++e) { h[e] = cur.rf[0][e]; h[4 + e] = cur.rf[1][e]; h[8 + e] = cur.rf[2][e]; h[12 + e] = cur.rf[3][e]; }
        } else { unpack8(cur.rb[0], h); unpack8(cur.rb[1], h + 8); const float ir = __builtin_amdgcn_rcpf(cur.rs);
#pragma unroll
            for (int e = 0; e < 16; ++e) h[e] *= ir; }
        float s = 0.f;
#pragma unroll
        for (int e = 0; e < 16; ++e) s += t[e] * t[e];
        const float r1 = __builtin_amdgcn_rsqf(wave_sum(s) * (1.f / DM) + EPSF);
        float s2 = 0.f;
#pragma unroll
        for (int e = 0; e < 16; ++e) { h[e] = h[e] + t[e] * r1 * wv[e]; s2 += h[e] * h[e]; }
        if (OUT_F32) {
            GAS f32x4* o = (GAS f32x4*)(out32 + (size_t)m * DM) + 2 * F.lane;
            o[0] = (f32x4){h[0], h[1], h[2], h[3]}; o[1] = (f32x4){h[4], h[5], h[6], h[7]}; o[128] = (f32x4){h[8], h[9], h[10], h[11]}; o[129] = (f32x4){h[12], h[13], h[14], h[15]};
        } else {
            const float rn = __builtin_amdgcn_rsqf(wave_sum(s2) * (1.f / DM) + EPSF);
            if (F.lane == 0) rstd[m] = rn;
#pragma unroll
            for (int e = 0; e < 16; ++e) h[e] *= rn;
            if (WITH_AB) wab_row(F, h, m);
            GAS v4u* o8 = (GAS v4u*)(R + (size_t)m * DM) + F.lane;
            o8[0] = (v4u){pk2(h[0], h[1]), pk2(h[2], h[3]), pk2(h[4], h[5]), pk2(h[6], h[7])};
            o8[64] = (v4u){pk2(h[8], h[9]), pk2(h[10], h[11]), pk2(h[12], h[13]), pk2(h[14], h[15])};
        }
        cur = nxt;
    }
}
__device__ __forceinline__ void post_phase(Frame& F, int l) {
    const int gw = blockIdx.x * NWAVES + F.wave, NGW = F.G * NWAVES;
    const bf16* oraw = (const bf16*)(F.ws + WS_ORAW); bf16* ocat = (bf16*)((unsigned char*)F.out + 128 * MiB);
    const bf16* planes = (const bf16*)(F.ws + WS_P);
    const int d0 = (8 * F.lane) & 127;
#pragma unroll
    for (int br = 0; br < 2; ++br) {
        float nw[8];
#pragma unroll
        for (int j = 0; j < 8; ++j) nw[j] = (br ? F.in[8] : F.in[4])[l * HDIM + d0 + j];
        const bf16* op = oraw + (size_t)br * PLANE; const bf16* gp = planes + (size_t)(br ? 7 : 6) * PLANE;   bf16* cp = ocat + (size_t)br * PLANE;
        for (int m0 = gw; m0 < MTOK; m0 += 4 * NGW) {
            v4u ov[4], gv[4];
#pragma unroll
            for (int u = 0; u < 4; ++u) { const int m = m0 + u * NGW; if (m < MTOK) { ov[u] = *(const GAS v4u*)(op + (size_t)m * 512 + 8 * F.lane); gv[u] = *(const GAS v4u*)(gp + (size_t)m * 512 + 8 * F.lane); } }
#pragma unroll
            for (int u = 0; u < 4; ++u) { const int m = m0 + u * NGW; if (m < MTOK) {
                const float o[8] = {bflo(ov[u].x), bfhi(ov[u].x), bflo(ov[u].y), bfhi(ov[u].y), bflo(ov[u].z), bfhi(ov[u].z), bflo(ov[u].w), bfhi(ov[u].w)};
                const float g[8] = {bflo(gv[u].x), bfhi(gv[u].x), bflo(gv[u].y), bfhi(gv[u].y), bflo(gv[u].z), bfhi(gv[u].z), bflo(gv[u].w), bfhi(gv[u].w)};
                float s = 0.f;
#pragma unroll
                for (int j = 0; j < 8; ++j) s += o[j] * o[j];
                s += __builtin_bit_cast(float, __builtin_amdgcn_update_dpp(0, __builtin_bit_cast(int, s), 0xB1, 0xF, 0xF, true));
                s += __builtin_bit_cast(float, __builtin_amdgcn_update_dpp(0, __builtin_bit_cast(int, s), 0x4E, 0xF, 0xF, true));
                s += __builtin_bit_cast(float, __builtin_amdgcn_update_dpp(0, __builtin_bit_cast(int, s), 0x141, 0xF, 0xF, true));
                s += __builtin_bit_cast(float, __builtin_amdgcn_update_dpp(0, __builtin_bit_cast(int, s), 0x140, 0xF, 0xF, true));
                const float rs = __builtin_amdgcn_rsqf(s * (1.f / HDIM) + EPSF);
                float r[8];
#pragma unroll
                for (int j = 0; j < 8; ++j) r[j] = o[j] * rs * nw[j] * (g[j] * sigmf(g[j]));
                v4u w; w.x = pk2(r[0], r[1]); w.y = pk2(r[2], r[3]); w.z = pk2(r[4], r[5]); w.w = pk2(r[6], r[7]);
                *(GAS v4u*)(cp + (size_t)m * 512 + 8 * F.lane) = w; } }
        }
    }
}

#ifndef DUP_MASK
#define DUP_MASK 0
#endif
#define REP(k) _Pragma("unroll") for (int rep_ = 0; rep_ < (((DUP_MASK >> (k)) & 1) ? 2 : 1); ++rep_)
#define IN(k) (lo <= (k) && (k) < hi)
#define SEAM(k) do { if (IN(k) && IN((k) + 1)) xcd_barrier(bar); } while (0)
#ifndef GB_UNITS
#define GB_UNITS 10
#endif
template <int l> __device__ __forceinline__ void layer_phases(Frame& F, const XcdBarrier& bar, const int lo, const int hi) {
        const int pb = 1 + 11 * l;
        const pg8::bf16_t* wl = (const pg8::bf16_t*)(F.ws + WS_W) + (size_t)l * W_LAYER;
        pg8::bf16_t* Rb = (pg8::bf16_t*)(F.ws + WS_R);
        REP(0) if (IN(pb + 0)) {
            pg8::Gemm g{Rb, wl + W_INA, MTOK, N_INA, DM}; pg8::StaticOrder S; S.init(MTOK, N_INA, F.G, (int)blockIdx.x);
            pg8::EpiProjA E{(pg8::bf16_t*)(F.ws + WS_P), PLANE};
            pg8::gemm_phase<pg8::EpiProjA, pg8::StaticOrder, PG8_ALIGN, PG8_SP2>(F.lds, g, S, E);
        }
        SEAM(pb + 0);
        REP(1) if (IN(pb + 1)) {
            { HgRaw cur, nxt; if ((int)blockIdx.x < NUNIT) hg_raw_load(cur, F, blockIdx.x, F.lane);
              for (int u = blockIdx.x; u < NUNIT; u += F.G) { if (u + F.G < NUNIT) hg_raw_load(nxt, F, u + F.G, F.lane); prep_hg_unit(F, l, u, cur); cur = nxt; } }
            { DnRaw cur, nxt; if ((int)blockIdx.x < NUNIT) dn_raw_load(cur, F, blockIdx.x, F.tid, F.lane);
              for (int u = blockIdx.x; u < NUNIT; u += F.G) { if (u + F.G < NUNIT) dn_raw_load(nxt, F, u + F.G, F.tid, F.lane); prep_dn_unit(F, l, u, cur); cur = nxt; } }
        }
        SEAM(pb + 1);
        REP(2) if (IN(pb + 2)) {
            const int bid = blockIdx.x; const bool grpA = (bid & 24) == 0;
            if (F.G == 256) {
                const int ja = (bid >> 5) * 8 + (bid & 7), jb = (bid & 7) + 8 * ((((bid >> 3) & 3) - 1) + 3 * (bid >> 5));
                if (grpA) { if (ja < 32) scan4_hg(F, l, ja); else scan4_dn(F, l, ja - 32); }
                pg8::Gemm g{Rb, wl + W_INB, MTOK, N_INB, DM}; pg8::SplitOrder S; S.so.init(MTOK, N_INB, F.G, 0);
                S.first = grpA ? 192 * GB_UNITS + ja : jb; S.stride = grpA ? 64 : 192; S.count = grpA ? (2048 - 192 * GB_UNITS) / 64 : GB_UNITS;
                pg8::EpiGate E{(pg8::bf16_t*)(F.ws + WS_GATES), (size_t)MTOK * DM};
                pg8::gemm_phase<pg8::EpiGate, pg8::SplitOrder, PG8_ALIGN, PG8_SP2>(F.lds, g, S, E);
            }
        }
        SEAM(pb + 2);
        REP(5) if (IN(pb + 5)) {
            pg8::Gemm g{(const pg8::bf16_t*)(F.ws + WS_OCAT), wl + W_O2, 2 * MTOK, 2048, 512};
            pg8::PairOrder S; S.so.init(MTOK, DM, F.G, (int)blockIdx.x);
            pg8::EpiMerge E{(pg8::bf16_t*)(F.ws + WS_MERGED), (const pg8::bf16_t*)(F.ws + WS_GATES), (size_t)MTOK * DM};
            pg8::gemm_phase<pg8::EpiMerge, pg8::PairOrder, PG8_ALIGN, PG8_SP2>(F.lds, g, S, E);
        }
        SEAM(pb + 5);
        REP(6) if (IN(pb + 6)) {
            pg8::Gemm g{(const pg8::bf16_t*)(F.ws + WS_MERGED), wl + W_OUT, MTOK, DM, DM}; pg8::StaticOrder S; S.init(MTOK, DM, F.G, (int)blockIdx.x);
            pg8::EpiBf16<0> E{(pg8::bf16_t*)(F.ws + WS_MIX), DM, nullptr, 0, 0, 1.f};
            pg8::gemm_phase<pg8::EpiBf16<0>, pg8::StaticOrder, PG8_ALIGN, PG8_SP2>(F.lds, g, S, E);
        }
        SEAM(pb + 6);
        REP(7) if (IN(pb + 7)) {
            const int gw = blockIdx.x * NWAVES + F.wave, NGW = F.G * NWAVES;
            if (l == 0) rowpass<true, false>(F, (const bf16*)(F.ws + WS_MIX), F.in[0], F.in[12] + l * DM, nullptr, 0, gw, NGW, MTOK);
            else rowpass<false, false>(F, (const bf16*)(F.ws + WS_MIX), nullptr, F.in[12] + l * DM, nullptr, 0, gw, NGW, MTOK);
        }
        SEAM(pb + 7);
        REP(8) if (IN(pb + 8)) {
            pg8::Gemm g{Rb, wl + W_GU, MTOK, 2 * DFF, DM}; pg8::StaticOrder S; S.init(MTOK, 2 * DFF, F.G, (int)blockIdx.x);
            pg8::EpiSwiGLU E{(pg8::bf16_t*)(F.ws + WS_ACT)};
            pg8::gemm_phase<pg8::EpiSwiGLU, pg8::StaticOrder, PG8_ALIGN, PG8_SP2>(F.lds, g, S, E);
        }
        SEAM(pb + 8);
        REP(9) if (IN(pb + 9)) {
            pg8::Gemm g{(const pg8::bf16_t*)(F.ws + WS_ACT), wl + W_DN, MTOK, DM, DFF}; pg8::StaticOrder S; S.init(MTOK, DM, F.G, (int)blockIdx.x);
            pg8::EpiBf16<0> E{(pg8::bf16_t*)(F.ws + WS_F), DM, nullptr, 0, 0, 1.f};
            pg8::gemm_phase<pg8::EpiBf16<0>, pg8::StaticOrder, PG8_ALIGN, PG8_SP2>(F.lds, g, S, E);
        }
        SEAM(pb + 9);
        REP(10) if (IN(pb + 10)) {
            const int gw = blockIdx.x * NWAVES + F.wave, NGW = F.G * NWAVES;
            if (l == DEPTH - 1) rowpass<false, true>(F, (const bf16*)(F.ws + WS_F), nullptr, F.in[16] + l * DM, F.out, 1, gw, NGW, MTOK);
            else { wab_stage(F, l + 1); rowpass<false, false, true>(F, (const bf16*)(F.ws + WS_F), nullptr, F.in[16] + l * DM, nullptr, 1, gw, NGW, MTOK); }
        }
        if (l + 1 < DEPTH) SEAM(pb + 10);
    }
#undef IN
#undef SEAM
struct Args { const float* in[17]; float* out; unsigned char* ws; int ph_lo, ph_hi; };
static_assert(sizeof(Args) == 17 * 8 + 8 + 8 + 8, "Args has no padding");
__global__ void __launch_bounds__(NWAVES * 64, 2) hybrid_fwd(Args args) {
    extern __shared__ __attribute__((aligned(16))) unsigned char lds[];
    Frame F;
    F.lds = (LAS unsigned char*)lds;
    F.MISC = (volatile LAS unsigned*)(F.lds + MISC_OFF);
    F.tid = threadIdx.x; F.lane = F.tid & 63; F.wave = __builtin_amdgcn_readfirstlane(F.tid >> 6);
    F.G = gridDim.x;
    F.ws = args.ws; F.out = args.out; F.ctl = (gu32*)(args.ws + WS_CTL);
#pragma unroll
    for (int i = 0; i < 17; ++i) F.in[i] = args.in[i];
    for (int u = F.tid; u < (LDS_BYTES - MISC_OFF) / 4; u += NWAVES * 64) ((LAS unsigned*)(F.lds + MISC_OFF))[u] = 0u;
    __syncthreads();
    const int lo = args.ph_lo, hi = args.ph_hi;
    XcdBarrier bar; bar.bar = (unsigned*)(F.ctl + CW_BAR); bar.x = 0; bar.st = nullptr;
    if (hi - lo > 1) bar = xcd_barrier_post((unsigned*)(F.ctl + CW_BAR), F.MISC + 8);
#define IN(k) (lo <= (k) && (k) < hi)
#define SEAM(k) do { if (IN(k) && IN((k) + 1)) xcd_barrier(bar); } while (0)

#ifndef NO_P0
    if (IN(0)) { p0_weights(F); p0_rows(F); }
#endif
    SEAM(0);

    layer_phases<0>(F, bar, lo, hi);
    layer_phases<1>(F, bar, lo, hi);
#undef IN
#undef SEAM
}

extern "C" void kernel_launch(void* const* d_in, const int* in_sizes, int n_in, void* d_out, int out_size, void* d_ws, size_t ws_size, hipStream_t stream) {
    static int grid = 0;
    if (grid == 0) {
        if (n_in != 17 || in_sizes[0] != MTOK * DM || out_size != MTOK * DM || ws_size < WS_END) {
            fprintf(stderr, "kernel_launch: unexpected shapes: n_in %d in0 %d out %d ws %zu (need %zu)\n", n_in, n_in > 0 ? in_sizes[0] : -1, out_size, ws_size, (size_t)WS_END); grid = -1; return; }
        int dev = 0, cus = 0, per_cu = 0;
        if (hipGetDevice(&dev) != hipSuccess || hipDeviceGetAttribute(&cus, hipDeviceAttributeMultiprocessorCount, dev) != hipSuccess) { grid = -1; return; }
        if (hipFuncSetAttribute((const void*)hybrid_fwd, hipFuncAttributeMaxDynamicSharedMemorySize, LDS_BYTES) != hipSuccess) { fprintf(stderr, "kernel_launch: hipFuncSetAttribute failed\n"); grid = -1; return; }
        if (hipOccupancyMaxActiveBlocksPerMultiprocessor(&per_cu, (const void*)hybrid_fwd, NWAVES * 64, LDS_BYTES) != hipSuccess || per_cu < 1)
            fprintf(stderr, "kernel_launch: note: occupancy query reports %d workgroups per CU\n", per_cu);
        (void)hipGetLastError();
        grid = cus;
    }
    if (grid < 0) return;
    if (hipMemsetAsync((char*)d_ws + WS_CTL, 0, CTL_ZERO_BYTES, stream) != hipSuccess) return;
    Args a{};
    for (int i = 0; i < 17; ++i) a.in[i] = (const float*)d_in[i];
    a.out = (float*)d_out; a.ws = (unsigned char*)d_ws;
#if MK_ONE_LAUNCH
    a.ph_lo = 0; a.ph_hi = N_PHASES;
    hipLaunchKernelGGL(hybrid_fwd, dim3(grid), dim3(NWAVES * 64), LDS_BYTES, stream, a);
#else
    for (int p = 0; p < N_PHASES; ++p) {
        a.ph_lo = p; a.ph_hi = p + 1;
        hipLaunchKernelGGL(hybrid_fwd, dim3(grid), dim3(NWAVES * 64), LDS_BYTES, stream, a);
    }
#endif
}
```

```cpp
#include <hip/hip_runtime.h>
#include <cstdio>
#include <cstdint>

constexpr int DM = 1024, BATCH = 8, SEQ = 8192, MTOK = BATCH * SEQ, DEPTH = 2;
constexpr int NHEAD = 4, HDIM = 128, HWID = 512;
constexpr int DFF = 2816, INW = 6152;
constexpr int N_INA = 4096;
constexpr int N_INB = 2048;
constexpr int CONVW = 4, CONVC = 1536;
constexpr float EPSF = 1e-6f;
#define MK_ONE_LAUNCH 1
namespace pg8 {
#define PG8_LAS __attribute__((address_space(3)))
typedef unsigned short bf16_t;
typedef short bf16x8 __attribute__((ext_vector_type(8)));
typedef float f32x4 __attribute__((ext_vector_type(4)));
typedef unsigned u32x4 __attribute__((ext_vector_type(4)));
constexpr int BM = 256, BK = 64, HALF = 128, HTB = HALF * BK * 2  , STAGE_BYTES = 8 * HTB, NXCD = 8, WGM = 8;

__host__ __device__ __forceinline__ int lds_byte(int r, int c) { const int st = (r >> 4) * 2 + (c >> 5), rr = r & 15, cc = c & 31, ob = rr * 64 + cc * 2; return st * 1024 + (ob ^ (((ob >> 9) & 1) << 5)); }
__host__ __device__ __forceinline__ void stage_rc(int b, int& R, int& C) { const int st = b / 1024, sb = b % 1024, swz = sb ^ (((sb >> 9) & 1) << 5); R = (st >> 1) * 16 + swz / 64; C = (st & 1) * 32 + (swz % 64) / 2; }
__host__ __device__ __forceinline__ int perm32(int rho) { const int n = rho >> 4, i = rho & 15; return 8 * (i >> 2) + 4 * n + (i & 3); }

struct Unit { int pm, pn; };
struct Gemm { const bf16_t* A; const bf16_t* Bt; int M, N, K; };

struct StaticOrder {
    int nM, nN, nwg, G, c;
    __host__ __device__ void init(int M, int N, int G_, int c_) { nM = M / BM; nN = N / BM; nwg = nM * nN; G = G_; c = c_; }
    __host__ __device__ bool next(int i, Unit& u) const {
        const long L = (long)i * G + c; if (L >= nwg) return false;
        int wgid = (int)L; { const int q = nwg / NXCD, r = nwg % NXCD, xcd = wgid % NXCD, off = wgid / NXCD; wgid = (xcd < r ? xcd * (q + 1) : r * (q + 1) + (xcd - r) * q) + off; }
        const int nig = WGM * nN, gid = wgid / nig, fm = gid * WGM, gsz = (nM - fm) < WGM ? (nM - fm) : WGM;
        u.pm = fm + ((wgid % nig) % gsz); u.pn = (wgid % nig) / gsz; return true;
    }
    __device__ __forceinline__ void a_ready(const Unit&) const {}
    __device__ __forceinline__ void done(const Unit&) const {}
};

__device__ __forceinline__ unsigned cvt_pk_bf16(float lo, float hi) { unsigned r; asm volatile("v_cvt_pk_bf16_f32 %0, %1, %2" : "=v"(r) : "v"(lo), "v"(hi)); return r; }
typedef float f32x2 __attribute__((ext_vector_type(2)));
__device__ __forceinline__ f32x2 gelu_pk(f32x2 v) {
    const f32x2 av = __builtin_elementwise_abs(v), d = av * 0.2316418882f + 1.0f;
    f32x2 t; t.x = __builtin_amdgcn_rcpf(d.x); t.y = __builtin_amdgcn_rcpf(d.y);
    f32x2 q = t * 0.5307027145f + (-0.7265760135f); q = q * t + 0.7107068705f; q = q * t + (-0.142248368f); q = q * t + 0.127414796f; q = q * t;
    const f32x2 s = (v * v) * (-0.72134752044f);
    f32x2 e; e.x = __builtin_amdgcn_exp2f(s.x); e.y = __builtin_amdgcn_exp2f(s.y);
    const f32x2 m = v * (q * e), r = v - m;
    f32x2 o; o.x = v.x < 0.f ? m.x : r.x; o.y = v.y < 0.f ? m.y : r.y; return o;
}

template <int ACT  > struct EpiBf16 {
    static constexpr bool PERM = true, AFTER_DRAIN = false; static_assert(ACT == 0 || ACT == 1, "EpiBf16: ACT is 0 (none) or 1 (gelu_pk)");
    bf16_t* O; int ldc; const float* bias; int split_cols; size_t split_stride; float scale0;
    __device__ __forceinline__ void operator()(const f32x4 (&acc)[2][2][4][2], const Unit& u, int wr, int wc, int fr, int fq) const {
        const int row0 = u.pm * BM + wr * 64 + fr; int colt = u.pn * BM; bf16_t* base = O;
        float sc = 1.f; if (split_cols) { const int t = colt / split_cols; base += (size_t)t * split_stride; colt -= t * split_cols; if (t == 0) sc = scale0; }
        const int col0 = colt + wc * 32 + 8 * fq, bcol0 = u.pn * BM + wc * 32 + 8 * fq;
        f32x4 bv[2][2];
#pragma unroll
        for (int bj = 0; bj < 2; ++bj)
#pragma unroll
            for (int n = 0; n < 2; ++n) bv[bj][n] = bias ? *(const f32x4*)(bias + bcol0 + bj * HALF + 4 * n) : (f32x4){0.f, 0.f, 0.f, 0.f};
#pragma unroll
        for (int ai = 0; ai < 2; ++ai)
#pragma unroll
            for (int m = 0; m < 4; ++m) { bf16_t* rowp = base + (size_t)(row0 + ai * HALF + m * 16) * ldc + col0;
#pragma unroll
                for (int bj = 0; bj < 2; ++bj) { f32x4 v0 = acc[ai][bj][m][0] + bv[bj][0], v1 = acc[ai][bj][m][1] + bv[bj][1];
                    if (ACT == 1) { f32x2 a = gelu_pk((f32x2){v0[0], v0[1]}), b = gelu_pk((f32x2){v0[2], v0[3]}), c = gelu_pk((f32x2){v1[0], v1[1]}), d = gelu_pk((f32x2){v1[2], v1[3]});
                        v0 = (f32x4){a.x, a.y, b.x, b.y}; v1 = (f32x4){c.x, c.y, d.x, d.y}; }
                    v0 = v0 * sc; v1 = v1 * sc; u32x4 w; w.x = cvt_pk_bf16(v0[0], v0[1]); w.y = cvt_pk_bf16(v0[2], v0[3]); w.z = cvt_pk_bf16(v1[0], v1[1]); w.w = cvt_pk_bf16(v1[2], v1[3]);
                    *(u32x4*)(rowp + bj * HALF) = w; } }
    }
};
__device__ __forceinline__ float bf_lo(unsigned w) { return __builtin_bit_cast(float, w << 16); }
__device__ __forceinline__ float bf_hi(unsigned w) { return __builtin_bit_cast(float, w & 0xffff0000u); }
__device__ __forceinline__ float sigm(float x) { return __builtin_amdgcn_rcpf(1.f + __expf(-x)); }
typedef __bf16 bfp2 __attribute__((ext_vector_type(2)));
__device__ __forceinline__ unsigned pkv(float lo, float hi) { f32x2 v = {lo, hi}; bfp2 r = __builtin_convertvector(v, bfp2); return __builtin_bit_cast(unsigned, r); }

struct EpiProjA {
    static constexpr bool PERM = true, AFTER_DRAIN = false;
    bf16_t* planes; size_t plane_stride;
    __device__ __forceinline__ void operator()(const f32x4 (&acc)[2][2][4][2], const Unit& u, int wr, int wc, int fr, int fq) const {
        const int row0 = u.pm * BM + wr * 64 + fr;
        {
            const int pl = u.pn >> 1, slot = pl == 3 ? 6 : (pl == 6 ? 3 : pl);
            bf16_t* base = planes + (size_t)slot * plane_stride;
            const int col0 = (u.pn & 1) * 256 + wc * 32 + 8 * fq;
#pragma unroll
            for (int ai = 0; ai < 2; ++ai)
#pragma unroll
                for (int m = 0; m < 4; ++m) { const int row = row0 + ai * HALF + m * 16; bf16_t* rowp = base + (size_t)row * 512 + col0;
#pragma unroll
                    for (int bj = 0; bj < 2; ++bj) { const f32x4 v0 = acc[ai][bj][m][0], v1 = acc[ai][bj][m][1];
                        u32x4 w; w.x = pkv(v0[0], v0[1]); w.y = pkv(v0[2], v0[3]); w.z = pkv(v1[0], v1[1]); w.w = pkv(v1[2], v1[3]);
                        *(u32x4*)(rowp + bj * HALF) = w; } }
        }
    }
};
struct EpiGate {
    static constexpr bool PERM = true, AFTER_DRAIN = false;
    bf16_t* gates; size_t plane_stride;
    __device__ __forceinline__ void operator()(const f32x4 (&acc)[2][2][4][2], const Unit& u, int wr, int wc, int fr, int fq) const {
        const int row0 = u.pm * BM + wr * 64 + fr;
        bf16_t* base = gates + (size_t)(u.pn >> 2) * plane_stride;
        const int col0 = (u.pn & 3) * 256 + wc * 32 + 8 * fq;
#pragma unroll
        for (int ai = 0; ai < 2; ++ai)
#pragma unroll
            for (int m = 0; m < 4; ++m) { const int row = row0 + ai * HALF + m * 16; bf16_t* rowp = base + (size_t)row * 1024 + col0;
#pragma unroll
                for (int bj = 0; bj < 2; ++bj) { f32x4 v0 = acc[ai][bj][m][0], v1 = acc[ai][bj][m][1];
#pragma unroll
                    for (int e = 0; e < 4; ++e) { v0[e] = sigm(v0[e]); v1[e] = sigm(v1[e]); }
                    u32x4 w; w.x = pkv(v0[0], v0[1]); w.y = pkv(v0[2], v0[3]); w.z = pkv(v1[0], v1[1]); w.w = pkv(v1[2], v1[3]);
                    *(u32x4*)(rowp + bj * HALF) = w; } }
    }
};
struct EpiMerge {
    static constexpr bool PERM = true, AFTER_DRAIN = false;
    bf16_t* out; const bf16_t* gates; size_t gate_stride;
    __device__ __forceinline__ void operator()(const f32x4 (&acc)[2][2][4][2], const Unit& u, int wr, int wc, int fr, int fq) const {
        const int br = u.pm >= (MTOK / BM) ? 1 : 0;
        const int pm = u.pm - br * (MTOK / BM), pn = u.pn - br * 4;
        const int row0 = pm * BM + wr * 64 + fr, col0 = pn * 256 + wc * 32 + 8 * fq;
        const bf16_t* gb = gates + (size_t)br * gate_stride;
#pragma unroll
        for (int ai = 0; ai < 2; ++ai)
#pragma unroll
            for (int m = 0; m < 4; ++m) { const size_t off = (size_t)(row0 + ai * HALF + m * 16) * 1024 + col0;
#pragma unroll
                for (int bj = 0; bj < 2; ++bj) { const u32x4 g = *(const u32x4*)(gb + off + bj * HALF);
                    f32x4 v0 = acc[ai][bj][m][0], v1 = acc[ai][bj][m][1];
                    v0[0] *= bf_lo(g.x); v0[1] *= bf_hi(g.x); v0[2] *= bf_lo(g.y); v0[3] *= bf_hi(g.y);
                    v1[0] *= bf_lo(g.z); v1[1] *= bf_hi(g.z); v1[2] *= bf_lo(g.w); v1[3] *= bf_hi(g.w);
                    if (br) { const u32x4 p = *(const u32x4*)(out + off + bj * HALF);
                        v0[0] += bf_lo(p.x); v0[1] += bf_hi(p.x); v0[2] += bf_lo(p.y); v0[3] += bf_hi(p.y);
                        v1[0] += bf_lo(p.z); v1[1] += bf_hi(p.z); v1[2] += bf_lo(p.w); v1[3] += bf_hi(p.w); }
                    u32x4 w; w.x = pkv(v0[0], v0[1]); w.y = pkv(v0[2], v0[3]); w.z = pkv(v1[0], v1[1]); w.w = pkv(v1[2], v1[3]);
                    *(u32x4*)(out + off + bj * HALF) = w; } }
    }
};
struct PairOrder {
    StaticOrder so;
    __device__ __forceinline__ bool next(int i, Unit& u) const { Unit t; if (!so.next(i >> 1, t)) return false; const int br = i & 1; u.pm = t.pm + br * (MTOK / BM); u.pn = t.pn + br * 4; return true; }
    __device__ __forceinline__ void a_ready(const Unit&) const {}
    __device__ __forceinline__ void done(const Unit&) const {}
};
struct SplitOrder {
    StaticOrder so; int first, stride, count;
    __device__ __forceinline__ bool next(int i, Unit& u) const {
        if (i >= count) return false;
        int wgid = first + i * stride; { const int q = so.nwg / NXCD, r = so.nwg % NXCD, xcd = wgid % NXCD, off = wgid / NXCD; wgid = (xcd < r ? xcd * (q + 1) : r * (q + 1) + (xcd - r) * q) + off; }
        const int nig = WGM * so.nN, gid = wgid / nig, fm = gid * WGM, gsz = (so.nM - fm) < WGM ? (so.nM - fm) : WGM;
        u.pm = fm + ((wgid % nig) % gsz); u.pn = (wgid % nig) / gsz; return true;
    }
    __device__ __forceinline__ void a_ready(const Unit&) const {}
    __device__ __forceinline__ void done(const Unit&) const {}
};
struct PanelOrder {
    int pm;
    __device__ __forceinline__ bool next(int i, Unit& u) const { if (i >= 4) return false; u.pm = pm; u.pn = i; return true; }
    __device__ __forceinline__ void a_ready(const Unit&) const {}
    __device__ __forceinline__ void done(const Unit&) const {}
};
struct EpiSwiGLU {
    static constexpr bool PERM = true, AFTER_DRAIN = false;
    bf16_t* act;
    __device__ __forceinline__ void operator()(const f32x4 (&acc)[2][2][4][2], const Unit& u, int wr, int wc, int fr, int fq) const {
        const int row0 = u.pm * BM + wr * 64 + fr, col0 = u.pn * 128 + wc * 32 + 8 * fq;
#pragma unroll
        for (int ai = 0; ai < 2; ++ai)
#pragma unroll
            for (int m = 0; m < 4; ++m) { const int row = row0 + ai * HALF + m * 16;
                float o[8];
#pragma unroll
                for (int n = 0; n < 2; ++n)
#pragma unroll
                    for (int e = 0; e < 4; ++e) { const float g = acc[ai][0][m][n][e], uu = acc[ai][1][m][n][e]; o[n * 4 + e] = g * sigm(g) * uu; }
                u32x4 w; w.x = pkv(o[0], o[1]); w.y = pkv(o[2], o[3]); w.z = pkv(o[4], o[5]); w.w = pkv(o[6], o[7]);
                *(u32x4*)(act + (size_t)row * DFF + col0) = w; }
    }
};

template <class Epi, class Sched, bool ALIGN_EPI = false, bool SP2 = false>
__device__ __forceinline__ void gemm_phase(PG8_LAS unsigned char* lds, const Gemm g, const Sched& S, const Epi& E) {
    int tid_ = threadIdx.x; asm volatile("" : "+v"(tid_));
    const int tid = tid_, wid = __builtin_amdgcn_readfirstlane(tid >> 6), lane = tid & 63, wr = wid >> 2, wc = wid & 3, fr = lane & 15, fq = lane >> 4;
    const int K = g.K, nt = K / BK;
    unsigned voffA[2], voffB[2];
#pragma unroll
    for (int i = 0; i < 2; ++i) { int R, C; stage_rc(tid * 16 + i * 8192, R, C); const int Rb = Epi::PERM ? ((R & ~31) + perm32(R & 31)) : R;
        voffA[i] = (unsigned)(R * K + C) * 2u; voffB[i] = (unsigned)(Rb * K + C) * 2u; }
    const size_t kstep = (size_t)(BK * 2);
    const size_t hstep = (size_t)HALF * K * 2;
    const size_t tstep = 2 * hstep;
    const unsigned ldsw = (unsigned)wid * 1024u;
    const int aoff = lds_byte(wr * 64 + fr, fq * 8), boff = lds_byte(wc * 32 + fr, fq * 8);
#define PG8_SA(b, h) (((b) * 2 + (h)) * HTB)
#define PG8_SB(b, h) ((4 + (b) * 2 + (h)) * HTB)
#define PG8_STAGE(bufoff, gbase, voff) do { _Pragma("unroll") for (int _i = 0; _i < 2; ++_i) \
        __builtin_amdgcn_global_load_lds((const unsigned*)((const char*)(gbase) + (voff)[_i]), (PG8_LAS unsigned*)(lds + (bufoff) + ldsw + _i * 8192), 16, 0, 0); } while (0)
#define PG8_LDA(dst, b, h) do { _Pragma("unroll") for (int m = 0; m < 4; ++m) _Pragma("unroll") for (int k = 0; k < 2; ++k) dst[m][k] = *(const PG8_LAS bf16x8*)(lds + PG8_SA(b, h) + aoff + m * 2048 + k * 1024); } while (0)
#define PG8_LDB(dst, b, h) do { _Pragma("unroll") for (int n = 0; n < 2; ++n) _Pragma("unroll") for (int k = 0; k < 2; ++k) dst[n][k] = *(const PG8_LAS bf16x8*)(lds + PG8_SB(b, h) + boff + n * 2048 + k * 1024); } while (0)
#define PG8_MMA(ai, bj, At, Bt) do { __builtin_amdgcn_s_setprio(1); _Pragma("unroll") for (int m = 0; m < 4; ++m) _Pragma("unroll") for (int n = 0; n < 2; ++n) _Pragma("unroll") for (int k = 0; k < 2; ++k) \
        acc[ai][bj][m][n] = __builtin_amdgcn_mfma_f32_16x16x32_bf16(Bt[n][k], At[m][k], acc[ai][bj][m][n], 0, 0, 0); __builtin_amdgcn_s_setprio(0); } while (0)
#define PG8_WAIT_V(n) asm volatile("s_waitcnt vmcnt(" #n ")" ::: "memory")
#define PG8_WAIT_L(n) asm volatile("s_waitcnt lgkmcnt(" #n ")" ::: "memory")
#define PG8_BAR __builtin_amdgcn_s_barrier()
#define PG8_SCHED __builtin_amdgcn_sched_barrier(0)
    Unit cur, nxt; int ui = 0;
    if (!S.next(0, cur)) return;
    f32x4 acc[2][2][4][2];
#pragma unroll
    for (int a = 0; a < 2; ++a)
#pragma unroll
        for (int b = 0; b < 2; ++b)
#pragma unroll
            for (int m = 0; m < 4; ++m)
#pragma unroll
                for (int n = 0; n < 2; ++n) acc[a][b][m][n] = (f32x4){0.f, 0.f, 0.f, 0.f};
    bf16x8 At[4][2], B0[2][2], B1[2][2];
    const char* cA = (const char*)g.A + (size_t)cur.pm * tstep; const char* cB = (const char*)g.Bt + (size_t)cur.pn * tstep;
    S.a_ready(cur);
    if constexpr (SP2) {
        PG8_STAGE(PG8_SB(0, 0), cB, voffB); PG8_STAGE(PG8_SB(0, 1), cB + hstep, voffB); PG8_STAGE(PG8_SA(0, 0), cA, voffA); PG8_STAGE(PG8_SA(0, 1), cA + hstep, voffA);
        if (wr == 1) PG8_BAR;
        PG8_WAIT_V(2); PG8_BAR;
        PG8_STAGE(PG8_SB(1, 0), cB + kstep, voffB); PG8_STAGE(PG8_SA(1, 0), cA + kstep, voffA); PG8_STAGE(PG8_SB(1, 1), cB + hstep + kstep, voffB);
        PG8_WAIT_V(6); PG8_BAR;
    } else {
        PG8_STAGE(PG8_SB(0, 0), cB, voffB); PG8_STAGE(PG8_SA(0, 0), cA, voffA); PG8_STAGE(PG8_SB(0, 1), cB + hstep, voffB); PG8_STAGE(PG8_SA(0, 1), cA + hstep, voffA);
        if (wr == 1) PG8_BAR;
        PG8_WAIT_V(4); PG8_BAR;
        PG8_STAGE(PG8_SB(1, 0), cB + kstep, voffB); PG8_STAGE(PG8_SA(1, 0), cA + kstep, voffA); PG8_STAGE(PG8_SB(1, 1), cB + hstep + kstep, voffB);
        PG8_WAIT_V(6); PG8_BAR;
    }
    for (;;) {
        const bool has_next = S.next(ui + 1, nxt);
        const char* nA = has_next ? (const char*)g.A + (size_t)nxt.pm * tstep : cA; const char* nB = has_next ? (const char*)g.Bt + (size_t)nxt.pn * tstep : cB;
        for (int t = 0; t < nt; t += 2) {
            const bool last = (t == nt - 2);
            const char* a1 = cA + (size_t)(t + 1) * kstep;
            const char* a2 = last ? nA : cA + (size_t)(t + 2) * kstep; const char* b2 = last ? nB : cB + (size_t)(t + 2) * kstep;
            const char* a3 = a2 + kstep; const char* b3 = b2 + kstep;
            if (last && has_next) S.a_ready(nxt);
            if constexpr (SP2) {
            PG8_LDB(B0, 0, 0); PG8_LDB(B1, 0, 1); PG8_SCHED; PG8_LDA(At, 0, 0); PG8_STAGE(PG8_SA(1, 1), a1 + hstep, voffA);
            PG8_WAIT_V(8); PG8_WAIT_L(0); PG8_BAR; PG8_MMA(0, 0, At, B0); PG8_MMA(0, 1, At, B1); PG8_BAR; PG8_SCHED;
            PG8_LDA(At, 0, 1); PG8_STAGE(PG8_SB(0, 0), b2, voffB); PG8_STAGE(PG8_SB(0, 1), b2 + hstep, voffB); PG8_STAGE(PG8_SA(0, 0), a2, voffA);
            PG8_WAIT_V(8); PG8_WAIT_L(0); PG8_BAR; PG8_MMA(1, 0, At, B0); PG8_MMA(1, 1, At, B1); PG8_BAR; PG8_SCHED;
            PG8_LDB(B0, 1, 0); PG8_LDB(B1, 1, 1); PG8_SCHED; PG8_LDA(At, 1, 0); PG8_STAGE(PG8_SA(0, 1), a2 + hstep, voffA);
            PG8_WAIT_V(8); PG8_WAIT_L(0); PG8_BAR; PG8_MMA(0, 0, At, B0); PG8_MMA(0, 1, At, B1); PG8_BAR; PG8_SCHED;
            PG8_LDA(At, 1, 1); PG8_STAGE(PG8_SB(1, 0), b3, voffB); PG8_STAGE(PG8_SB(1, 1), b3 + hstep, voffB); PG8_STAGE(PG8_SA(1, 0), a3, voffA);
            PG8_WAIT_V(8); PG8_WAIT_L(0); PG8_BAR; PG8_MMA(1, 0, At, B0); PG8_MMA(1, 1, At, B1); PG8_BAR; PG8_SCHED;
            } else {
            PG8_LDB(B0, 0, 0); PG8_SCHED; PG8_LDA(At, 0, 0); PG8_STAGE(PG8_SA(1, 1), a1 + hstep, voffA);
            PG8_WAIT_L(8); PG8_BAR; PG8_WAIT_L(0); PG8_MMA(0, 0, At, B0); PG8_BAR; PG8_SCHED;
            PG8_LDB(B1, 0, 1); PG8_STAGE(PG8_SB(0, 0), b2, voffB);
            PG8_BAR; PG8_WAIT_L(0); PG8_MMA(0, 1, At, B1); PG8_BAR;
            PG8_LDA(At, 0, 1); PG8_STAGE(PG8_SA(0, 0), a2, voffA);
            PG8_BAR; PG8_WAIT_L(0); PG8_MMA(1, 0, At, B0); PG8_BAR; PG8_SCHED;
            PG8_STAGE(PG8_SB(0, 1), b2 + hstep, voffB);
            PG8_WAIT_V(6); PG8_BAR; PG8_MMA(1, 1, At, B1); PG8_BAR;
            PG8_LDB(B0, 1, 0); PG8_SCHED; PG8_LDA(At, 1, 0); PG8_STAGE(PG8_SA(0, 1), a2 + hstep, voffA);
            PG8_WAIT_L(8); PG8_BAR; PG8_WAIT_L(0); PG8_MMA(0, 0, At, B0); PG8_BAR; PG8_SCHED;
            PG8_LDB(B1, 1, 1); PG8_STAGE(PG8_SB(1, 0), b3, voffB);
            PG8_BAR; PG8_WAIT_L(0); PG8_MMA(0, 1, At, B1); PG8_BAR;
            PG8_LDA(At, 1, 1); PG8_STAGE(PG8_SA(1, 0), a3, voffA);
            PG8_BAR; PG8_WAIT_L(0); PG8_MMA(1, 0, At, B0); PG8_BAR; PG8_SCHED;
            PG8_STAGE(PG8_SB(1, 1), b3 + hstep, voffB);
            PG8_WAIT_V(6); PG8_BAR; PG8_MMA(1, 1, At, B1); PG8_BAR;
            }
        }
        if constexpr (ALIGN_EPI) { if (wr == 0) PG8_BAR; }
        if constexpr (!Epi::AFTER_DRAIN) { E(acc, cur, wr, wc, fr, fq); S.done(cur); }
        if (!has_next) break;
#pragma unroll
        for (int a = 0; a < 2; ++a)
#pragma unroll
            for (int b = 0; b < 2; ++b)
#pragma unroll
                for (int m = 0; m < 4; ++m)
#pragma unroll
                    for (int n = 0; n < 2; ++n) acc[a][b][m][n] = (f32x4){0.f, 0.f, 0.f, 0.f};
        cur = nxt; cA = nA; cB = nB; ++ui;
        if constexpr (ALIGN_EPI) { if (wr == 1) PG8_BAR; }
    }
    PG8_WAIT_V(0);
    if constexpr (!ALIGN_EPI) { if (wr == 0) PG8_BAR; }
    PG8_BAR;
    if constexpr (Epi::AFTER_DRAIN) { E.fused(acc, cur, wr, wc, fr, fq, lds, wid, lane); S.done(cur); }
#undef PG8_SA
#undef PG8_SB
#undef PG8_STAGE
#undef PG8_LDA
#undef PG8_LDB
#undef PG8_MMA
#undef PG8_WAIT_V
#undef PG8_WAIT_L
#undef PG8_BAR
#undef PG8_SCHED
}
}

#ifndef PG8_SP2
#define PG8_SP2 true
#endif
#ifndef PG8_ALIGN
#define PG8_ALIGN true
#endif
constexpr int NWAVES = 8;
#ifndef MK_ONE_LAUNCH
#define MK_ONE_LAUNCH 0
#endif
constexpr int N_PHASES = 1 + 11 * DEPTH;

constexpr size_t MiB = 1u << 20;
constexpr size_t WS_CTL = 0, CTL_ZERO_BYTES = 1 * MiB;
constexpr size_t WS_W = 1 * MiB;
constexpr size_t W_INA = 0, W_INB = W_INA + (size_t)N_INA * DM, W_O2 = W_INB + (size_t)N_INB * DM, W_OUT = W_O2 + (size_t)2048 * 512,
                 W_GU = W_OUT + (size_t)DM * DM, W_DN = W_GU + (size_t)2 * DFF * DM, W_LAYER = W_DN + (size_t)DM * DFF;
static_assert(W_LAYER * 2 <= 33 * MiB, "weights per layer");
constexpr size_t WS_RSTD = 67 * MiB;
constexpr size_t WS_AB = 68 * MiB;
constexpr size_t WS_R = 72 * MiB;
constexpr size_t WS_P = 200 * MiB;
constexpr size_t PLANE = (size_t)MTOK * 512;
constexpr size_t WS_X = 712 * MiB;
constexpr size_t WS_GATES = 200 * MiB;
constexpr size_t WS_MERGED = 456 * MiB;
constexpr size_t WS_MIX = 584 * MiB;
constexpr size_t WS_ACT = 200 * MiB;
constexpr size_t WS_F = 584 * MiB;
constexpr size_t WS_END = 1004 * MiB;
constexpr int CW_BAR = 4096;

constexpr int LDS_BYTES = 163840;
constexpr int MISC_OFF = LDS_BYTES - 512;

#define GAS __attribute__((address_space(1)))
#define LAS __attribute__((address_space(3)))
typedef unsigned short bf16;
typedef unsigned v4u __attribute__((ext_vector_type(4)));
typedef unsigned v2u __attribute__((ext_vector_type(2)));
typedef float f32x4 __attribute__((ext_vector_type(4)));
typedef GAS unsigned gu32;
#define RLX_AGENT __ATOMIC_RELAXED, __HIP_MEMORY_SCOPE_AGENT
#define LDS_WAIT() asm volatile("s_waitcnt lgkmcnt(0)" ::: "memory")
#define VM_WAIT() asm volatile("s_waitcnt vmcnt(0)" ::: "memory")
typedef __bf16 bfv2_ __attribute__((ext_vector_type(2)));
typedef float fv2_ __attribute__((ext_vector_type(2)));
__device__ __forceinline__ unsigned pk2(float lo, float hi) { fv2_ v = {lo, hi}; bfv2_ r = __builtin_convertvector(v, bfv2_); return __builtin_bit_cast(unsigned, r); }
__device__ __forceinline__ unsigned f2bf(float f) { return pk2(f, 0.f) & 0xffffu; }
__device__ __forceinline__ float bflo(unsigned w) { return __builtin_bit_cast(float, w << 16); }
__device__ __forceinline__ float bfhi(unsigned w) { return __builtin_bit_cast(float, w & 0xffff0000u); }
__device__ __forceinline__ float bf1(bf16 b) { return __builtin_bit_cast(float, (unsigned)b << 16); }
__device__ __forceinline__ float sigmf(float x) { return __builtin_amdgcn_rcpf(1.f + __expf(-x)); }
__device__ __forceinline__ float wave_sum(float v) {
    v += __builtin_bit_cast(float, __builtin_amdgcn_update_dpp(0, __builtin_bit_cast(int, v), 0xB1, 0xF, 0xF, true));
    v += __builtin_bit_cast(float, __builtin_amdgcn_update_dpp(0, __builtin_bit_cast(int, v), 0x4E, 0xF, 0xF, true));
    v += __builtin_bit_cast(float, __builtin_amdgcn_update_dpp(0, __builtin_bit_cast(int, v), 0x141, 0xF, 0xF, true));
    v += __builtin_bit_cast(float, __builtin_amdgcn_update_dpp(0, __builtin_bit_cast(int, v), 0x140, 0xF, 0xF, true));
    const int vi = __builtin_bit_cast(int, v);
    return (__builtin_bit_cast(float, __builtin_amdgcn_readlane(vi, 0)) + __builtin_bit_cast(float, __builtin_amdgcn_readlane(vi, 16))) +
           (__builtin_bit_cast(float, __builtin_amdgcn_readlane(vi, 32)) + __builtin_bit_cast(float, __builtin_amdgcn_readlane(vi, 48)));
}
#define XB_TMO      128
#define XB_XCNT(j)  (256  + 64 * (j))
#define XB_XSUB(j)  (1280 + 64 * (j))
#define XB_XGEN(j)  (2304 + 64 * (j))
#define XB_TOP      3328
#define XB_TOPGEN   3392
#define XCD_BAR_WORDS 3456
#define XB_SPIN_CAP (1u << 18)

__device__ __forceinline__ unsigned xb_ld(unsigned* p)              { return __hip_atomic_load(p, __ATOMIC_RELAXED, __HIP_MEMORY_SCOPE_AGENT); }
__device__ __forceinline__ unsigned xb_add(unsigned* p, unsigned v) { return __hip_atomic_fetch_add(p, v, __ATOMIC_RELAXED, __HIP_MEMORY_SCOPE_AGENT); }
__device__ __forceinline__ unsigned xb_xcc_id() { return (unsigned)__builtin_amdgcn_s_getreg((3 << 11) | 20) & 0xFu; }
#define XB_SPIN(cond, bar) do { unsigned _sp = 0; while (cond) { __builtin_amdgcn_s_sleep(1); \
    if ((++_sp & 255u) == 0u) { if (xb_ld(&(bar)[XB_TMO])) break; if (_sp > XB_SPIN_CAP) { atomicAdd(&(bar)[XB_TMO], 1u); break; } } } } while (0)

struct XcdBarrier {
    unsigned* bar; unsigned x;
    volatile LAS unsigned* st;
};

__device__ __forceinline__ XcdBarrier xcd_barrier_post(unsigned* bar, volatile LAS unsigned* st) {
    XcdBarrier b; b.bar = bar; b.x = xb_xcc_id(); b.st = st;
    if (threadIdx.x == 0) (void)xb_add(&bar[XB_XCNT(b.x)], 1u);
    return b;
}
__device__ __forceinline__ void xcd_barrier_complete(unsigned* bar, unsigned x, unsigned& nloc, unsigned& nx) {
    const unsigned G = gridDim.x * gridDim.y * gridDim.z;
    unsigned sum, cnt, mine, sp = 0u;
    for (;;) {
        sum = 0u; cnt = 0u; mine = 0u;
#pragma unroll
        for (unsigned j = 0; j < 16; ++j) { const unsigned c = xb_ld(&bar[XB_XCNT(j)]); sum += c; cnt += (c > 0u) ? 1u : 0u; mine = (j == x) ? c : mine; }
        if (sum == G) break;
        __builtin_amdgcn_s_sleep(1);
        if ((++sp & 255u) == 0u) { if (xb_ld(&bar[XB_TMO])) break; if (sp > XB_SPIN_CAP) { atomicAdd(&bar[XB_TMO], 1u); break; } }
    }
    nloc = mine > 0u ? mine : 1u; nx = cnt > 0u ? cnt : 1u;
}

__device__ __forceinline__ void xcd_barrier(const XcdBarrier& b) {
    asm volatile("s_waitcnt vmcnt(0)" ::: "memory");
    __syncthreads();
    if (threadIdx.x == 0) {
        unsigned* bar = b.bar;
        __builtin_amdgcn_s_waitcnt(0);
        unsigned nloc = b.st[0], nx = b.st[1];
        if (nloc == 0u) { xcd_barrier_complete(bar, b.x, nloc, nx); b.st[0] = nloc; b.st[1] = nx; }
        const unsigned old = xb_add(&bar[XB_XSUB(b.x)], 1u);
        const unsigned gen = old / nloc;
        if (old + 1u == (gen + 1u) * nloc) {
            __builtin_amdgcn_fence(__ATOMIC_RELEASE, "agent");
            asm volatile("s_waitcnt vmcnt(0)" ::: "memory");
            const unsigned og = xb_add(&bar[XB_TOP], 1u);
            const unsigned tg = og / nx;
            if (og + 1u == (tg + 1u) * nx) xb_add(&bar[XB_TOPGEN], 1u);
            else XB_SPIN(xb_ld(&bar[XB_TOPGEN]) == tg, bar);
            __builtin_amdgcn_fence(__ATOMIC_ACQUIRE, "agent");
            xb_add(&bar[XB_XGEN(b.x)], 1u);
            asm volatile("s_waitcnt vmcnt(0)" ::: "memory");
        } else {
            XB_SPIN(xb_ld(&bar[XB_XGEN(b.x)]) == gen, bar);
            __builtin_amdgcn_fence(__ATOMIC_ACQUIRE, "agent");
            asm volatile("s_waitcnt vmcnt(0)" ::: "memory");
        }
    }
    __syncthreads();
}

struct Frame {
    LAS unsigned char* lds;
    volatile LAS unsigned* MISC;
    gu32* ctl;
    int tid, lane, wave, G;
    const float* in[17];
    float* out; unsigned char* ws;
};


typedef short bf16x8 __attribute__((ext_vector_type(8)));
typedef float f32x16 __attribute__((ext_vector_type(16)));
typedef __bf16 bfv2 __attribute__((ext_vector_type(2)));
typedef float fv2 __attribute__((ext_vector_type(2)));
#define MFMA32(a, b, c) __builtin_amdgcn_mfma_f32_32x32x16_bf16((a), (b), (c), 0, 0, 0)
__device__ __forceinline__ unsigned pkc(float a, float b) { fv2 v = {a, b}; bfv2 r = __builtin_convertvector(v, bfv2); return __builtin_bit_cast(unsigned, r); }
__device__ __forceinline__ bf16x8 pack_half(const f32x16& x, int s) {
    v4u p; p.x = pkc(x[8 * s + 0], x[8 * s + 1]); p.y = pkc(x[8 * s + 2], x[8 * s + 3]); p.z = pkc(x[8 * s + 4], x[8 * s + 5]); p.w = pkc(x[8 * s + 6], x[8 * s + 7]);
    return __builtin_bit_cast(bf16x8, p);
}
__device__ __forceinline__ f32x16 zero16() { f32x16 z;
#pragma unroll
    for (int i = 0; i < 16; ++i) z[i] = 0.f; return z; }
__device__ __forceinline__ bf16x8 lds_frag(const LAS unsigned char* p) { return __builtin_bit_cast(bf16x8, *(const LAS v4u*)p); }

constexpr int NUNIT = BATCH * (SEQ / 64) * NHEAD;
constexpr size_t HG1_UNIT = 32768, HG2_UNIT = 25600;
constexpr size_t DN_UNIT = 74752;
constexpr size_t WS_DNB = 712 * MiB;
#ifdef DN_REF
constexpr size_t WS_ORAW = 712 * MiB;
#else
constexpr size_t WS_ORAW = 456 * MiB;
#endif
constexpr int PQ = 272, PT = 144;

struct HgRaw { unsigned q[8], f[8], i[8]; };
__device__ __forceinline__ void hg_raw_load(HgRaw& a, Frame& F, int unit, int lane) {
    const int h = unit & 3, n = (unit >> 2) & 127, b = unit >> 9; const size_t row0 = (size_t)b * SEQ + 64 * n;
    const bf16* P0 = (const bf16*)(F.ws + WS_P); const bf16* P1 = P0 + PLANE; const bf16* P2 = P1 + PLANE;
#pragma unroll
    for (int i = 0; i < 8; ++i) { const size_t off = (row0 + 8 * F.wave + i) * 512 + 128 * h + 2 * lane;
        a.q[i] = *(const GAS unsigned*)(P0 + off); a.f[i] = *(const GAS unsigned*)(P1 + off); a.i[i] = *(const GAS unsigned*)(P2 + off); }
}
__device__ __forceinline__ void prep_hg_unit(Frame& F, int l, int unit, const HgRaw& raw) {
    const int h = unit & 3, n = (unit >> 2) & 127, b = unit >> 9;
    const size_t row0 = (size_t)b * SEQ + 64 * n;
    LAS unsigned char* L = F.lds;
    LAS float* TOT = (LAS float*)L;
    LAS unsigned char* QT = L + 4096; LAS unsigned char* KT = QT + 64 * PQ; LAS unsigned char* QSR = KT + 64 * PQ;
    LAS unsigned char* KHT = QSR + 64 * PQ; LAS unsigned char* VI = KHT + 128 * PT; LAS unsigned char* ATT = VI + 64 * PQ;
    const bf16* P0 = (const bf16*)(F.ws + WS_P); const bf16* P1 = P0 + PLANE; const bf16* P2 = P1 + PLANE;
    unsigned char* part1 = (unsigned char*)F.out + 128 * MiB + (size_t)unit * HG1_UNIT;
    unsigned char* part2 = (unsigned char*)F.out + (size_t)unit * HG2_UNIT;
    const int w = F.wave; int lane = F.lane; asm volatile("" : "+v"(lane));
    const int d0 = 2 * lane;
    float lb[2] = {0.f, 0.f};
    if (l == 1) { lb[0] = sigmf(F.in[1][512 + 128 * h + d0] - F.in[1][128 * h + d0]); lb[1] = sigmf(F.in[1][512 + 128 * h + d0 + 1] - F.in[1][128 * h + d0 + 1]); }
    float q[8][2], kk[8][2], cs[8][2];
    {
        float run[2] = {0.f, 0.f};
#pragma unroll
        for (int i = 0; i < 8; ++i) {
            const unsigned qv = raw.q[i], fv = raw.f[i], iv = raw.i[i];
            *(LAS unsigned*)(VI + (8 * w + i) * PQ + 2 * d0) = iv;
            q[i][0] = bflo(qv); q[i][1] = bfhi(qv);
            const float fl[2] = {bflo(fv), bfhi(fv)};
#pragma unroll
            for (int e = 0; e < 2; ++e) { const float sg = sigmf(fl[e]); const float f = lb[e] + (1.f - lb[e]) * sg; kk[i][e] = (1.f - lb[e]) * (1.f - sg);
                run[e] += __logf(f); cs[i][e] = run[e]; } }
        TOT[w * 128 + d0] = run[0]; TOT[w * 128 + d0 + 1] = run[1];
    }
    __syncthreads();
    {
        float off[2] = {0.f, 0.f}, bref[2] = {0.f, 0.f}, blast[2] = {0.f, 0.f};
#pragma unroll
        for (int ww = 0; ww < 8; ++ww) { const float t0 = TOT[ww * 128 + d0], t1 = TOT[ww * 128 + d0 + 1];
            if (ww < w) { off[0] += t0; off[1] += t1; } if (ww < 4) { bref[0] += t0; bref[1] += t1; } blast[0] += t0; blast[1] += t1; }
        unsigned kh[2][4];
#pragma unroll
        for (int i = 0; i < 8; ++i) { float qt[2], kt[2], qs[2], kh_[2];
#pragma unroll
            for (int e = 0; e < 2; ++e) { const float bb = off[e] + cs[i][e];
                qt[e] = q[i][e] * __expf(fminf(bb - bref[e], 80.f)); kt[e] = kk[i][e] * __expf(fminf(bref[e] - bb, 80.f));
                qs[e] = q[i][e] * __expf(bb); kh_[e] = kk[i][e] * __expf(blast[e] - bb); }
            const int t = 8 * w + i;
            *(LAS unsigned*)(QT + t * PQ + 2 * d0) = pk2(qt[0], qt[1]); *(LAS unsigned*)(KT + t * PQ + 2 * d0) = pk2(kt[0], kt[1]); *(LAS unsigned*)(QSR + t * PQ + 2 * d0) = pk2(qs[0], qs[1]);
            if (i & 1) { kh[0][i >> 1] |= f2bf(kh_[0]) << 16; kh[1][i >> 1] |= f2bf(kh_[1]) << 16; } else { kh[0][i >> 1] = f2bf(kh_[0]); kh[1][i >> 1] = f2bf(kh_[1]); } }
        *(LAS v4u*)(KHT + d0 * PT + 16 * w) = (v4u){kh[0][0], kh[0][1], kh[0][2], kh[0][3]};
        *(LAS v4u*)(KHT + (d0 + 1) * PT + 16 * w) = (v4u){kh[1][0], kh[1][1], kh[1][2], kh[1][3]};
        if (w == 0) { *(GAS fv2*)(part2 + 8192 + 4 * d0) = (fv2){__expf(blast[0]), __expf(blast[1])}; }
    }
    __syncthreads();
    const int r = lane & 31, hg = lane >> 5;
    if (w < 3) {
        const int m = w >= 1 ? 1 : 0, mp = w == 2 ? 1 : 0;
        f32x16 acc = zero16();
#pragma unroll
        for (int ks = 0; ks < 8; ++ks) acc = MFMA32(lds_frag(QT + (32 * m + r) * PQ + 32 * ks + 16 * hg), lds_frag(KT + (32 * mp + r) * PQ + 32 * ks + 16 * hg), acc);
#pragma unroll
        for (int i = 0; i < 16; ++i) { const int ii = 32 * m + (i & 3) + 8 * (i >> 2) + 4 * hg, jj = 32 * mp + r;
            *(LAS bf16*)(ATT + ii * PT + 2 * jj) = (bf16)f2bf((jj <= ii ? 1.f : 0.f) * acc[i]); }
    } else if (w == 3) {
#pragma unroll
        for (int i = 0; i < 16; ++i) *(LAS bf16*)(ATT + (2 * i + hg) * PT + 2 * (32 + r)) = 0;
    }
    __syncthreads();
#pragma unroll
    for (int i = 0; i < 2; ++i) { const int f = w + 8 * i, m = f >> 3, kt = f & 7;
        const LAS unsigned char* src = QSR + (32 * m + r) * PQ + 2 * (16 * kt + 4 * hg);
        const v2u a = *(const LAS v2u*)src, c = *(const LAS v2u*)(src + 16);
        *(GAS v4u*)(part1 + f * 1024 + lane * 16) = (v4u){a.x, a.y, c.x, c.y}; }
#pragma unroll
    for (int i = 0; i < 2; ++i) { const int f = w + 8 * i, t4 = f >> 2, ktp = f & 3;
        *(GAS v4u*)(part1 + 16384 + f * 1024 + lane * 16) = *(const LAS v4u*)(KHT + (32 * t4 + r) * PT + 2 * (16 * ktp + 8 * hg)); }
    { const int f = w, m = f >> 2, ktp = f & 3;
        *(GAS v4u*)(part2 + f * 1024 + lane * 16) = *(const LAS v4u*)(ATT + (32 * m + r) * PT + 2 * (16 * ktp + 8 * hg)); }
#pragma unroll
    for (int i = 0; i < 2; ++i) { const int f = w + 8 * i, sl = f >> 2, ktp = f & 3;
        unsigned short e[8];
#pragma unroll
        for (int j = 0; j < 8; ++j) e[j] = *(const LAS bf16*)(VI + (16 * ktp + 8 * hg + j) * PQ + 2 * (32 * sl + r));
        *(GAS v4u*)(part2 + 9216 + f * 1024 + lane * 16) = (v4u){(unsigned)e[0] | ((unsigned)e[1] << 16), (unsigned)e[2] | ((unsigned)e[3] << 16), (unsigned)e[4] | ((unsigned)e[5] << 16), (unsigned)e[6] | ((unsigned)e[7] << 16)}; }
    __syncthreads();
}

__device__ __forceinline__ void scan_hg_chain(Frame& F, int bh, int sl0) {
    const int sl = sl0 + (F.wave & 1);
    const int b = bh >> 2, h = bh & 3;
    bf16* oraw = (bf16*)(F.ws + WS_ORAW);
    f32x16 S[4];
#pragma unroll
    for (int t = 0; t < 4; ++t) S[t] = zero16();
#define HG_ISSUE(nn, bufo) do { const int unit_ = (b * 128 + (nn)) * 4 + h; \
        const unsigned char* p1_ = (const unsigned char*)F.out + 128 * MiB + (size_t)unit_ * HG1_UNIT; const unsigned char* p2_ = (const unsigned char*)F.out + (size_t)unit_ * HG2_UNIT; \
        for (int f = F.wave - 2; f < 49; f += 6) { const unsigned char* src = f < 32 ? p1_ + f * 1024 : (f < 41 ? p2_ + (f - 32) * 1024 : p2_ + 9216 + (sl0 + ((f - 41) >> 2)) * 4096 + ((f - 41) & 3) * 1024); \
            __builtin_amdgcn_global_load_lds((const unsigned*)(src + lane * 16), (LAS unsigned*)(F.lds + (bufo) + f * 1024), 16, 0, 0); } } while (0)
    { const int lane = F.lane; if (F.wave >= 2) HG_ISSUE(0, 0); }
    for (int n = 0; n < SEQ / 64; ++n) {
        int lane = F.lane; asm volatile("" : "+v"(lane));
        const int r = lane & 31, hg = lane >> 5;
        LAS unsigned char* L = F.lds + (n & 1) * 66560;
        if (F.wave >= 2) asm volatile("s_waitcnt vmcnt(0)" ::: "memory");
        __syncthreads();
        if (F.wave >= 2 && n + 1 < SEQ / 64) HG_ISSUE(n + 1, ((n + 1) & 1) * 66560);
        if (F.wave < 2) {
            const size_t row0 = (size_t)b * SEQ + 64 * n;
            const LAS unsigned char* Lp = L + lane * 16;
            bf16x8 bs[8];
#pragma unroll
            for (int kt = 0; kt < 8; ++kt) bs[kt] = pack_half(S[kt >> 1], kt & 1);
            bf16x8 bv[4];
#pragma unroll
            for (int kt = 0; kt < 4; ++kt) bv[kt] = lds_frag(Lp + 41984 + (F.wave & 1) * 4096 + kt * 1024);
            f32x16 o[2] = {zero16(), zero16()};
#define HG_DECAY(t4) do { _Pragma("unroll") for (int g = 0; g < 4; ++g) { const f32x4 dc = *(const LAS f32x4*)(L + 40960 + 4 * (32 * (t4) + 8 * g + 4 * hg)); \
                _Pragma("unroll") for (int e = 0; e < 4; ++e) S[t4][4 * g + e] *= dc[e]; } } while (0)
            bf16x8 rg0 = lds_frag(Lp + 0);
            bf16x8 rg1 = lds_frag(Lp + 1024);
            bf16x8 rg2 = lds_frag(Lp + 2048);
            bf16x8 rg3 = lds_frag(Lp + 3072);
            bf16x8 rg4 = lds_frag(Lp + 4096);
            bf16x8 rg5 = lds_frag(Lp + 5120);
            bf16x8 rg6 = lds_frag(Lp + 6144);
            bf16x8 rg7 = lds_frag(Lp + 7168);
            { const bf16x8 a = rg0; rg0 = lds_frag(Lp + 8192);
              o[0] = MFMA32(a, bs[0], o[0]); }
            __builtin_amdgcn_sched_barrier(0);
            { const bf16x8 a = rg1; rg1 = lds_frag(Lp + 9216);
              o[0] = MFMA32(a, bs[1], o[0]); }
            __builtin_amdgcn_sched_barrier(0);
            { const bf16x8 a = rg2; rg2 = lds_frag(Lp + 10240);
              o[0] = MFMA32(a, bs[2], o[0]); }
            __builtin_amdgcn_sched_barrier(0);
            { const bf16x8 a = rg3; rg3 = lds_frag(Lp + 11264);
              o[0] = MFMA32(a, bs[3], o[0]); }
            __builtin_amdgcn_sched_barrier(0);
            { const bf16x8 a = rg4; rg4 = lds_frag(Lp + 12288);
              o[0] = MFMA32(a, bs[4], o[0]); }
            __builtin_amdgcn_sched_barrier(0);
            { const bf16x8 a = rg5; rg5 = lds_frag(Lp + 13312);
              o[0] = MFMA32(a, bs[5], o[0]); }
            __builtin_amdgcn_sched_barrier(0);
            { const bf16x8 a = rg6; rg6 = lds_frag(Lp + 14336);
              o[0] = MFMA32(a, bs[6], o[0]); }
            __builtin_amdgcn_sched_barrier(0);
            { const bf16x8 a = rg7; rg7 = lds_frag(Lp + 15360);
              o[0] = MFMA32(a, bs[7], o[0]); }
            __builtin_amdgcn_sched_barrier(0);
            { const bf16x8 a = rg0; rg0 = lds_frag(Lp + 32768);
              o[1] = MFMA32(a, bs[0], o[1]); }
            __builtin_amdgcn_sched_barrier(0);
            { const bf16x8 a = rg1; rg1 = lds_frag(Lp + 33792);
              o[1] = MFMA32(a, bs[1], o[1]); }
            __builtin_amdgcn_sched_barrier(0);
            { const bf16x8 a = rg2; rg2 = lds_frag(Lp + 36864);
              o[1] = MFMA32(a, bs[2], o[1]); }
            __builtin_amdgcn_sched_barrier(0);
            { const bf16x8 a = rg3; rg3 = lds_frag(Lp + 37888);
              o[1] = MFMA32(a, bs[3], o[1]); }
            __builtin_amdgcn_sched_barrier(0);
            { const bf16x8 a = rg4; rg4 = lds_frag(Lp + 38912);
              o[1] = MFMA32(a, bs[4], o[1]); }
            __builtin_amdgcn_sched_barrier(0);
            { const bf16x8 a = rg5; rg5 = lds_frag(Lp + 39936);
              o[1] = MFMA32(a, bs[5], o[1]); }
            __builtin_amdgcn_sched_barrier(0);
            { const bf16x8 a = rg6; rg6 = lds_frag(Lp + 16384);
              o[1] = MFMA32(a, bs[6], o[1]); }
            __builtin_amdgcn_sched_barrier(0);
            { const bf16x8 a = rg7; rg7 = lds_frag(Lp + 17408);
              o[1] = MFMA32(a, bs[7], o[1]); }
            __builtin_amdgcn_sched_barrier(0);
            { const bf16x8 a = rg0; rg0 = lds_frag(Lp + 18432);
              o[0] = MFMA32(a, bv[0], o[0]); }
            __builtin_amdgcn_sched_barrier(0);
            { const bf16x8 a = rg1; rg1 = lds_frag(Lp + 19456);
              o[0] = MFMA32(a, bv[1], o[0]); }
            __builtin_amdgcn_sched_barrier(0);
            { const bf16x8 a = rg2; rg2 = lds_frag(Lp + 20480);
              o[1] = MFMA32(a, bv[0], o[1]); }
            __builtin_amdgcn_sched_barrier(0);
            { const bf16x8 a = rg3; rg3 = lds_frag(Lp + 21504);
              o[1] = MFMA32(a, bv[1], o[1]); }
            __builtin_amdgcn_sched_barrier(0);
            { const bf16x8 a = rg4; rg4 = lds_frag(Lp + 22528);
              o[1] = MFMA32(a, bv[2], o[1]); }
            __builtin_amdgcn_sched_barrier(0);
            { const bf16x8 a = rg5; rg5 = lds_frag(Lp + 23552);
              o[1] = MFMA32(a, bv[3], o[1]); }
            __builtin_amdgcn_sched_barrier(0);
            { const bf16x8 a = rg6; rg6 = lds_frag(Lp + 24576);
              HG_DECAY(0);
              S[0] = MFMA32(a, bv[0], S[0]); }
            __builtin_amdgcn_sched_barrier(0);
            { const bf16x8 a = rg7; rg7 = lds_frag(Lp + 25600);
              S[0] = MFMA32(a, bv[1], S[0]); }
            __builtin_amdgcn_sched_barrier(0);
            { const bf16x8 a = rg0; rg0 = lds_frag(Lp + 26624);
              S[0] = MFMA32(a, bv[2], S[0]); }
            __builtin_amdgcn_sched_barrier(0);
            { const bf16x8 a = rg1; rg1 = lds_frag(Lp + 27648);
              S[0] = MFMA32(a, bv[3], S[0]); }
            __builtin_amdgcn_sched_barrier(0);
            { const bf16x8 a = rg2; rg2 = lds_frag(Lp + 28672);
              HG_DECAY(1);
              S[1] = MFMA32(a, bv[0], S[1]); }
            __builtin_amdgcn_sched_barrier(0);
            { const bf16x8 a = rg3; rg3 = lds_frag(Lp + 29696);
              S[1] = MFMA32(a, bv[1], S[1]); }
            __builtin_amdgcn_sched_barrier(0);
            { const bf16x8 a = rg4; rg4 = lds_frag(Lp + 30720);
              S[1] = MFMA32(a, bv[2], S[1]); }
            __builtin_amdgcn_sched_barrier(0);
            { const bf16x8 a = rg5; rg5 = lds_frag(Lp + 31744);
              S[1] = MFMA32(a, bv[3], S[1]); }
            __builtin_amdgcn_sched_barrier(0);
            { const bf16x8 a = rg6;
              HG_DECAY(2);
              S[2] = MFMA32(a, bv[0], S[2]); }
            __builtin_amdgcn_sched_barrier(0);
            { const bf16x8 a = rg7;
              S[2] = MFMA32(a, bv[1], S[2]); }
            __builtin_amdgcn_sched_barrier(0);
            { const bf16x8 a = rg0;
              S[2] = MFMA32(a, bv[2], S[2]); }
            __builtin_amdgcn_sched_barrier(0);
            { const bf16x8 a = rg1;
              S[2] = MFMA32(a, bv[3], S[2]); }
            __builtin_amdgcn_sched_barrier(0);
            { const bf16x8 a = rg2;
              HG_DECAY(3);
              S[3] = MFMA32(a, bv[0], S[3]); }
            __builtin_amdgcn_sched_barrier(0);
            { const bf16x8 a = rg3;
              S[3] = MFMA32(a, bv[1], S[3]); }
            __builtin_amdgcn_sched_barrier(0);
            { const bf16x8 a = rg4;
              S[3] = MFMA32(a, bv[2], S[3]); }
            __builtin_amdgcn_sched_barrier(0);
            { const bf16x8 a = rg5;
              S[3] = MFMA32(a, bv[3], S[3]); }
            __builtin_amdgcn_sched_barrier(0);
#undef HG_DECAY
#pragma unroll
            for (int m = 0; m < 2; ++m)
#pragma unroll
                for (int i = 0; i < 16; ++i) oraw[(row0 + 32 * m + (i & 3) + 8 * (i >> 2) + 4 * hg) * 512 + 128 * h + 32 * sl + r] = (bf16)f2bf(o[m][i]);
        }
    }
    __syncthreads();
}

__device__ __forceinline__ float softplus2(float x) { return x > 20.f ? x : log1pf(__expf(x)); }
#define MFMA16F(a, b, c) __builtin_amdgcn_mfma_f32_16x16x4f32((a), (b), (c), 0, 0, 0)
struct DnRaw { v4u q[3], k[3], v[3]; float a, bl; };
__device__ __forceinline__ void dn_raw_load(DnRaw& r, Frame& F, int unit, int tid, int lane) {
    const int h = unit & 3, n = (unit >> 2) & 127, b = unit >> 9; const size_t row0 = (size_t)b * SEQ + 64 * n;
    const bf16* P4 = (const bf16*)(F.ws + WS_P) + 4 * PLANE; const bf16* P5 = P4 + PLANE; const bf16* P6 = (const bf16*)(F.ws + WS_P) + 3 * PLANE;
#pragma unroll
    for (int i = 0; i < 3; ++i) { const int idx = tid + 512 * i, rr = idx >> 4, d8 = (idx & 15) * 8;
        v4u qv = (v4u){0u, 0u, 0u, 0u}, kv = qv, vv = qv;
        if (idx < 67 * 16 && 64 * n + rr >= 3) { const size_t off = (row0 + rr - 3) * 512 + 128 * h + d8; qv = *(const GAS v4u*)(P4 + off); kv = *(const GAS v4u*)(P5 + off); vv = *(const GAS v4u*)(P6 + off); }
        r.q[i] = qv; r.k[i] = kv; r.v[i] = vv; }
    const float* ab = (const float*)(F.ws + WS_AB);
    r.a = ab[(row0 + lane) * 8 + h]; r.bl = ab[(row0 + lane) * 8 + 4 + h];
}
__device__ __forceinline__ void prep_dn_unit(Frame& F, int l, int unit, const DnRaw& raw) {
    const int h = unit & 3, n = (unit >> 2) & 127, b = unit >> 9;
    const size_t row0 = (size_t)b * SEQ + 64 * n;
    LAS unsigned char* L = F.lds;
    LAS unsigned char* RQ = L; LAS unsigned char* RK = L + 17152; LAS unsigned char* RV = L + 34304;
    LAS float* AM = (LAS float*)L; LAS float* TM = (LAS float*)(L + 17408); LAS unsigned char* TB = L; LAS unsigned char* ATT = L + 34816;
    LAS unsigned char* QN = L + 51456; LAS unsigned char* KN = L + 68864; LAS unsigned char* QG = L + 86272; LAS unsigned char* WN = QN;
    LAS unsigned char* XT = L + 103680; LAS unsigned char* VT = L + 122112; LAS unsigned char* KDT = L + 140544;
    LAS float* GCA = (LAS float*)(L + 158976); LAS float* BEA = (LAS float*)(L + 159232);
    const bf16* P4 = (const bf16*)(F.ws + WS_P) + 4 * PLANE; const bf16* P5 = P4 + PLANE; const bf16* P6 = (const bf16*)(F.ws + WS_P) + 3 * PLANE;
    const float* ab = (const float*)(F.ws + WS_AB);
    unsigned char* ub = F.ws + WS_DNB + (size_t)unit * DN_UNIT;
    const int w = F.wave; int lane = F.lane; asm volatile("" : "+v"(lane));
    const int d0 = 2 * lane, r = lane & 31, hg = lane >> 5;
#pragma unroll
    for (int i = 0; i < 3; ++i) { const int idx = F.tid + 512 * i, rr = idx >> 4, d8 = (idx & 15) * 8;
        if (idx < 67 * 16) { *(LAS v4u*)(RQ + rr * 256 + 2 * d8) = raw.q[i]; *(LAS v4u*)(RK + rr * 256 + 2 * d8) = raw.k[i]; *(LAS v4u*)(RV + rr * 256 + 2 * d8) = raw.v[i]; } }
    float gc, beta;
    { const float a = raw.a, bl = raw.bl;
      float x = -__expf(F.in[6][l * NHEAD + h]) * softplus2(a + F.in[7][l * NHEAD + h]);
#pragma unroll
      for (int o = 1; o < 64; o <<= 1) { const float y = __shfl_up(x, o); if (lane >= o) x += y; }
      gc = x; beta = sigmf(bl);
      if (w == 0) { GCA[lane] = gc; BEA[lane] = beta; } }
    const float glast = __shfl(gc, 63);
    __syncthreads();
    {
        const float* cw = F.in[5] + (size_t)l * CONVW * CONVC + 128 * h + d0;
        float cwq[4][2], cwk[4][2], cwv[4][2];
#pragma unroll
        for (int j = 0; j < 4; ++j) { cwq[j][0] = cw[j * CONVC]; cwq[j][1] = cw[j * CONVC + 1]; cwk[j][0] = cw[j * CONVC + 512]; cwk[j][1] = cw[j * CONVC + 513]; cwv[j][0] = cw[j * CONVC + 1024]; cwv[j][1] = cw[j * CONVC + 1025]; }
        unsigned rq[11], rk[11], rv[11];
#pragma unroll
        for (int i = 0; i < 11; ++i) { rq[i] = *(const LAS unsigned*)(RQ + (8 * w + i) * 256 + 2 * d0); rk[i] = *(const LAS unsigned*)(RK + (8 * w + i) * 256 + 2 * d0); rv[i] = *(const LAS unsigned*)(RV + (8 * w + i) * 256 + 2 * d0); }
        unsigned xt[2][4], vt[2][4], kd[2][4];
#pragma unroll
        for (int i = 0; i < 8; ++i) {
            float cq[2] = {0.f, 0.f}, ck[2] = {0.f, 0.f}, cv[2] = {0.f, 0.f};
#pragma unroll
            for (int j = 0; j < 4; ++j) { cq[0] += cwq[j][0] * bflo(rq[i + j]); cq[1] += cwq[j][1] * bfhi(rq[i + j]); ck[0] += cwk[j][0] * bflo(rk[i + j]); ck[1] += cwk[j][1] * bfhi(rk[i + j]);
                cv[0] += cwv[j][0] * bflo(rv[i + j]); cv[1] += cwv[j][1] * bfhi(rv[i + j]); }
#pragma unroll
            for (int e = 0; e < 2; ++e) { cq[e] *= sigmf(cq[e]); ck[e] *= sigmf(ck[e]); cv[e] *= sigmf(cv[e]); }
            const float sq = wave_sum(cq[0] * cq[0] + cq[1] * cq[1]), sk = wave_sum(ck[0] * ck[0] + ck[1] * ck[1]);
            const float rqn = __builtin_amdgcn_rsqf(sq + EPSF) * 0.08838834764831845f, rkn = __builtin_amdgcn_rsqf(sk + EPSF);
            const int t = 8 * w + i;
            const float gci = __shfl(gc, t), bei = __shfl(beta, t);
            const float eg = __expf(gci), ed = __expf(glast - gci);
            const float q0 = cq[0] * rqn, q1 = cq[1] * rqn, k0 = ck[0] * rkn, k1 = ck[1] * rkn;
            *(LAS unsigned*)(QN + t * PQ + 2 * d0) = pk2(q0, q1); *(LAS unsigned*)(KN + t * PQ + 2 * d0) = pk2(k0, k1); *(LAS unsigned*)(QG + t * PQ + 2 * d0) = pk2(q0 * eg, q1 * eg);
            const unsigned x0 = f2bf(k0 * bei * eg), x1 = f2bf(k1 * bei * eg), v0 = f2bf(cv[0] * bei), v1 = f2bf(cv[1] * bei), e0 = f2bf(k0 * ed), e1 = f2bf(k1 * ed);
            if (i & 1) { xt[0][i >> 1] |= x0 << 16; xt[1][i >> 1] |= x1 << 16; vt[0][i >> 1] |= v0 << 16; vt[1][i >> 1] |= v1 << 16; kd[0][i >> 1] |= e0 << 16; kd[1][i >> 1] |= e1 << 16; }
            else { xt[0][i >> 1] = x0; xt[1][i >> 1] = x1; vt[0][i >> 1] = v0; vt[1][i >> 1] = v1; kd[0][i >> 1] = e0; kd[1][i >> 1] = e1; }
        }
#pragma unroll
        for (int e = 0; e < 2; ++e) {
            *(LAS v4u*)(XT + (d0 + e) * PT + 16 * w) = (v4u){xt[e][0], xt[e][1], xt[e][2], xt[e][3]};
            *(LAS v4u*)(VT + (d0 + e) * PT + 16 * w) = (v4u){vt[e][0], vt[e][1], vt[e][2], vt[e][3]};
            *(LAS v4u*)(KDT + (d0 + e) * PT + 16 * w) = (v4u){kd[e][0], kd[e][1], kd[e][2], kd[e][3]}; }
    }
    __syncthreads();
    if (w < 6) {
        const int tsel = w % 3, m = tsel >= 1 ? 1 : 0, mp = tsel == 2 ? 1 : 0;
        const LAS unsigned char* Asrc = w < 3 ? KN : QN;
        f32x16 acc = zero16();
#pragma unroll
        for (int ks = 0; ks < 8; ++ks) acc = MFMA32(lds_frag(Asrc + (32 * m + r) * PQ + 32 * ks + 16 * hg), lds_frag(KN + (32 * mp + r) * PQ + 32 * ks + 16 * hg), acc);
        const int jj = 32 * mp + r; const float gj = GCA[jj];
#pragma unroll
        for (int i = 0; i < 16; ++i) { const int ii = 32 * m + (i & 3) + 8 * (i >> 2) + 4 * hg; const float gi = GCA[ii];
            const float bei = BEA[ii], ex = __expf(fminf(gi - gj, 0.f));
            const float va = (jj < ii ? 1.f : 0.f) * (acc[i] * bei * ex), vq = (jj <= ii ? 1.f : 0.f) * (acc[i] * ex);
            if (w < 3) AM[ii * 68 + jj] = va; else *(LAS bf16*)(ATT + ii * PT + 2 * jj) = (bf16)f2bf(vq); }
    } else if (w == 6) {
#pragma unroll
        for (int i = 0; i < 16; ++i) *(LAS bf16*)(ATT + (2 * i + hg) * PT + 2 * (32 + r)) = 0;
    }
    __syncthreads();
    if (w == 0) {
        const int kb = lane >> 4, c = lane & 15;
        float x[16];
#pragma unroll
        for (int i = 0; i < 16; ++i) { float s = (i == c) ? 1.f : 0.f;
#pragma unroll
            for (int j4 = 0; j4 < (i + 3) / 4; ++j4) { const f32x4 a = *(const LAS f32x4*)(AM + (16 * kb + i) * 68 + 16 * kb + 4 * j4);
#pragma unroll
                for (int e = 0; e < 4; ++e) if (4 * j4 + e < i) s -= a[e] * x[4 * j4 + e]; }
            x[i] = s; }
#pragma unroll
        for (int i = 0; i < 16; ++i) TM[(16 * kb + i) * 68 + 16 * kb + c] = x[i];
    }
    __syncthreads();
#pragma unroll
    for (int lev = 1; lev <= 3; ++lev) {
        if (w < 4 - lev) { const int bi = w + lev, bk = w; const int li = lane & 15, lq = lane >> 4;
            f32x4 Mx = (f32x4){0.f, 0.f, 0.f, 0.f};
            for (int bj = bk; bj < bi; ++bj)
#pragma unroll
                for (int ks = 0; ks < 4; ++ks) Mx = MFMA16F(AM[(16 * bi + li) * 68 + 16 * bj + 4 * ks + lq], TM[(16 * bj + 4 * ks + lq) * 68 + 16 * bk + li], Mx);
            f32x4 Tx = (f32x4){0.f, 0.f, 0.f, 0.f};
#pragma unroll
            for (int e = 0; e < 4; ++e) Tx = MFMA16F(TM[(16 * bi + li) * 68 + 16 * bi + 4 * lq + e], Mx[e], Tx);
#pragma unroll
            for (int e = 0; e < 4; ++e) TM[(16 * bi + 4 * lq + e) * 68 + 16 * bk + li] = -Tx[e];
        }
        __syncthreads();
    }
    { float tv[8];
#pragma unroll
      for (int i = 0; i < 8; ++i) { const int idx = F.tid + 512 * i, ii = idx >> 6, jj = idx & 63; tv[i] = (jj >> 4) > (ii >> 4) ? 0.f : TM[ii * 68 + jj]; }
      __syncthreads();
#pragma unroll
      for (int i = 0; i < 8; ++i) { const int idx = F.tid + 512 * i, ii = idx >> 6, jj = idx & 63; *(LAS bf16*)(TB + ii * PT + 2 * jj) = (bf16)f2bf(tv[i]); } }
    __syncthreads();
    {
        const int nt = w & 3; const LAS unsigned char* Bsrc = w < 4 ? XT : VT;
        f32x16 acc[2] = {zero16(), zero16()};
#pragma unroll
        for (int ks = 0; ks < 4; ++ks) { const bf16x8 bfr = lds_frag(Bsrc + (32 * nt + r) * PT + 32 * ks + 16 * hg);
            if (ks < 2) acc[0] = MFMA32(lds_frag(TB + r * PT + 32 * ks + 16 * hg), bfr, acc[0]);
            acc[1] = MFMA32(lds_frag(TB + (32 + r) * PT + 32 * ks + 16 * hg), bfr, acc[1]); }
        if (w < 4) {
#pragma unroll
            for (int m = 0; m < 2; ++m)
#pragma unroll
                for (int i = 0; i < 16; ++i) *(LAS bf16*)(WN + (32 * m + (i & 3) + 8 * (i >> 2) + 4 * hg) * PQ + 2 * (32 * nt + r)) = (bf16)f2bf(-acc[m][i]);
        } else {
#pragma unroll
            for (int m = 0; m < 2; ++m) { v4u o0, o1;
                o0.x = pk2(acc[m][0], acc[m][1]); o0.y = pk2(acc[m][2], acc[m][3]); o0.z = pk2(acc[m][4], acc[m][5]); o0.w = pk2(acc[m][6], acc[m][7]);
                o1.x = pk2(acc[m][8], acc[m][9]); o1.y = pk2(acc[m][10], acc[m][11]); o1.z = pk2(acc[m][12], acc[m][13]); o1.w = pk2(acc[m][14], acc[m][15]);
                GAS v4u* dst = (GAS v4u*)(ub + 58368 + nt * 4096 + m * 2048 + lane * 32); dst[0] = o0; dst[1] = o1; }
        }
    }
    __syncthreads();
#pragma unroll
    for (int i = 0; i < 2; ++i) { const int f = w + 8 * i, m = f >> 3, kt = f & 7;
        { const LAS unsigned char* src = WN + (32 * m + r) * PQ + 2 * (16 * kt + 4 * hg); const v2u a = *(const LAS v2u*)src, c = *(const LAS v2u*)(src + 16);
          *(GAS v4u*)(ub + f * 1024 + lane * 16) = (v4u){a.x, a.y, c.x, c.y}; }
        { const LAS unsigned char* src = QG + (32 * m + r) * PQ + 2 * (16 * kt + 4 * hg); const v2u a = *(const LAS v2u*)src, c = *(const LAS v2u*)(src + 16);
          *(GAS v4u*)(ub + 16384 + f * 1024 + lane * 16) = (v4u){a.x, a.y, c.x, c.y}; } }
#pragma unroll
    for (int i = 0; i < 2; ++i) { const int f = w + 8 * i, t4 = f >> 2, ktp = f & 3;
        const LAS unsigned char* src = KDT + (32 * t4 + r) * PT + 2 * (16 * ktp + 4 * hg); const v2u a = *(const LAS v2u*)src, c = *(const LAS v2u*)(src + 16);
        *(GAS v4u*)(ub + 32768 + f * 1024 + lane * 16) = (v4u){a.x, a.y, c.x, c.y}; }
    { const int f = w, m = f >> 2, ktp = f & 3;
        const LAS unsigned char* src = ATT + (32 * m + r) * PT + 2 * (16 * ktp + 4 * hg); const v2u a = *(const LAS v2u*)src, c = *(const LAS v2u*)(src + 16);
        *(GAS v4u*)(ub + 49152 + f * 1024 + lane * 16) = (v4u){a.x, a.y, c.x, c.y}; }
    if (F.tid == 0) *(GAS float*)(ub + 57344) = __expf(glast);
    __syncthreads();
}

__device__ __forceinline__ void scan_dn_chain(Frame& F, int bh, int sl0) {
    const int sl = sl0 + (F.wave & 1);
    const int b = bh >> 2, h = bh & 3;
    bf16* oraw = (bf16*)(F.ws + WS_ORAW) + PLANE;
    f32x16 S[4];
#pragma unroll
    for (int t = 0; t < 4; ++t) S[t] = zero16();
#define DN_ISSUE(nn, bufo) do { const int unit_ = (b * 128 + (nn)) * 4 + h; const unsigned char* ub_ = F.ws + WS_DNB + (size_t)unit_ * DN_UNIT; \
        for (int f = F.wave - 2; f < 65; f += 6) { const unsigned char* src = f < 57 ? ub_ + f * 1024 : ub_ + 58368 + (sl0 + ((f - 57) >> 2)) * 4096 + ((f - 57) & 3) * 1024; \
            __builtin_amdgcn_global_load_lds((const unsigned*)(src + lane * 16), (LAS unsigned*)(F.lds + (bufo) + f * 1024), 16, 0, 0); } } while (0)
    { const int lane = F.lane; if (F.wave >= 2) DN_ISSUE(0, 0); }
    for (int n = 0; n < SEQ / 64; ++n) {
        int lane = F.lane; asm volatile("" : "+v"(lane));
        const int r = lane & 31, hg = lane >> 5;
        LAS unsigned char* L = F.lds + (n & 1) * 66560;
        if (F.wave >= 2) asm volatile("s_waitcnt vmcnt(0)" ::: "memory");
        __syncthreads();
        if (F.wave >= 2 && n + 1 < SEQ / 64) DN_ISSUE(n + 1, ((n + 1) & 1) * 66560);
        if (F.wave < 2) {
            const size_t row0 = (size_t)b * SEQ + 64 * n;
            const LAS unsigned char* Lp = L + lane * 16;
            bf16x8 bs[8];
#pragma unroll
            for (int kt = 0; kt < 8; ++kt) bs[kt] = pack_half(S[kt >> 1], kt & 1);
            f32x16 vn[2], o[2] = {zero16(), zero16()};
#pragma unroll
            for (int m = 0; m < 2; ++m) { const v4u u0 = *(const LAS v4u*)(L + 58368 + (F.wave & 1) * 4096 + m * 2048 + lane * 32), u1 = *(const LAS v4u*)(L + 58368 + (F.wave & 1) * 4096 + m * 2048 + lane * 32 + 16);
                vn[m][0] = bflo(u0.x); vn[m][1] = bfhi(u0.x); vn[m][2] = bflo(u0.y); vn[m][3] = bfhi(u0.y); vn[m][4] = bflo(u0.z); vn[m][5] = bfhi(u0.z); vn[m][6] = bflo(u0.w); vn[m][7] = bfhi(u0.w);
                vn[m][8] = bflo(u1.x); vn[m][9] = bfhi(u1.x); vn[m][10] = bflo(u1.y); vn[m][11] = bfhi(u1.y); vn[m][12] = bflo(u1.z); vn[m][13] = bfhi(u1.z); vn[m][14] = bflo(u1.w); vn[m][15] = bfhi(u1.w); }
            const float dl = *(const LAS float*)(L + 57344);
            bf16x8 bv[4];
            bf16x8 rg0 = lds_frag(Lp + 0);
            bf16x8 rg1 = lds_frag(Lp + 1024);
            bf16x8 rg2 = lds_frag(Lp + 2048);
            bf16x8 rg3 = lds_frag(Lp + 3072);
            bf16x8 rg4 = lds_frag(Lp + 4096);
            bf16x8 rg5 = lds_frag(Lp + 5120);
            bf16x8 rg6 = lds_frag(Lp + 6144);
            bf16x8 rg7 = lds_frag(Lp + 7168);
            { const bf16x8 a = rg0; rg0 = lds_frag(Lp + 8192);
              vn[0] = MFMA32(a, bs[0], vn[0]); }
            __builtin_amdgcn_sched_barrier(0);
            { const bf16x8 a = rg1; rg1 = lds_frag(Lp + 9216);
              vn[0] = MFMA32(a, bs[1], vn[0]); }
            __builtin_amdgcn_sched_barrier(0);
            { const bf16x8 a = rg2; rg2 = lds_frag(Lp + 10240);
              vn[0] = MFMA32(a, bs[2], vn[0]); }
            __builtin_amdgcn_sched_barrier(0);
            { const bf16x8 a = rg3; rg3 = lds_frag(Lp + 11264);
              vn[0] = MFMA32(a, bs[3], vn[0]); }
            __builtin_amdgcn_sched_barrier(0);
            { const bf16x8 a = rg4; rg4 = lds_frag(Lp + 12288);
              vn[0] = MFMA32(a, bs[4], vn[0]); }
            __builtin_amdgcn_sched_barrier(0);
            { const bf16x8 a = rg5; rg5 = lds_frag(Lp + 13312);
              vn[0] = MFMA32(a, bs[5], vn[0]); }
            __builtin_amdgcn_sched_barrier(0);
            { const bf16x8 a = rg6; rg6 = lds_frag(Lp + 14336);
              vn[0] = MFMA32(a, bs[6], vn[0]); }
            __builtin_amdgcn_sched_barrier(0);
            { const bf16x8 a = rg7; rg7 = lds_frag(Lp + 15360);
              vn[0] = MFMA32(a, bs[7], vn[0]); }
            __builtin_amdgcn_sched_barrier(0);
            { const bf16x8 a = rg0; rg0 = lds_frag(Lp + 16384);
              vn[1] = MFMA32(a, bs[0], vn[1]); }
            __builtin_amdgcn_sched_barrier(0);
            { const bf16x8 a = rg1; rg1 = lds_frag(Lp + 17408);
              vn[1] = MFMA32(a, bs[1], vn[1]); }
            __builtin_amdgcn_sched_barrier(0);
            { const bf16x8 a = rg2; rg2 = lds_frag(Lp + 18432);
              vn[1] = MFMA32(a, bs[2], vn[1]); }
            __builtin_amdgcn_sched_barrier(0);
            { const bf16x8 a = rg3; rg3 = lds_frag(Lp + 19456);
              vn[1] = MFMA32(a, bs[3], vn[1]); }
            __builtin_amdgcn_sched_barrier(0);
            { const bf16x8 a = rg4; rg4 = lds_frag(Lp + 20480);
              vn[1] = MFMA32(a, bs[4], vn[1]); }
            __builtin_amdgcn_sched_barrier(0);
            { const bf16x8 a = rg5; rg5 = lds_frag(Lp + 21504);
              vn[1] = MFMA32(a, bs[5], vn[1]); }
            __builtin_amdgcn_sched_barrier(0);
            { const bf16x8 a = rg6; rg6 = lds_frag(Lp + 22528);
              vn[1] = MFMA32(a, bs[6], vn[1]); }
            __builtin_amdgcn_sched_barrier(0);
            { const bf16x8 a = rg7; rg7 = lds_frag(Lp + 23552);
              vn[1] = MFMA32(a, bs[7], vn[1]); }
            __builtin_amdgcn_sched_barrier(0);
            { const bf16x8 a = rg0; rg0 = lds_frag(Lp + 24576);
              o[0] = MFMA32(a, bs[0], o[0]); }
            __builtin_amdgcn_sched_barrier(0);
            { const bf16x8 a = rg1; rg1 = lds_frag(Lp + 25600);
              o[0] = MFMA32(a, bs[1], o[0]); }
            __builtin_amdgcn_sched_barrier(0);
            { const bf16x8 a = rg2; rg2 = lds_frag(Lp + 26624);
              o[0] = MFMA32(a, bs[2], o[0]); }
            __builtin_amdgcn_sched_barrier(0);
            { const bf16x8 a = rg3; rg3 = lds_frag(Lp + 27648);
              o[0] = MFMA32(a, bs[3], o[0]); }
            __builtin_amdgcn_sched_barrier(0);
            { const bf16x8 a = rg4; rg4 = lds_frag(Lp + 28672);
              o[0] = MFMA32(a, bs[4], o[0]); }
            __builtin_amdgcn_sched_barrier(0);
            { const bf16x8 a = rg5; rg5 = lds_frag(Lp + 29696);
              o[0] = MFMA32(a, bs[5], o[0]); }
            __builtin_amdgcn_sched_barrier(0);
            { const bf16x8 a = rg6; rg6 = lds_frag(Lp + 30720);
              o[0] = MFMA32(a, bs[6], o[0]); }
            __builtin_amdgcn_sched_barrier(0);
            { const bf16x8 a = rg7; rg7 = lds_frag(Lp + 31744);
              o[0] = MFMA32(a, bs[7], o[0]); }
            __builtin_amdgcn_sched_barrier(0);
            { const bf16x8 a = rg0; rg0 = lds_frag(Lp + 49152);
              o[1] = MFMA32(a, bs[0], o[1]); }
            __builtin_amdgcn_sched_barrier(0);
            { const bf16x8 a = rg1; rg1 = lds_frag(Lp + 50176);
              o[1] = MFMA32(a, bs[1], o[1]); }
            __builtin_amdgcn_sched_barrier(0);
            { const bf16x8 a = rg2; rg2 = lds_frag(Lp + 53248);
              o[1] = MFMA32(a, bs[2], o[1]); }
            __builtin_amdgcn_sched_barrier(0);
            { const bf16x8 a = rg3; rg3 = lds_frag(Lp + 54272);
              o[1] = MFMA32(a, bs[3], o[1]); }
            __builtin_amdgcn_sched_barrier(0);
            { const bf16x8 a = rg4; rg4 = lds_frag(Lp + 55296);
              o[1] = MFMA32(a, bs[4], o[1]); }
            __builtin_amdgcn_sched_barrier(0);
            { const bf16x8 a = rg5; rg5 = lds_frag(Lp + 56320);
              o[1] = MFMA32(a, bs[5], o[1]); }
            __builtin_amdgcn_sched_barrier(0);
            { const bf16x8 a = rg6; rg6 = lds_frag(Lp + 32768);
              o[1] = MFMA32(a, bs[6], o[1]); }
            __builtin_amdgcn_sched_barrier(0);
            { const bf16x8 a = rg7; rg7 = lds_frag(Lp + 33792);
              o[1] = MFMA32(a, bs[7], o[1]); }
            __builtin_amdgcn_sched_barrier(0);
            { const bf16x8 a = rg0; rg0 = lds_frag(Lp + 34816);
              bv[0] = pack_half(vn[0], 0); bv[1] = pack_half(vn[0], 1); bv[2] = pack_half(vn[1], 0); bv[3] = pack_half(vn[1], 1);
              o[0] = MFMA32(a, bv[0], o[0]); }
            __builtin_amdgcn_sched_barrier(0);
            { const bf16x8 a = rg1; rg1 = lds_frag(Lp + 35840);
              o[0] = MFMA32(a, bv[1], o[0]); }
            __builtin_amdgcn_sched_barrier(0);
            { const bf16x8 a = rg2; rg2 = lds_frag(Lp + 36864);
              o[1] = MFMA32(a, bv[0], o[1]); }
            __builtin_amdgcn_sched_barrier(0);
            { const bf16x8 a = rg3; rg3 = lds_frag(Lp + 37888);
              o[1] = MFMA32(a, bv[1], o[1]); }
            __builtin_amdgcn_sched_barrier(0);
            { const bf16x8 a = rg4; rg4 = lds_frag(Lp + 38912);
              o[1] = MFMA32(a, bv[2], o[1]); }
            __builtin_amdgcn_sched_barrier(0);
            { const bf16x8 a = rg5; rg5 = lds_frag(Lp + 39936);
              o[1] = MFMA32(a, bv[3], o[1]); }
            __builtin_amdgcn_sched_barrier(0);
            { const bf16x8 a = rg6; rg6 = lds_frag(Lp + 40960);
              S[0] = S[0] * dl;
              S[0] = MFMA32(a, bv[0], S[0]); }
            __builtin_amdgcn_sched_barrier(0);
            { const bf16x8 a = rg7; rg7 = lds_frag(Lp + 41984);
              S[0] = MFMA32(a, bv[1], S[0]); }
            __builtin_amdgcn_sched_barrier(0);
            { const bf16x8 a = rg0; rg0 = lds_frag(Lp + 43008);
              S[0] = MFMA32(a, bv[2], S[0]); }
            __builtin_amdgcn_sched_barrier(0);
            { const bf16x8 a = rg1; rg1 = lds_frag(Lp + 44032);
              S[0] = MFMA32(a, bv[3], S[0]); }
            __builtin_amdgcn_sched_barrier(0);
            { const bf16x8 a = rg2; rg2 = lds_frag(Lp + 45056);
              S[1] = S[1] * dl;
              S[1] = MFMA32(a, bv[0], S[1]); }
            __builtin_amdgcn_sched_barrier(0);
            { const bf16x8 a = rg3; rg3 = lds_frag(Lp + 46080);
              S[1] = MFMA32(a, bv[1], S[1]); }
            __builtin_amdgcn_sched_barrier(0);
            { const bf16x8 a = rg4; rg4 = lds_frag(Lp + 47104);
              S[1] = MFMA32(a, bv[2], S[1]); }
            __builtin_amdgcn_sched_barrier(0);
            { const bf16x8 a = rg5; rg5 = lds_frag(Lp + 48128);
              S[1] = MFMA32(a, bv[3], S[1]); }
            __builtin_amdgcn_sched_barrier(0);
            { const bf16x8 a = rg6;
              S[2] = S[2] * dl;
              S[2] = MFMA32(a, bv[0], S[2]); }
            __builtin_amdgcn_sched_barrier(0);
            { const bf16x8 a = rg7;
              S[2] = MFMA32(a, bv[1], S[2]); }
            __builtin_amdgcn_sched_barrier(0);
            { const bf16x8 a = rg0;
              S[2] = MFMA32(a, bv[2], S[2]); }
            __builtin_amdgcn_sched_barrier(0);
            { const bf16x8 a = rg1;
              S[2] = MFMA32(a, bv[3], S[2]); }
            __builtin_amdgcn_sched_barrier(0);
            { const bf16x8 a = rg2;
              S[3] = S[3] * dl;
              S[3] = MFMA32(a, bv[0], S[3]); }
            __builtin_amdgcn_sched_barrier(0);
            { const bf16x8 a = rg3;
              S[3] = MFMA32(a, bv[1], S[3]); }
            __builtin_amdgcn_sched_barrier(0);
            { const bf16x8 a = rg4;
              S[3] = MFMA32(a, bv[2], S[3]); }
            __builtin_amdgcn_sched_barrier(0);
            { const bf16x8 a = rg5;
              S[3] = MFMA32(a, bv[3], S[3]); }
            __builtin_amdgcn_sched_barrier(0);
#pragma unroll
            for (int m = 0; m < 2; ++m)
#pragma unroll
                for (int i = 0; i < 16; ++i) oraw[(row0 + 32 * m + (i & 3) + 8 * (i >> 2) + 4 * hg) * 512 + 128 * h + 32 * sl + r] = (bf16)f2bf(o[m][i]);
        }
    }
    __syncthreads();
}

constexpr int OST4 = 145408;

__device__ __forceinline__ void post4_chunk(Frame& F, const bf16* gplane, bf16* ocat, const float* nwp, size_t row0, int h, int lane) {
    const int pw = F.wave - 6, d8 = 8 * (lane & 15);
    float nw[8];
    { const f32x4 a = *(const GAS f32x4*)(nwp + d8), c = *(const GAS f32x4*)(nwp + d8 + 4); nw[0] = a.x; nw[1] = a.y; nw[2] = a.z; nw[3] = a.w; nw[4] = c.x; nw[5] = c.y; nw[6] = c.z; nw[7] = c.w; }
#pragma unroll
    for (int hf = 0; hf < 2; ++hf) {
    v4u gv[8];
#pragma unroll
    for (int it = 4 * hf; it < 4 * hf + 4; ++it) { const int t = 8 * it + 4 * pw + (lane >> 4); gv[it] = *(const GAS v4u*)(gplane + (row0 + t) * 512 + 128 * h + d8); }
#pragma unroll
    for (int it = 4 * hf; it < 4 * hf + 4; ++it) { const int t = 8 * it + 4 * pw + (lane >> 4);
        const v4u ov = *(const LAS v4u*)(F.lds + OST4 + t * 256 + 2 * d8);
        const float o[8] = {bflo(ov.x), bfhi(ov.x), bflo(ov.y), bfhi(ov.y), bflo(ov.z), bfhi(ov.z), bflo(ov.w), bfhi(ov.w)};
        const float g[8] = {bflo(gv[it].x), bfhi(gv[it].x), bflo(gv[it].y), bfhi(gv[it].y), bflo(gv[it].z), bfhi(gv[it].z), bflo(gv[it].w), bfhi(gv[it].w)};
        float s = 0.f;
#pragma unroll
        for (int j = 0; j < 8; ++j) s += o[j] * o[j];
        s += __builtin_bit_cast(float, __builtin_amdgcn_update_dpp(0, __builtin_bit_cast(int, s), 0xB1, 0xF, 0xF, true));
        s += __builtin_bit_cast(float, __builtin_amdgcn_update_dpp(0, __builtin_bit_cast(int, s), 0x4E, 0xF, 0xF, true));
        s += __builtin_bit_cast(float, __builtin_amdgcn_update_dpp(0, __builtin_bit_cast(int, s), 0x141, 0xF, 0xF, true));
        s += __builtin_bit_cast(float, __builtin_amdgcn_update_dpp(0, __builtin_bit_cast(int, s), 0x140, 0xF, 0xF, true));
        const float rs = __builtin_amdgcn_rsqf(s * (1.f / HDIM) + EPSF);
        float q[8];
#pragma unroll
        for (int j = 0; j < 8; ++j) q[j] = o[j] * rs * nw[j] * (g[j] * sigmf(g[j]));
        *(GAS v4u*)(ocat + (row0 + t) * 512 + 128 * h + d8) = (v4u){pk2(q[0], q[1]), pk2(q[2], q[3]), pk2(q[4], q[5]), pk2(q[6], q[7])}; }
    }
}

__device__ __forceinline__ void scan4_hg(Frame& F, int l, int bh) {
    const int b = bh >> 2, h = bh & 3;
#define ISSUE4(nn, bufo) do { const int unit_ = (b * 128 + (nn)) * 4 + h; \
        const unsigned char* p1_ = (const unsigned char*)F.out + 128 * MiB + (size_t)unit_ * HG1_UNIT; const unsigned char* p2_ = (const unsigned char*)F.out + (size_t)unit_ * HG2_UNIT; \
        for (int f = F.wave - 4; f < 57; f += 4) { const unsigned char* src = f < 32 ? p1_ + f * 1024 : p2_ + (f - 32) * 1024; \
            __builtin_amdgcn_global_load_lds((const unsigned*)(src + lane * 16), (LAS unsigned*)(F.lds + (bufo) + f * 1024), 16, 0, 0); } } while (0)
#define BAR_B1() do { asm volatile("s_waitcnt lgkmcnt(0)" ::: "memory"); __builtin_amdgcn_s_barrier(); asm volatile("" ::: "memory"); } while (0)
    if (F.wave < 4) {
        bf16* oraw = (bf16*)(F.ws + WS_ORAW) + (size_t)0 * PLANE;
        f32x16 S[4];
#pragma unroll
        for (int t = 0; t < 4; ++t) S[t] = zero16();
        for (int n = 0; n < SEQ / 64; ++n) {
            int lane = F.lane; asm volatile("" : "+v"(lane));
            const int r = lane & 31, hg = lane >> 5;
            LAS unsigned char* L = F.lds + (n & 1) * 72704;
            const size_t row0 = (size_t)b * SEQ + 64 * n;
            BAR_B1();
            const LAS unsigned char* Lp = L + lane * 16;
            bf16x8 bs[8];
#pragma unroll
            for (int kt = 0; kt < 8; ++kt) bs[kt] = pack_half(S[kt >> 1], kt & 1);
            bf16x8 bv[4];
#pragma unroll
            for (int kt = 0; kt < 4; ++kt) bv[kt] = lds_frag(Lp + 41984 + F.wave * 4096 + kt * 1024);
            f32x16 o[2] = {zero16(), zero16()};
#define HG_DECAY(t4) do { _Pragma("unroll") for (int g = 0; g < 4; ++g) { const f32x4 dc = *(const LAS f32x4*)(L + 40960 + 4 * (32 * (t4) + 8 * g + 4 * hg)); \
                _Pragma("unroll") for (int e = 0; e < 4; ++e) S[t4][4 * g + e] *= dc[e]; } } while (0)
            bf16x8 rg0 = lds_frag(Lp + 0);
            bf16x8 rg1 = lds_frag(Lp + 1024);
            bf16x8 rg2 = lds_frag(Lp + 2048);
            bf16x8 rg3 = lds_frag(Lp + 3072);
            bf16x8 rg4 = lds_frag(Lp + 4096);
            bf16x8 rg5 = lds_frag(Lp + 5120);
            bf16x8 rg6 = lds_frag(Lp + 6144);
            bf16x8 rg7 = lds_frag(Lp + 7168);
            { const bf16x8 a = rg0; rg0 = lds_frag(Lp + 8192);
              o[0] = MFMA32(a, bs[0], o[0]);
            }
            __builtin_amdgcn_sched_barrier(0);
            { const bf16x8 a = rg1; rg1 = lds_frag(Lp + 9216);
              o[0] = MFMA32(a, bs[1], o[0]);
            }
            __builtin_amdgcn_sched_barrier(0);
            { const bf16x8 a = rg2; rg2 = lds_frag(Lp + 10240);
              o[0] = MFMA32(a, bs[2], o[0]);
            }
            __builtin_amdgcn_sched_barrier(0);
            { const bf16x8 a = rg3; rg3 = lds_frag(Lp + 11264);
              o[0] = MFMA32(a, bs[3], o[0]);
            }
            __builtin_amdgcn_sched_barrier(0);
            { const bf16x8 a = rg4; rg4 = lds_frag(Lp + 12288);
              o[0] = MFMA32(a, bs[4], o[0]);
            }
            __builtin_amdgcn_sched_barrier(0);
            { const bf16x8 a = rg5; rg5 = lds_frag(Lp + 13312);
              o[0] = MFMA32(a, bs[5], o[0]);
            }
            __builtin_amdgcn_sched_barrier(0);
            { const bf16x8 a = rg6; rg6 = lds_frag(Lp + 14336);
              o[0] = MFMA32(a, bs[6], o[0]);
            }
            __builtin_amdgcn_sched_barrier(0);
            { const bf16x8 a = rg7; rg7 = lds_frag(Lp + 15360);
              o[0] = MFMA32(a, bs[7], o[0]);
            }
            __builtin_amdgcn_sched_barrier(0);
            { const bf16x8 a = rg0; rg0 = lds_frag(Lp + 32768);
              o[1] = MFMA32(a, bs[0], o[1]);
            }
            __builtin_amdgcn_sched_barrier(0);
            { const bf16x8 a = rg1; rg1 = lds_frag(Lp + 33792);
              o[1] = MFMA32(a, bs[1], o[1]);
            }
            __builtin_amdgcn_sched_barrier(0);
            { const bf16x8 a = rg2; rg2 = lds_frag(Lp + 36864);
              o[1] = MFMA32(a, bs[2], o[1]);
            }
            __builtin_amdgcn_sched_barrier(0);
            { const bf16x8 a = rg3; rg3 = lds_frag(Lp + 37888);
              o[1] = MFMA32(a, bs[3], o[1]);
            }
            __builtin_amdgcn_sched_barrier(0);
            { const bf16x8 a = rg4; rg4 = lds_frag(Lp + 38912);
              o[1] = MFMA32(a, bs[4], o[1]);
            }
            __builtin_amdgcn_sched_barrier(0);
            { const bf16x8 a = rg5; rg5 = lds_frag(Lp + 39936);
              o[1] = MFMA32(a, bs[5], o[1]);
            }
            __builtin_amdgcn_sched_barrier(0);
            { const bf16x8 a = rg6; rg6 = lds_frag(Lp + 16384);
              o[1] = MFMA32(a, bs[6], o[1]);
            }
            __builtin_amdgcn_sched_barrier(0);
            { const bf16x8 a = rg7; rg7 = lds_frag(Lp + 17408);
              o[1] = MFMA32(a, bs[7], o[1]);
            }
            __builtin_amdgcn_sched_barrier(0);
            { const bf16x8 a = rg0; rg0 = lds_frag(Lp + 18432);
              o[0] = MFMA32(a, bv[0], o[0]);
            }
            __builtin_amdgcn_sched_barrier(0);
            { const bf16x8 a = rg1; rg1 = lds_frag(Lp + 19456);
              o[0] = MFMA32(a, bv[1], o[0]);
            }
            __builtin_amdgcn_sched_barrier(0);
            { const bf16x8 a = rg2; rg2 = lds_frag(Lp + 20480);
              o[1] = MFMA32(a, bv[0], o[1]);
            }
            __builtin_amdgcn_sched_barrier(0);
            { const bf16x8 a = rg3; rg3 = lds_frag(Lp + 21504);
              o[1] = MFMA32(a, bv[1], o[1]);
            }
            __builtin_amdgcn_sched_barrier(0);
            { const bf16x8 a = rg4; rg4 = lds_frag(Lp + 22528);
              o[1] = MFMA32(a, bv[2], o[1]);
            }
            __builtin_amdgcn_sched_barrier(0);
            { const bf16x8 a = rg5; rg5 = lds_frag(Lp + 23552);
              o[1] = MFMA32(a, bv[3], o[1]);
            }
            __builtin_amdgcn_sched_barrier(0);
            { const bf16x8 a = rg6; rg6 = lds_frag(Lp + 24576);
              HG_DECAY(0);
              S[0] = MFMA32(a, bv[0], S[0]);
            }
            __builtin_amdgcn_sched_barrier(0);
            { const bf16x8 a = rg7; rg7 = lds_frag(Lp + 25600);
              S[0] = MFMA32(a, bv[1], S[0]);
            }
            __builtin_amdgcn_sched_barrier(0);
            { const bf16x8 a = rg0; rg0 = lds_frag(Lp + 26624);
              S[0] = MFMA32(a, bv[2], S[0]);
            }
            __builtin_amdgcn_sched_barrier(0);
            { const bf16x8 a = rg1; rg1 = lds_frag(Lp + 27648);
              S[0] = MFMA32(a, bv[3], S[0]);
            }
            __builtin_amdgcn_sched_barrier(0);
            { const bf16x8 a = rg2; rg2 = lds_frag(Lp + 28672);
              HG_DECAY(1);
              S[1] = MFMA32(a, bv[0], S[1]);
            }
            __builtin_amdgcn_sched_barrier(0);
            { const bf16x8 a = rg3; rg3 = lds_frag(Lp + 29696);
              S[1] = MFMA32(a, bv[1], S[1]);
            }
            __builtin_amdgcn_sched_barrier(0);
            { const bf16x8 a = rg4; rg4 = lds_frag(Lp + 30720);
              S[1] = MFMA32(a, bv[2], S[1]);
            }
            __builtin_amdgcn_sched_barrier(0);
            { const bf16x8 a = rg5; rg5 = lds_frag(Lp + 31744);
              S[1] = MFMA32(a, bv[3], S[1]);
            }
            __builtin_amdgcn_sched_barrier(0);
            { const bf16x8 a = rg6;
              HG_DECAY(2);
              S[2] = MFMA32(a, bv[0], S[2]);
            }
            __builtin_amdgcn_sched_barrier(0);
            { const bf16x8 a = rg7;
              S[2] = MFMA32(a, bv[1], S[2]);
            }
            __builtin_amdgcn_sched_barrier(0);
            { const bf16x8 a = rg0;
              S[2] = MFMA32(a, bv[2], S[2]);
            }
            __builtin_amdgcn_sched_barrier(0);
            { const bf16x8 a = rg1;
              S[2] = MFMA32(a, bv[3], S[2]);
            }
            __builtin_amdgcn_sched_barrier(0);
            { const bf16x8 a = rg2;
              HG_DECAY(3);
              S[3] = MFMA32(a, bv[0], S[3]);
            }
            __builtin_amdgcn_sched_barrier(0);
            { const bf16x8 a = rg3;
              S[3] = MFMA32(a, bv[1], S[3]);
            }
            __builtin_amdgcn_sched_barrier(0);
            { const bf16x8 a = rg4;
              S[3] = MFMA32(a, bv[2], S[3]);
            }
            __builtin_amdgcn_sched_barrier(0);
            { const bf16x8 a = rg5;
              S[3] = MFMA32(a, bv[3], S[3]);
            }
            __builtin_amdgcn_sched_barrier(0);
#undef HG_DECAY
#pragma unroll
            for (int m = 0; m < 2; ++m)
#pragma unroll
                for (int i = 0; i < 16; ++i) oraw[(row0 + 32 * m + (i & 3) + 8 * (i >> 2) + 4 * hg) * 512 + 128 * h + 32 * F.wave + r] = (bf16)f2bf(o[m][i]);
        }
    } else {
        { const int lane = F.lane; ISSUE4(0, 0); }
        for (int n = 0; n < SEQ / 64; ++n) {
            int lane = F.lane; asm volatile("" : "+v"(lane));
            asm volatile("s_waitcnt vmcnt(0)" ::: "memory");
            BAR_B1();
            if (n + 1 < SEQ / 64) ISSUE4(n + 1, ((n + 1) & 1) * 72704);
        }
    }
    __syncthreads();
#undef ISSUE4
#undef BAR_B1
}

__device__ __forceinline__ void scan4_dn(Frame& F, int l, int bh) {
    const int b = bh >> 2, h = bh & 3;
#define ISSUE4(nn, bufo) do { const int unit_ = (b * 128 + (nn)) * 4 + h; const unsigned char* ub_ = F.ws + WS_DNB + (size_t)unit_ * DN_UNIT; \
        for (int f = F.wave - 4; f < 71; f += 4) { const unsigned char* src = f < 48 ? ub_ + f * 1024 : (f < 54 ? ub_ + 49152 + ((f - 48) < 2 ? (f - 48) : (f - 46)) * 1024 : (f == 54 ? ub_ + 57344 : ub_ + 58368 + (f - 55) * 1024)); \
            __builtin_amdgcn_global_load_lds((const unsigned*)(src + lane * 16), (LAS unsigned*)(F.lds + (bufo) + f * 1024), 16, 0, 0); } } while (0)
#define BAR_B1() do { asm volatile("s_waitcnt lgkmcnt(0)" ::: "memory"); __builtin_amdgcn_s_barrier(); asm volatile("" ::: "memory"); } while (0)
    if (F.wave < 4) {
        bf16* oraw = (bf16*)(F.ws + WS_ORAW) + (size_t)1 * PLANE;
        f32x16 S[4];
#pragma unroll
        for (int t = 0; t < 4; ++t) S[t] = zero16();
        for (int n = 0; n < SEQ / 64; ++n) {
            int lane = F.lane; asm volatile("" : "+v"(lane));
            const int r = lane & 31, hg = lane >> 5;
            LAS unsigned char* L = F.lds + (n & 1) * 72704;
            const size_t row0 = (size_t)b * SEQ + 64 * n;
            BAR_B1();
            const LAS unsigned char* Lp = L + lane * 16;
            bf16x8 bs[8];
#pragma unroll
            for (int kt = 0; kt < 8; ++kt) bs[kt] = pack_half(S[kt >> 1], kt & 1);
            f32x16 vn[2], o[2] = {zero16(), zero16()};
#pragma unroll
            for (int m = 0; m < 2; ++m) { const v4u u0 = *(const LAS v4u*)(L + 56320 + F.wave * 4096 + m * 2048 + lane * 32), u1 = *(const LAS v4u*)(L + 56320 + F.wave * 4096 + m * 2048 + lane * 32 + 16);
                vn[m][0] = bflo(u0.x); vn[m][1] = bfhi(u0.x); vn[m][2] = bflo(u0.y); vn[m][3] = bfhi(u0.y); vn[m][4] = bflo(u0.z); vn[m][5] = bfhi(u0.z); vn[m][6] = bflo(u0.w); vn[m][7] = bfhi(u0.w);
                vn[m][8] = bflo(u1.x); vn[m][9] = bfhi(u1.x); vn[m][10] = bflo(u1.y); vn[m][11] = bfhi(u1.y); vn[m][12] = bflo(u1.z); vn[m][13] = bfhi(u1.z); vn[m][14] = bflo(u1.w); vn[m][15] = bfhi(u1.w); }
            const float dl = *(const LAS float*)(L + 55296);
            bf16x8 bv[4];
            bf16x8 rg0 = lds_frag(Lp + 0);
            bf16x8 rg1 = lds_frag(Lp + 1024);
            bf16x8 rg2 = lds_frag(Lp + 2048);
            bf16x8 rg3 = lds_frag(Lp + 3072);
            bf16x8 rg4 = lds_frag(Lp + 4096);
            bf16x8 rg5 = lds_frag(Lp + 5120);
            bf16x8 rg6 = lds_frag(Lp + 6144);
            bf16x8 rg7 = lds_frag(Lp + 7168);
            { const bf16x8 a = rg0; rg0 = lds_frag(Lp + 8192);
              vn[0] = MFMA32(a, bs[0], vn[0]);
            }
            __builtin_amdgcn_sched_barrier(0);
            { const bf16x8 a = rg1; rg1 = lds_frag(Lp + 9216);
              vn[0] = MFMA32(a, bs[1], vn[0]);
            }
            __builtin_amdgcn_sched_barrier(0);
            { const bf16x8 a = rg2; rg2 = lds_frag(Lp + 10240);
              vn[0] = MFMA32(a, bs[2], vn[0]);
            }
            __builtin_amdgcn_sched_barrier(0);
            { const bf16x8 a = rg3; rg3 = lds_frag(Lp + 11264);
              vn[0] = MFMA32(a, bs[3], vn[0]);
            }
            __builtin_amdgcn_sched_barrier(0);
            { const bf16x8 a = rg4; rg4 = lds_frag(Lp + 12288);
              vn[0] = MFMA32(a, bs[4], vn[0]);
            }
            __builtin_amdgcn_sched_barrier(0);
            { const bf16x8 a = rg5; rg5 = lds_frag(Lp + 13312);
              vn[0] = MFMA32(a, bs[5], vn[0]);
            }
            __builtin_amdgcn_sched_barrier(0);
            { const bf16x8 a = rg6; rg6 = lds_frag(Lp + 14336);
              vn[0] = MFMA32(a, bs[6], vn[0]);
            }
            __builtin_amdgcn_sched_barrier(0);
            { const bf16x8 a = rg7; rg7 = lds_frag(Lp + 15360);
              vn[0] = MFMA32(a, bs[7], vn[0]);
            }
            __builtin_amdgcn_sched_barrier(0);
            { const bf16x8 a = rg0; rg0 = lds_frag(Lp + 16384);
              vn[1] = MFMA32(a, bs[0], vn[1]);
            }
            __builtin_amdgcn_sched_barrier(0);
            { const bf16x8 a = rg1; rg1 = lds_frag(Lp + 17408);
              vn[1] = MFMA32(a, bs[1], vn[1]);
            }
            __builtin_amdgcn_sched_barrier(0);
            { const bf16x8 a = rg2; rg2 = lds_frag(Lp + 18432);
              vn[1] = MFMA32(a, bs[2], vn[1]);
            }
            __builtin_amdgcn_sched_barrier(0);
            { const bf16x8 a = rg3; rg3 = lds_frag(Lp + 19456);
              vn[1] = MFMA32(a, bs[3], vn[1]);
            }
            __builtin_amdgcn_sched_barrier(0);
            { const bf16x8 a = rg4; rg4 = lds_frag(Lp + 20480);
              vn[1] = MFMA32(a, bs[4], vn[1]);
            }
            __builtin_amdgcn_sched_barrier(0);
            { const bf16x8 a = rg5; rg5 = lds_frag(Lp + 21504);
              vn[1] = MFMA32(a, bs[5], vn[1]);
            }
            __builtin_amdgcn_sched_barrier(0);
            { const bf16x8 a = rg6; rg6 = lds_frag(Lp + 22528);
              vn[1] = MFMA32(a, bs[6], vn[1]);
            }
            __builtin_amdgcn_sched_barrier(0);
            { const bf16x8 a = rg7; rg7 = lds_frag(Lp + 23552);
              vn[1] = MFMA32(a, bs[7], vn[1]);
            }
            __builtin_amdgcn_sched_barrier(0);
            { const bf16x8 a = rg0; rg0 = lds_frag(Lp + 24576);
              o[0] = MFMA32(a, bs[0], o[0]);
            }
            __builtin_amdgcn_sched_barrier(0);
            { const bf16x8 a = rg1; rg1 = lds_frag(Lp + 25600);
              o[0] = MFMA32(a, bs[1], o[0]);
            }
            __builtin_amdgcn_sched_barrier(0);
            { const bf16x8 a = rg2; rg2 = lds_frag(Lp + 26624);
              o[0] = MFMA32(a, bs[2], o[0]);
            }
            __builtin_amdgcn_sched_barrier(0);
            { const bf16x8 a = rg3; rg3 = lds_frag(Lp + 27648);
              o[0] = MFMA32(a, bs[3], o[0]);
            }
            __builtin_amdgcn_sched_barrier(0);
            { const bf16x8 a = rg4; rg4 = lds_frag(Lp + 28672);
              o[0] = MFMA32(a, bs[4], o[0]);
            }
            __builtin_amdgcn_sched_barrier(0);
            { const bf16x8 a = rg5; rg5 = lds_frag(Lp + 29696);
              o[0] = MFMA32(a, bs[5], o[0]);
            }
            __builtin_amdgcn_sched_barrier(0);
            { const bf16x8 a = rg6; rg6 = lds_frag(Lp + 30720);
              o[0] = MFMA32(a, bs[6], o[0]);
            }
            __builtin_amdgcn_sched_barrier(0);
            { const bf16x8 a = rg7; rg7 = lds_frag(Lp + 31744);
              o[0] = MFMA32(a, bs[7], o[0]);
            }
            __builtin_amdgcn_sched_barrier(0);
            { const bf16x8 a = rg0; rg0 = lds_frag(Lp + 49152);
              o[1] = MFMA32(a, bs[0], o[1]);
            }
            __builtin_amdgcn_sched_barrier(0);
            { const bf16x8 a = rg1; rg1 = lds_frag(Lp + 50176);
              o[1] = MFMA32(a, bs[1], o[1]);
            }
            __builtin_amdgcn_sched_barrier(0);
            { const bf16x8 a = rg2; rg2 = lds_frag(Lp + 51200);
              o[1] = MFMA32(a, bs[2], o[1]);
            }
            __builtin_amdgcn_sched_barrier(0);
            { const bf16x8 a = rg3; rg3 = lds_frag(Lp + 52224);
              o[1] = MFMA32(a, bs[3], o[1]);
            }
            __builtin_amdgcn_sched_barrier(0);
            { const bf16x8 a = rg4; rg4 = lds_frag(Lp + 53248);
              o[1] = MFMA32(a, bs[4], o[1]);
            }
            __builtin_amdgcn_sched_barrier(0);
            { const bf16x8 a = rg5; rg5 = lds_frag(Lp + 54272);
              o[1] = MFMA32(a, bs[5], o[1]);
            }
            __builtin_amdgcn_sched_barrier(0);
            { const bf16x8 a = rg6; rg6 = lds_frag(Lp + 32768);
              o[1] = MFMA32(a, bs[6], o[1]);
            }
            __builtin_amdgcn_sched_barrier(0);
            { const bf16x8 a = rg7; rg7 = lds_frag(Lp + 33792);
              o[1] = MFMA32(a, bs[7], o[1]);
            }
            __builtin_amdgcn_sched_barrier(0);
            { const bf16x8 a = rg0; rg0 = lds_frag(Lp + 34816);
              bv[0] = pack_half(vn[0], 0); bv[1] = pack_half(vn[0], 1); bv[2] = pack_half(vn[1], 0); bv[3] = pack_half(vn[1], 1);
              o[0] = MFMA32(a, bv[0], o[0]);
            }
            __builtin_amdgcn_sched_barrier(0);
            { const bf16x8 a = rg1; rg1 = lds_frag(Lp + 35840);
              o[0] = MFMA32(a, bv[1], o[0]);
            }
            __builtin_amdgcn_sched_barrier(0);
            { const bf16x8 a = rg2; rg2 = lds_frag(Lp + 36864);
              o[1] = MFMA32(a, bv[0], o[1]);
            }
            __builtin_amdgcn_sched_barrier(0);
            { const bf16x8 a = rg3; rg3 = lds_frag(Lp + 37888);
              o[1] = MFMA32(a, bv[1], o[1]);
            }
            __builtin_amdgcn_sched_barrier(0);
            { const bf16x8 a = rg4; rg4 = lds_frag(Lp + 38912);
              o[1] = MFMA32(a, bv[2], o[1]);
            }
            __builtin_amdgcn_sched_barrier(0);
            { const bf16x8 a = rg5; rg5 = lds_frag(Lp + 39936);
              o[1] = MFMA32(a, bv[3], o[1]);
            }
            __builtin_amdgcn_sched_barrier(0);
            { const bf16x8 a = rg6; rg6 = lds_frag(Lp + 40960);
              S[0] = S[0] * dl;
              S[0] = MFMA32(a, bv[0], S[0]);
            }
            __builtin_amdgcn_sched_barrier(0);
            { const bf16x8 a = rg7; rg7 = lds_frag(Lp + 41984);
              S[0] = MFMA32(a, bv[1], S[0]);
            }
            __builtin_amdgcn_sched_barrier(0);
            { const bf16x8 a = rg0; rg0 = lds_frag(Lp + 43008);
              S[0] = MFMA32(a, bv[2], S[0]);
            }
            __builtin_amdgcn_sched_barrier(0);
            { const bf16x8 a = rg1; rg1 = lds_frag(Lp + 44032);
              S[0] = MFMA32(a, bv[3], S[0]);
            }
            __builtin_amdgcn_sched_barrier(0);
            { const bf16x8 a = rg2; rg2 = lds_frag(Lp + 45056);
              S[1] = S[1] * dl;
              S[1] = MFMA32(a, bv[0], S[1]);
            }
            __builtin_amdgcn_sched_barrier(0);
            { const bf16x8 a = rg3; rg3 = lds_frag(Lp + 46080);
              S[1] = MFMA32(a, bv[1], S[1]);
            }
            __builtin_amdgcn_sched_barrier(0);
            { const bf16x8 a = rg4; rg4 = lds_frag(Lp + 47104);
              S[1] = MFMA32(a, bv[2], S[1]);
            }
            __builtin_amdgcn_sched_barrier(0);
            { const bf16x8 a = rg5; rg5 = lds_frag(Lp + 48128);
              S[1] = MFMA32(a, bv[3], S[1]);
            }
            __builtin_amdgcn_sched_barrier(0);
            { const bf16x8 a = rg6;
              S[2] = S[2] * dl;
              S[2] = MFMA32(a, bv[0], S[2]);
            }
            __builtin_amdgcn_sched_barrier(0);
            { const bf16x8 a = rg7;
              S[2] = MFMA32(a, bv[1], S[2]);
            }
            __builtin_amdgcn_sched_barrier(0);
            { const bf16x8 a = rg0;
              S[2] = MFMA32(a, bv[2], S[2]);
            }
            __builtin_amdgcn_sched_barrier(0);
            { const bf16x8 a = rg1;
              S[2] = MFMA32(a, bv[3], S[2]);
            }
            __builtin_amdgcn_sched_barrier(0);
            { const bf16x8 a = rg2;
              S[3] = S[3] * dl;
              S[3] = MFMA32(a, bv[0], S[3]);
            }
            __builtin_amdgcn_sched_barrier(0);
            { const bf16x8 a = rg3;
              S[3] = MFMA32(a, bv[1], S[3]);
            }
            __builtin_amdgcn_sched_barrier(0);
            { const bf16x8 a = rg4;
              S[3] = MFMA32(a, bv[2], S[3]);
            }
            __builtin_amdgcn_sched_barrier(0);
            { const bf16x8 a = rg5;
              S[3] = MFMA32(a, bv[3], S[3]);
            }
            __builtin_amdgcn_sched_barrier(0);
#pragma unroll
            for (int m = 0; m < 2; ++m)
#pragma unroll
                for (int i = 0; i < 16; ++i) oraw[(row0 + 32 * m + (i & 3) + 8 * (i >> 2) + 4 * hg) * 512 + 128 * h + 32 * F.wave + r] = (bf16)f2bf(o[m][i]);
        }
    } else {
        { const int lane = F.lane; ISSUE4(0, 0); }
        for (int n = 0; n < SEQ / 64; ++n) {
            int lane = F.lane; asm volatile("" : "+v"(lane));
            asm volatile("s_waitcnt vmcnt(0)" ::: "memory");
            BAR_B1();
            if (n + 1 < SEQ / 64) ISSUE4(n + 1, ((n + 1) & 1) * 72704);
        }
    }
    __syncthreads();
#undef ISSUE4
#undef BAR_B1
}
enum { MAT_INA = 0, MAT_INB, MAT_OHG, MAT_ODN, MAT_OUT, MAT_GU, MAT_DN, MAT_N };
__device__ __forceinline__ int colmap(int mat, int n) {
    switch (mat) {
        case MAT_INA: return n;
        case MAT_INB: return 4104 + n;
        case MAT_GU: { const int pn = n >> 8, r = n & 255; return r < 128 ? 128 * pn + r : DFF + 128 * pn + (r - 128); }
        default: return n;
    }
}
__device__ __forceinline__ void transpose_item(const float* W, int K, int Nsrc, bf16* WT, int mat, const float* gain, LAS float* scr, int kb, int nb, int lane) {
    const int k0 = 64 * kb, n0 = 32 * nb;
    const int sc = colmap(mat, n0 + (lane & 31));
#pragma unroll 8
    for (int i = 0; i < 32; ++i) { const int kk = 2 * i + (lane >> 5);
        float v = 0.f; if (sc >= 0) { v = W[(size_t)(k0 + kk) * Nsrc + sc]; if (gain) v *= gain[k0 + kk]; }
        scr[kk * 33 + (lane & 31)] = v; }
    LDS_WAIT(); asm volatile("" ::: "memory");
    const int c = lane & 7;
#pragma unroll
    for (int j = 0; j < 4; ++j) { const int n = (lane >> 3) + 8 * j; const LAS float* s = scr + (8 * c) * 33 + n;
        v4u o; o.x = pk2(s[0 * 33], s[1 * 33]); o.y = pk2(s[2 * 33], s[3 * 33]); o.z = pk2(s[4 * 33], s[5 * 33]); o.w = pk2(s[6 * 33], s[7 * 33]);
        *(GAS v4u*)(WT + (size_t)(n0 + n) * K + k0 + 8 * c) = o; }
    LDS_WAIT(); asm volatile("" ::: "memory");
}
__device__ __forceinline__ void p0_weights(Frame& F) {
    LAS float* scr = (LAS float*)(F.lds + F.wave * 16384);
    const int gw = blockIdx.x * NWAVES + F.wave, NGW = F.G * NWAVES;
    constexpr int I_INA = 16 * (N_INA / 32), I_INB = 16 * (N_INB / 32), I_OH = 8 * 32, I_OUT = 16 * 32, I_GU = 16 * (2 * DFF / 32), I_DN = (DFF / 64) * 32;
    constexpr int I_LAYER = I_INA + I_INB + 2 * I_OH + I_OUT + I_GU + I_DN;
    for (int it = gw; it < DEPTH * I_LAYER; it += NGW) {
        const int l = it / I_LAYER; int r = it % I_LAYER;
        bf16* wl = (bf16*)(F.ws + WS_W) + (size_t)l * W_LAYER;
        if (r < I_INA) { const int nblk = N_INA / 32; transpose_item(F.in[3] + (size_t)l * DM * INW, DM, INW, wl + W_INA, MAT_INA, F.in[2] + l * DM, scr, r / nblk, r % nblk, F.lane); continue; } r -= I_INA;
        if (r < I_INB) { const int nblk = N_INB / 32; transpose_item(F.in[3] + (size_t)l * DM * INW, DM, INW, wl + W_INB, MAT_INB, F.in[2] + l * DM, scr, r / nblk, r % nblk, F.lane); continue; } r -= I_INB;
        if (r < I_OH) { transpose_item(F.in[9] + (size_t)l * 512 * DM, 512, DM, wl + W_O2, MAT_OHG, nullptr, scr, r / 32, r % 32, F.lane); continue; } r -= I_OH;
        if (r < I_OH) { transpose_item(F.in[10] + (size_t)l * 512 * DM, 512, DM, wl + W_O2 + (size_t)1024 * 512, MAT_ODN, nullptr, scr, r / 32, r % 32, F.lane); continue; } r -= I_OH;
        if (r < I_OUT) { transpose_item(F.in[11] + (size_t)l * DM * DM, DM, DM, wl + W_OUT, MAT_OUT, nullptr, scr, r / 32, r % 32, F.lane); continue; } r -= I_OUT;
        if (r < I_GU) { const int nblk = 2 * DFF / 32; transpose_item(F.in[14] + (size_t)l * DM * 2 * DFF, DM, 2 * DFF, wl + W_GU, MAT_GU, F.in[13] + l * DM, scr, r / nblk, r % nblk, F.lane); continue; } r -= I_GU;
        transpose_item(F.in[15] + (size_t)l * DFF * DM, DFF, DM, wl + W_DN, MAT_DN, nullptr, scr, r / 32, r % 32, F.lane);
    }
}
__device__ __forceinline__ void wab_stage(Frame& F, int l) {
    __syncthreads();
    LAS float* W = (LAS float*)F.lds;
    const float* win = F.in[3] + (size_t)l * DM * INW + 4096; const float* gain = F.in[2] + l * DM;
#pragma unroll
    for (int i = 0; i < 2; ++i) { const int k = F.tid + 512 * i; const float g = gain[k];
        const f32x4 a = *(const GAS f32x4*)(win + (size_t)k * INW), c = *(const GAS f32x4*)(win + (size_t)k * INW + 4);
#pragma unroll
        for (int e = 0; e < 4; ++e) { W[e * 1024 + k] = a[e] * g; W[(4 + e) * 1024 + k] = c[e] * g; } }
    __syncthreads();
}
__device__ __forceinline__ void wab_row(Frame& F, const float* hn, int m) {
    const LAS float* W = (const LAS float*)F.lds;
    float r[8];
#pragma unroll
    for (int j = 0; j < 8; ++j) { const LAS f32x4* p = (const LAS f32x4*)(W + j * 1024) + 2 * F.lane; const f32x4 a = p[0], c = p[1], d = p[128], e = p[129];
        float s = 0.f;
#pragma unroll
        for (int t = 0; t < 4; ++t) s += hn[t] * a[t] + hn[4 + t] * c[t] + hn[8 + t] * d[t] + hn[12 + t] * e[t];
        r[j] = wave_sum(s); }
    if (F.lane == 0) { GAS f32x4* o = (GAS f32x4*)((float*)(F.ws + WS_AB) + (size_t)m * 8); o[0] = (f32x4){r[0], r[1], r[2], r[3]}; o[1] = (f32x4){r[4], r[5], r[6], r[7]}; }
}
__device__ __forceinline__ void p0_rows(Frame& F) {
    wab_stage(F, 0);
    const int gw = blockIdx.x * NWAVES + F.wave, NGW = F.G * NWAVES;
    bf16* R = (bf16*)(F.ws + WS_R); float* rstd = (float*)(F.ws + WS_RSTD);
    f32x4 cur[4], nxt[4];
    if (gw < MTOK) { const GAS f32x4* xr = (const GAS f32x4*)(F.in[0] + (size_t)gw * DM) + 2 * F.lane; cur[0] = xr[0]; cur[1] = xr[1]; cur[2] = xr[128]; cur[3] = xr[129]; }
    for (int m = gw; m < MTOK; m += NGW) {
        const int mn = m + NGW;
        if (mn < MTOK) { const GAS f32x4* xr = (const GAS f32x4*)(F.in[0] + (size_t)mn * DM) + 2 * F.lane; nxt[0] = xr[0]; nxt[1] = xr[1]; nxt[2] = xr[128]; nxt[3] = xr[129]; }
        float s = 0.f;
#pragma unroll
        for (int j = 0; j < 4; ++j) s += (cur[j].x * cur[j].x + cur[j].y * cur[j].y) + (cur[j].z * cur[j].z + cur[j].w * cur[j].w);
        const float rs = __builtin_amdgcn_rsqf(wave_sum(s) * (1.f / DM) + EPSF);
        if (F.lane == 0) rstd[m] = rs;
#pragma unroll
        for (int j = 0; j < 4; ++j) cur[j] = cur[j] * rs;
        { float hn[16];
#pragma unroll
          for (int j = 0; j < 4; ++j) { hn[4 * j] = cur[j].x; hn[4 * j + 1] = cur[j].y; hn[4 * j + 2] = cur[j].z; hn[4 * j + 3] = cur[j].w; }
          wab_row(F, hn, m); }
        GAS v4u* o8 = (GAS v4u*)(R + (size_t)m * DM) + F.lane;
        o8[0] = (v4u){pk2(cur[0].x, cur[0].y), pk2(cur[0].z, cur[0].w), pk2(cur[1].x, cur[1].y), pk2(cur[1].z, cur[1].w)};
        o8[64] = (v4u){pk2(cur[2].x, cur[2].y), pk2(cur[2].z, cur[2].w), pk2(cur[3].x, cur[3].y), pk2(cur[3].z, cur[3].w)};
#pragma unroll
        for (int j = 0; j < 4; ++j) cur[j] = nxt[j];
    }
}
struct RowRegs { v4u t[2]; v4u rb[2]; f32x4 rf[4]; float rs; };
template <bool RESID_F32>
__device__ __forceinline__ void row_load(RowRegs& a, const bf16* tin, const float* resid32, const bf16* R, const float* rs_in, int m, int lane) {
    const GAS v4u* tr = (const GAS v4u*)(tin + (size_t)m * DM) + lane; a.t[0] = tr[0]; a.t[1] = tr[64];
    if (RESID_F32) { const GAS f32x4* xr = (const GAS f32x4*)(resid32 + (size_t)m * DM) + 2 * lane; a.rf[0] = xr[0]; a.rf[1] = xr[1]; a.rf[2] = xr[128]; a.rf[3] = xr[129]; }
    else { const GAS v4u* rr = (const GAS v4u*)(R + (size_t)m * DM) + lane; a.rb[0] = rr[0]; a.rb[1] = rr[64]; int mv = m; asm volatile("" : "+v"(mv));
        a.rs = ((const GAS float*)rs_in)[mv]; }
}
__device__ __forceinline__ void unpack8(const v4u q, float* o) { o[0] = bflo(q.x); o[1] = bfhi(q.x); o[2] = bflo(q.y); o[3] = bfhi(q.y); o[4] = bflo(q.z); o[5] = bfhi(q.z); o[6] = bflo(q.w); o[7] = bfhi(q.w); }
template <bool RESID_F32, bool OUT_F32, bool WITH_AB = false>
__device__ __forceinline__ void rowpass(Frame& F, const bf16* tin, const float* resid32, const float* w, float* out32, int rs_sel, int gw, int NGW, int MEND) {
    bf16* R = (bf16*)(F.ws + WS_R); const float* rs_in = (const float*)(F.ws + WS_RSTD) + (size_t)rs_sel * MTOK; float* rstd = (float*)(F.ws + WS_RSTD) + (size_t)(rs_sel ^ 1) * MTOK;
    float wv[16];
    { const GAS f32x4* wp = (const GAS f32x4*)w + 2 * F.lane; const f32x4 a = wp[0], b = wp[1], c = wp[128], d = wp[129];
#pragma unroll
      for (int e = 0; e < 4; ++e) { wv[e] = a[e]; wv[4 + e] = b[e]; wv[8 + e] = c[e]; wv[12 + e] = d[e]; } }
    RowRegs cur, nxt;
    if (gw < MEND) row_load<RESID_F32>(cur, tin, resid32, R, rs_in, gw, F.lane);
    for (int m = gw; m < MEND; m += NGW) {
        const int mn = m + NGW;
        if (mn < MEND) row_load<RESID_F32>(nxt, tin, resid32, R, rs_in, mn, F.lane);
        float t[16], h[16];
        unpack8(cur.t[0], t); unpack8(cur.t[1], t + 8);
        if (RESID_F32) {
#pragma unroll
            for (int e = 0; e < 4; ++e) { h[e] = cur.rf[0][e]; h[4 + e] = cur.rf[1][e]; h[8 + e] = cur.rf[2][e]; h[12 + e] = cur.rf[3][e]; }
        } else { unpack8(cur.rb[0], h); unpack8(cur.rb[1], h + 8); const float ir = __builtin_amdgcn_rcpf(cur.rs);
#pragma unroll
            for (int e = 0; e < 16; ++e) h[e] *= ir; }
        float s = 0.f;
#pragma unroll
        for (int e = 0; e < 16; ++e) s += t[e] * t[e];
        const float r1 = __builtin_amdgcn_rsqf(wave_sum(s) * (1.f / DM) + EPSF);
        float s2 = 0.f;
#pragma unroll
        for (int e = 0; e < 16; ++e) { h[e] = h[e] + t[e] * r1 * wv[e]; s2 += h[e] * h[e]; }
        if (OUT_F32) {
            GAS f32x4* o = (GAS f32x4*)(out32 + (size_t)m * DM) + 2 * F.lane;
            o[0] = (f32x4){h[0], h[1], h[2], h[3]}; o[1] = (f32x4){h[4], h[5], h[6], h[7]}; o[128] = (f32x4){h[8], h[9], h[10], h[11]}; o[129] = (f32x4){h[12], h[13], h[14], h[15]};
        } else {
            const float rn = __builtin_amdgcn_rsqf(wave_sum(s2) * (1.f / DM) + EPSF);
            if (F.lane == 0) rstd[m] = rn;
#pragma unroll
            for (int e = 0; e < 16; ++e) h[e] *= rn;
            if (WITH_AB) wab_row(F, h, m);
            GAS v4u* o8 = (GAS v4u*)(R + (size_t)m * DM) + F.lane;
            o8[0] = (v4u){pk2(h[0], h[1]), pk2(h[2], h[3]), pk2(h[4], h[5]), pk2(h[6], h[7])};
            o8[64] = (v4u){pk2(h[8], h[9]), pk2(h[10], h[11]), pk2(h[12], h[13]), pk2(h[14], h[15])};
        }
        cur = nxt;
    }
}
__device__ __forceinline__ void post_phase(Frame& F, int l) {
    const int gw = blockIdx.x * NWAVES + F.wave, NGW = F.G * NWAVES;
    const bf16* oraw = (const bf16*)(F.ws + WS_ORAW); bf16* ocat = (bf16*)((unsigned char*)F.out + 128 * MiB);
    const bf16* planes = (const bf16*)(F.ws + WS_P);
    const int d0 = (8 * F.lane) & 127;
#pragma unroll
    for (int br = 0; br < 2; ++br) {
        float nw[8];
#pragma unroll
        for (int j = 0; j < 8; ++j) nw[j] = (br ? F.in[8] : F.in[4])[l * HDIM + d0 + j];
        const bf16* op = oraw + (size_t)br * PLANE; const bf16* gp = planes + (size_t)(br ? 7 : 6) * PLANE;   bf16* cp = ocat + (size_t)br * PLANE;
        for (int m0 = gw; m0 < MTOK; m0 += 4 * NGW) {
            v4u ov[4], gv[4];
#pragma unroll
            for (int u = 0; u < 4; ++u) { const int m = m0 + u * NGW; if (m < MTOK) { ov[u] = *(const GAS v4u*)(op + (size_t)m * 512 + 8 * F.lane); gv[u] = *(const GAS v4u*)(gp + (size_t)m * 512 + 8 * F.lane); } }
#pragma unroll
            for (int u = 0; u < 4; ++u) { const int m = m0 + u * NGW; if (m < MTOK) {
                const float o[8] = {bflo(ov[u].x), bfhi(ov[u].x), bflo(ov[u].y), bfhi(ov[u].y), bflo(ov[u].z), bfhi(ov[u].z), bflo(ov[u].w), bfhi(ov[u].w)};
                const float g[8] = {bflo(gv[u].x), bfhi(gv[u].x), bflo(gv[u].y), bfhi(gv[u].y), bflo(gv[u].z), bfhi(gv[u].z), bflo(gv[u].w), bfhi(gv[u].w)};
                float s = 0.f;
#pragma unroll
                for (int j = 0; j < 8; ++j) s += o[j] * o[j];
                s += __builtin_bit_cast(float, __builtin_amdgcn_update_dpp(0, __builtin_bit_cast(int, s), 0xB1, 0xF, 0xF, true));
                s += __builtin_bit_cast(float, __builtin_amdgcn_update_dpp(0, __builtin_bit_cast(int, s), 0x4E, 0xF, 0xF, true));
                s += __builtin_bit_cast(float, __builtin_amdgcn_update_dpp(0, __builtin_bit_cast(int, s), 0x141, 0xF, 0xF, true));
                s += __builtin_bit_cast(float, __builtin_amdgcn_update_dpp(0, __builtin_bit_cast(int, s), 0x140, 0xF, 0xF, true));
                const float rs = __builtin_amdgcn_rsqf(s * (1.f / HDIM) + EPSF);
                float r[8];
#pragma unroll
                for (int j = 0; j < 8; ++j) r[j] = o[j] * rs * nw[j] * (g[j] * sigmf(g[j]));
                v4u w; w.x = pk2(r[0], r[1]); w.y = pk2(r[2], r[3]); w.z = pk2(r[4], r[5]); w.w = pk2(r[6], r[7]);
                *(GAS v4u*)(cp + (size_t)m * 512 + 8 * F.lane) = w; } }
        }
    }
}

#ifndef DUP_MASK
#define DUP_MASK 0
#endif
#define REP(k) _Pragma("unroll") for (int rep_ = 0; rep_ < (((DUP_MASK >> (k)) & 1) ? 2 : 1); ++rep_)
#define IN(k) (lo <= (k) && (k) < hi)
#define SEAM(k) do { if (IN(k) && IN((k) + 1)) xcd_barrier(bar); } while (0)
#ifndef GB_UNITS
#define GB_UNITS 10
#endif
template <int l> __device__ __forceinline__ void layer_phases(Frame& F, const XcdBarrier& bar, const int lo, const int hi) {
        const int pb = 1 + 11 * l;
        const pg8::bf16_t* wl = (const pg8::bf16_t*)(F.ws + WS_W) + (size_t)l * W_LAYER;
        pg8::bf16_t* Rb = (pg8::bf16_t*)(F.ws + WS_R);
        REP(0) if (IN(pb + 0)) {
            pg8::Gemm g{Rb, wl + W_INA, MTOK, N_INA, DM}; pg8::StaticOrder S; S.init(MTOK, N_INA, F.G, (int)blockIdx.x);
            pg8::EpiProjA E{(pg8::bf16_t*)(F.ws + WS_P), PLANE};
            pg8::gemm_phase<pg8::EpiProjA, pg8::StaticOrder, PG8_ALIGN, PG8_SP2>(F.lds, g, S, E);
        }
        SEAM(pb + 0);
        REP(1) if (IN(pb + 1)) {
            { HgRaw cur, nxt; if ((int)blockIdx.x < NUNIT) hg_raw_load(cur, F, blockIdx.x, F.lane);
              for (int u = blockIdx.x; u < NUNIT; u += F.G) { if (u + F.G < NUNIT) hg_raw_load(nxt, F, u + F.G, F.lane); prep_hg_unit(F, l, u, cur); cur = nxt; } }
            { DnRaw cur, nxt; if ((int)blockIdx.x < NUNIT) dn_raw_load(cur, F, blockIdx.x, F.tid, F.lane);
              for (int u = blockIdx.x; u < NUNIT; u += F.G) { if (u + F.G < NUNIT) dn_raw_load(nxt, F, u + F.G, F.tid, F.lane); prep_dn_unit(F, l, u, cur); cur = nxt; } }
        }
        SEAM(pb + 1);
        REP(2) if (IN(pb + 2)) {
            const int bid = blockIdx.x; const bool grpA = (bid & 24) == 0;
            if (F.G == 256) {
                const int ja = (bid >> 5) * 8 + (bid & 7), jb = (bid & 7) + 8 * ((((bid >> 3) & 3) - 1) + 3 * (bid >> 5));
                if (grpA) { if (ja < 32) scan4_hg(F, l, ja); else scan4_dn(F, l, ja - 32); }
                pg8::Gemm g{Rb, wl + W_INB, MTOK, N_INB, DM}; pg8::SplitOrder S; S.so.init(MTOK, N_INB, F.G, 0);
                S.first = grpA ? 192 * GB_UNITS + ja : jb; S.stride = grpA ? 64 : 192; S.count = grpA ? (2048 - 192 * GB_UNITS) / 64 : GB_UNITS;
                pg8::EpiGate E{(pg8::bf16_t*)(F.ws + WS_GATES), (size_t)MTOK * DM};
                pg8::gemm_phase<pg8::EpiGate, pg8::SplitOrder, PG8_ALIGN, PG8_SP2>(F.lds, g, S, E);
            }
        }
        SEAM(pb + 2);
        REP(3) if (IN(pb + 3)) post_phase(F, l);
        SEAM(pb + 3);
        REP(5) if (IN(pb + 5)) {
            pg8::Gemm g{(const pg8::bf16_t*)((unsigned char*)F.out + 128 * MiB), wl + W_O2, 2 * MTOK, 2048, 512};
            pg8::PairOrder S; S.so.init(MTOK, DM, F.G, (int)blockIdx.x);
            pg8::EpiMerge E{(pg8::bf16_t*)(F.ws + WS_MERGED), (const pg8::bf16_t*)(F.ws + WS_GATES), (size_t)MTOK * DM};
            pg8::gemm_phase<pg8::EpiMerge, pg8::PairOrder, PG8_ALIGN, PG8_SP2>(F.lds, g, S, E);
        }
        SEAM(pb + 5);
        REP(6) if (IN(pb + 6)) {
            pg8::Gemm g{(const pg8::bf16_t*)(F.ws + WS_MERGED), wl + W_OUT, MTOK, DM, DM}; pg8::StaticOrder S; S.init(MTOK, DM, F.G, (int)blockIdx.x);
            pg8::EpiBf16<0> E{(pg8::bf16_t*)(F.ws + WS_MIX), DM, nullptr, 0, 0, 1.f};
            pg8::gemm_phase<pg8::EpiBf16<0>, pg8::StaticOrder, PG8_ALIGN, PG8_SP2>(F.lds, g, S, E);
        }
        SEAM(pb + 6);
        REP(7) if (IN(pb + 7)) {
            const int gw = blockIdx.x * NWAVES + F.wave, NGW = F.G * NWAVES;
            if (l == 0) rowpass<true, false>(F, (const bf16*)(F.ws + WS_MIX), F.in[0], F.in[12] + l * DM, nullptr, 0, gw, NGW, MTOK);
            else rowpass<false, false>(F, (const bf16*)(F.ws + WS_MIX), nullptr, F.in[12] + l * DM, nullptr, 0, gw, NGW, MTOK);
        }
        SEAM(pb + 7);
        REP(8) if (IN(pb + 8)) {
            pg8::Gemm g{Rb, wl + W_GU, MTOK, 2 * DFF, DM}; pg8::StaticOrder S; S.init(MTOK, 2 * DFF, F.G, (int)blockIdx.x);
            pg8::EpiSwiGLU E{(pg8::bf16_t*)(F.ws + WS_ACT)};
            pg8::gemm_phase<pg8::EpiSwiGLU, pg8::StaticOrder, PG8_ALIGN, PG8_SP2>(F.lds, g, S, E);
        }
        SEAM(pb + 8);
        REP(9) if (IN(pb + 9)) {
            pg8::Gemm g{(const pg8::bf16_t*)(F.ws + WS_ACT), wl + W_DN, MTOK, DM, DFF}; pg8::StaticOrder S; S.init(MTOK, DM, F.G, (int)blockIdx.x);
            pg8::EpiBf16<0> E{(pg8::bf16_t*)(F.ws + WS_F), DM, nullptr, 0, 0, 1.f};
            pg8::gemm_phase<pg8::EpiBf16<0>, pg8::StaticOrder, PG8_ALIGN, PG8_SP2>(F.lds, g, S, E);
        }
        SEAM(pb + 9);
        REP(10) if (IN(pb + 10)) {
            const int gw = blockIdx.x * NWAVES + F.wave, NGW = F.G * NWAVES;
            if (l == DEPTH - 1) rowpass<false, true>(F, (const bf16*)(F.ws + WS_F), nullptr, F.in[16] + l * DM, F.out, 1, gw, NGW, MTOK);
            else { wab_stage(F, l + 1); rowpass<false, false, true>(F, (const bf16*)(F.ws + WS_F), nullptr, F.in[16] + l * DM, nullptr, 1, gw, NGW, MTOK); }
        }
        if (l + 1 < DEPTH) SEAM(pb + 10);
    }
#undef IN
#undef SEAM
struct Args { const float* in[17]; float* out; unsigned char* ws; int ph_lo, ph_hi; };
static_assert(sizeof(Args) == 17 * 8 + 8 + 8 + 8, "Args has no padding");
__global__ void __launch_bounds__(NWAVES * 64, 2) hybrid_fwd(Args args) {
    extern __shared__ __attribute__((aligned(16))) unsigned char lds[];
    Frame F;
    F.lds = (LAS unsigned char*)lds;
    F.MISC = (volatile LAS unsigned*)(F.lds + MISC_OFF);
    F.tid = threadIdx.x; F.lane = F.tid & 63; F.wave = __builtin_amdgcn_readfirstlane(F.tid >> 6);
    F.G = gridDim.x;
    F.ws = args.ws; F.out = args.out; F.ctl = (gu32*)(args.ws + WS_CTL);
#pragma unroll
    for (int i = 0; i < 17; ++i) F.in[i] = args.in[i];
    for (int u = F.tid; u < (LDS_BYTES - MISC_OFF) / 4; u += NWAVES * 64) ((LAS unsigned*)(F.lds + MISC_OFF))[u] = 0u;
    __syncthreads();
    const int lo = args.ph_lo, hi = args.ph_hi;
    XcdBarrier bar; bar.bar = (unsigned*)(F.ctl + CW_BAR); bar.x = 0; bar.st = nullptr;
    if (hi - lo > 1) bar = xcd_barrier_post((unsigned*)(F.ctl + CW_BAR), F.MISC + 8);
#define IN(k) (lo <= (k) && (k) < hi)
#define SEAM(k) do { if (IN(k) && IN((k) + 1)) xcd_barrier(bar); } while (0)

#ifndef NO_P0
    if (IN(0)) { p0_weights(F); p0_rows(F); }
#endif
    SEAM(0);

    layer_phases<0>(F, bar, lo, hi);
    layer_phases<1>(F, bar, lo, hi);
#undef IN
#undef SEAM
}

extern "C" void kernel_launch(void* const* d_in, const int* in_sizes, int n_in, void* d_out, int out_size, void* d_ws, size_t ws_size, hipStream_t stream) {
    static int grid = 0;
    if (grid == 0) {
        if (n_in != 17 || in_sizes[0] != MTOK * DM || out_size != MTOK * DM || ws_size < WS_END) {
            fprintf(stderr, "kernel_launch: unexpected shapes: n_in %d in0 %d out %d ws %zu (need %zu)\n", n_in, n_in > 0 ? in_sizes[0] : -1, out_size, ws_size, (size_t)WS_END); grid = -1; return; }
        int dev = 0, cus = 0, per_cu = 0;
        if (hipGetDevice(&dev) != hipSuccess || hipDeviceGetAttribute(&cus, hipDeviceAttributeMultiprocessorCount, dev) != hipSuccess) { grid = -1; return; }
        if (hipFuncSetAttribute((const void*)hybrid_fwd, hipFuncAttributeMaxDynamicSharedMemorySize, LDS_BYTES) != hipSuccess) { fprintf(stderr, "kernel_launch: hipFuncSetAttribute failed\n"); grid = -1; return; }
        if (hipOccupancyMaxActiveBlocksPerMultiprocessor(&per_cu, (const void*)hybrid_fwd, NWAVES * 64, LDS_BYTES) != hipSuccess || per_cu < 1)
            fprintf(stderr, "kernel_launch: note: occupancy query reports %d workgroups per CU\n", per_cu);
        (void)hipGetLastError();
        grid = cus;
    }
    if (grid < 0) return;
    if (hipMemsetAsync((char*)d_ws + WS_CTL, 0, CTL_ZERO_BYTES, stream) != hipSuccess) return;
    Args a{};
    for (int i = 0; i < 17; ++i) a.in[i] = (const float*)d_in[i];
    a.out = (float*)d_out; a.ws = (unsigned char*)d_ws;
#if MK_ONE_LAUNCH
    a.ph_lo = 0; a.ph_hi = N_PHASES;
    hipLaunchKernelGGL(hybrid_fwd, dim3(grid), dim3(NWAVES * 64), LDS_BYTES, stream, a);
#else
    for (int p = 0; p < N_PHASES; ++p) {
        a.ph_lo = p; a.ph_hi = p + 1;
        hipLaunchKernelGGL(hybrid_fwd, dim3(grid), dim3(NWAVES * 64), LDS_BYTES, stream, a);
    }
#endif
}
```

```cpp
#include <hip/hip_runtime.h>
#include <cstdio>
#include <cstdint>

constexpr int DM = 1024, BATCH = 8, SEQ = 8192, MTOK = BATCH * SEQ, DEPTH = 2;
constexpr int NHEAD = 4, HDIM = 128, HWID = 512;
constexpr int DFF = 2816, INW = 6152;
constexpr int N_INA = 4096;
constexpr int N_INB = 2048;
constexpr int CONVW = 4, CONVC = 1536;
constexpr float EPSF = 1e-6f;
#define MK_ONE_LAUNCH 1
#define HELPERS_LOAD 1
namespace pg8 {
#define PG8_LAS __attribute__((address_space(3)))
typedef unsigned short bf16_t;
typedef short bf16x8 __attribute__((ext_vector_type(8)));
typedef float f32x4 __attribute__((ext_vector_type(4)));
typedef unsigned u32x4 __attribute__((ext_vector_type(4)));
typedef int i32x4_ __attribute__((ext_vector_type(4)));
typedef int i32x8_ __attribute__((ext_vector_type(8)));
template <bool C, class A, class B> struct sel_ { using type = A; };
template <class A, class B> struct sel_<false, A, B> { using type = B; };
constexpr int BM = 256, BK = 64, HALF = 128, HTB = HALF * BK * 2  , STAGE_BYTES = 8 * HTB, NXCD = 8, WGM = 8;

__host__ __device__ __forceinline__ int lds_byte(int r, int c) { const int st = (r >> 4) * 2 + (c >> 5), rr = r & 15, cc = c & 31, ob = rr * 64 + cc * 2; return st * 1024 + (ob ^ (((ob >> 9) & 1) << 5)); }
__host__ __device__ __forceinline__ void stage_rc(int b, int& R, int& C) { const int st = b / 1024, sb = b % 1024, swz = sb ^ (((sb >> 9) & 1) << 5); R = (st >> 1) * 16 + swz / 64; C = (st & 1) * 32 + (swz % 64) / 2; }
__host__ __device__ __forceinline__ int perm32(int rho) { const int n = rho >> 4, i = rho & 15; return 8 * (i >> 2) + 4 * n + (i & 3); }

struct Unit { int pm, pn; };
struct Gemm { const bf16_t* A; const bf16_t* Bt; int M, N, K; const bf16_t* A2 = nullptr; int pm2 = 1 << 30; const bf16_t* A3 = nullptr; int pm3 = 1 << 30; };

struct StaticOrder {
    int nM, nN, nwg, G, c;
    __host__ __device__ void init(int M, int N, int G_, int c_) { nM = M / BM; nN = N / BM; nwg = nM * nN; G = G_; c = c_; }
    __host__ __device__ bool next(int i, Unit& u) const {
        const long L = (long)i * G + c; if (L >= nwg) return false;
        int wgid = (int)L; { const int q = nwg / NXCD, r = nwg % NXCD, xcd = wgid % NXCD, off = wgid / NXCD; wgid = (xcd < r ? xcd * (q + 1) : r * (q + 1) + (xcd - r) * q) + off; }
        const int nig = WGM * nN, gid = wgid / nig, fm = gid * WGM, gsz = (nM - fm) < WGM ? (nM - fm) : WGM;
        u.pm = fm + ((wgid % nig) % gsz); u.pn = (wgid % nig) / gsz; return true;
    }
    __device__ __forceinline__ void a_ready(const Unit&) const {}
    __device__ __forceinline__ void done(const Unit&) const {}
};

__device__ __forceinline__ unsigned cvt_pk_bf16(float lo, float hi) { unsigned r; asm volatile("v_cvt_pk_bf16_f32 %0, %1, %2" : "=v"(r) : "v"(lo), "v"(hi)); return r; }
typedef float f32x2 __attribute__((ext_vector_type(2)));
__device__ __forceinline__ f32x2 gelu_pk(f32x2 v) {
    const f32x2 av = __builtin_elementwise_abs(v), d = av * 0.2316418882f + 1.0f;
    f32x2 t; t.x = __builtin_amdgcn_rcpf(d.x); t.y = __builtin_amdgcn_rcpf(d.y);
    f32x2 q = t * 0.5307027145f + (-0.7265760135f); q = q * t + 0.7107068705f; q = q * t + (-0.142248368f); q = q * t + 0.127414796f; q = q * t;
    const f32x2 s = (v * v) * (-0.72134752044f);
    f32x2 e; e.x = __builtin_amdgcn_exp2f(s.x); e.y = __builtin_amdgcn_exp2f(s.y);
    const f32x2 m = v * (q * e), r = v - m;
    f32x2 o; o.x = v.x < 0.f ? m.x : r.x; o.y = v.y < 0.f ? m.y : r.y; return o;
}

template <int ACT  > struct EpiBf16 {
    static constexpr bool PERM = true, AFTER_DRAIN = false, HOOK = false; static_assert(ACT == 0 || ACT == 1, "EpiBf16: ACT is 0 (none) or 1 (gelu_pk)");
    bf16_t* O; int ldc; const float* bias; int split_cols; size_t split_stride; float scale0;
    __device__ __forceinline__ void operator()(const f32x4 (&acc)[2][2][4][2], const Unit& u, int wr, int wc, int fr, int fq) const {
        const int row0 = u.pm * BM + wr * 64 + fr; int colt = u.pn * BM; bf16_t* base = O;
        float sc = 1.f; if (split_cols) { const int t = colt / split_cols; base += (size_t)t * split_stride; colt -= t * split_cols; if (t == 0) sc = scale0; }
        const int col0 = colt + wc * 32 + 8 * fq, bcol0 = u.pn * BM + wc * 32 + 8 * fq;
        f32x4 bv[2][2];
#pragma unroll
        for (int bj = 0; bj < 2; ++bj)
#pragma unroll
            for (int n = 0; n < 2; ++n) bv[bj][n] = bias ? *(const f32x4*)(bias + bcol0 + bj * HALF + 4 * n) : (f32x4){0.f, 0.f, 0.f, 0.f};
#pragma unroll
        for (int ai = 0; ai < 2; ++ai)
#pragma unroll
            for (int m = 0; m < 4; ++m) { bf16_t* rowp = base + (size_t)(row0 + ai * HALF + m * 16) * ldc + col0;
#pragma unroll
                for (int bj = 0; bj < 2; ++bj) { f32x4 v0 = acc[ai][bj][m][0] + bv[bj][0], v1 = acc[ai][bj][m][1] + bv[bj][1];
                    if (ACT == 1) { f32x2 a = gelu_pk((f32x2){v0[0], v0[1]}), b = gelu_pk((f32x2){v0[2], v0[3]}), c = gelu_pk((f32x2){v1[0], v1[1]}), d = gelu_pk((f32x2){v1[2], v1[3]});
                        v0 = (f32x4){a.x, a.y, b.x, b.y}; v1 = (f32x4){c.x, c.y, d.x, d.y}; }
                    v0 = v0 * sc; v1 = v1 * sc; u32x4 w; w.x = cvt_pk_bf16(v0[0], v0[1]); w.y = cvt_pk_bf16(v0[2], v0[3]); w.z = cvt_pk_bf16(v1[0], v1[1]); w.w = cvt_pk_bf16(v1[2], v1[3]);
                    *(u32x4*)(rowp + bj * HALF) = w; } }
    }
};
__device__ __forceinline__ float bf_lo(unsigned w) { return __builtin_bit_cast(float, w << 16); }
__device__ __forceinline__ float bf_hi(unsigned w) { return __builtin_bit_cast(float, w & 0xffff0000u); }
__device__ __forceinline__ float sigm(float x) { return __builtin_amdgcn_rcpf(1.f + __expf(-x)); }
typedef __bf16 bfp2 __attribute__((ext_vector_type(2)));
__device__ __forceinline__ unsigned pkv(float lo, float hi) { f32x2 v = {lo, hi}; bfp2 r = __builtin_convertvector(v, bfp2); return __builtin_bit_cast(unsigned, r); }

struct EpiProjA {
    static constexpr bool PERM = true, AFTER_DRAIN = false, HOOK = false;
    bf16_t* planes; size_t plane_stride;
    __device__ __forceinline__ void operator()(const f32x4 (&acc)[2][2][4][2], const Unit& u, int wr, int wc, int fr, int fq) const {
        const int row0 = u.pm * BM + wr * 64 + fr;
        {
            const int pl = u.pn >> 1, slot = pl == 3 ? 6 : (pl == 6 ? 3 : pl); const bool gate = pl == 3 || pl == 7;
            bf16_t* base = planes + (size_t)slot * plane_stride;
            const int col0 = (u.pn & 1) * 256 + wc * 32 + 8 * fq;
#pragma unroll
            for (int ai = 0; ai < 2; ++ai)
#pragma unroll
                for (int m = 0; m < 4; ++m) { const int row = row0 + ai * HALF + m * 16; bf16_t* rowp = base + (size_t)row * 512 + col0;
#pragma unroll
                    for (int bj = 0; bj < 2; ++bj) { f32x4 v0 = acc[ai][bj][m][0], v1 = acc[ai][bj][m][1];
                        if (gate) {
#pragma unroll
                            for (int e = 0; e < 4; ++e) { v0[e] *= sigm(v0[e]); v1[e] *= sigm(v1[e]); } }
                        u32x4 w; w.x = pkv(v0[0], v0[1]); w.y = pkv(v0[2], v0[3]); w.z = pkv(v1[0], v1[1]); w.w = pkv(v1[2], v1[3]);
                        *(u32x4*)(rowp + bj * HALF) = w; } }
        }
    }
};
struct EpiGate {
    static constexpr bool PERM = true, AFTER_DRAIN = false, HOOK = false;
    unsigned char* gates; size_t plane_stride; float sc;
    __device__ __forceinline__ void operator()(const f32x4 (&acc)[2][2][4][2], const Unit& u, int wr, int wc, int fr, int fq) const {
        const int row0 = u.pm * BM + wr * 64 + fr;
        unsigned char* base = gates + (size_t)(u.pn >> 2) * plane_stride;
        const int col0 = (u.pn & 3) * 256 + wc * 32 + 8 * fq;
#pragma unroll
        for (int ai = 0; ai < 2; ++ai)
#pragma unroll
            for (int m = 0; m < 4; ++m) { const int row = row0 + ai * HALF + m * 16; unsigned char* rowp = base + (size_t)row * 1024 + col0;
#pragma unroll
                for (int bj = 0; bj < 2; ++bj) { f32x4 v0 = acc[ai][bj][m][0], v1 = acc[ai][bj][m][1]; unsigned q[8];
#pragma unroll
                    for (int e = 0; e < 4; ++e) { q[e] = (unsigned)fmaxf(sigm(v0[e] * sc) * 255.f + 0.5f, 1.f); q[4 + e] = (unsigned)fmaxf(sigm(v1[e] * sc) * 255.f + 0.5f, 1.f);     }
                    f32x2 w_; unsigned w0 = q[0] | (q[1] << 8) | (q[2] << 16) | (q[3] << 24), w1 = q[4] | (q[5] << 8) | (q[6] << 16) | (q[7] << 24);
                    typedef unsigned u32x2 __attribute__((ext_vector_type(2)));
                    *(u32x2*)(rowp + bj * HALF) = (u32x2){w0, w1}; (void)w_; } }
    }
};
struct EpiMerge {
    static constexpr bool PERM = true, AFTER_DRAIN = false, HOOK = true;
    bf16_t* out; const unsigned char* gates; size_t gate_stride; const bf16_t* sums;
    PG8_LAS unsigned char* lds_tab; int par;
    static constexpr int TAB_OFF = STAGE_BYTES, TAB_BYTES = 8192;
    typedef unsigned u32x2 __attribute__((ext_vector_type(2)));
    __device__ __forceinline__ bool is_switch(const Unit& u) const { return u.pm < (MTOK / BM); }
    __device__ __forceinline__ void hook_prefetch(const Unit& u, int tid, u32x4 (&q)[2]) const {
        if (tid < 256) { const int br = u.pm >= (MTOK / BM) ? 1 : 0; const size_t m = (size_t)(u.pm - br * (MTOK / BM)) * BM + tid;
            const u32x4* p = (const u32x4*)(sums + (m * 8 + br * 4) * 4); q[0] = p[0]; q[1] = p[1]; }
    }
    __device__ __forceinline__ void hook_table(PG8_LAS unsigned char* lds, int parity, int tid, const u32x4 (&q)[2]) const {
        if (tid < 256) { const unsigned w[8] = {q[0].x, q[0].y, q[0].z, q[0].w, q[1].x, q[1].y, q[1].z, q[1].w}; float rs[4];
#pragma unroll
            for (int h = 0; h < 4; ++h) { const float ss = (bf_lo(w[2 * h]) + bf_hi(w[2 * h])) + (bf_lo(w[2 * h + 1]) + bf_hi(w[2 * h + 1])); rs[h] = __builtin_amdgcn_rsqf(ss * (1.f / HDIM) + EPSF); }
            const f32x4 t = {rs[0] * __builtin_amdgcn_rcpf(rs[1]), rs[1] * __builtin_amdgcn_rcpf(rs[2]), rs[2] * __builtin_amdgcn_rcpf(rs[3]), rs[3]};
            PG8_LAS f32x4* d = (PG8_LAS f32x4*)(lds + TAB_OFF + parity * TAB_BYTES + tid * 32); d[0] = t; d[1] = (f32x4){__builtin_amdgcn_rcpf(rs[0]), 0.f, 0.f, 0.f}; }
    }
    __device__ __forceinline__ void hook_scale(f32x4 (&acc)[2][2][4][2], PG8_LAS unsigned char* lds, int parity, int hidx, int wr, int fr) const {
        float sc[2][4];
        const PG8_LAS unsigned char* tb = lds + TAB_OFF + parity * TAB_BYTES + (wr * 64 + fr) * 32 + hidx * 4;
#pragma unroll
        for (int ai = 0; ai < 2; ++ai)
#pragma unroll
            for (int m = 0; m < 4; ++m) sc[ai][m] = *(const PG8_LAS float*)(tb + (ai * HALF + m * 16) * 32);
        asm volatile("s_waitcnt lgkmcnt(0)" ::: "memory");
#pragma unroll
        for (int ai = 0; ai < 2; ++ai)
#pragma unroll
            for (int m = 0; m < 4; ++m)
#pragma unroll
                for (int bj = 0; bj < 2; ++bj)
#pragma unroll
                    for (int n = 0; n < 2; ++n) acc[ai][bj][m][n] = acc[ai][bj][m][n] * sc[ai][m];
    }
    __device__ __forceinline__ void switch_branch(f32x4 (&acc)[2][2][4][2], const Unit& u, PG8_LAS unsigned char* lds, int par_cur, int par_nxt, int wr, int wc, int fr, int fq) const {
        const int row0 = u.pm * BM + wr * 64 + fr, col0 = u.pn * 256 + wc * 32 + 8 * fq;
#pragma unroll
        for (int grp = 0; grp < 4; ++grp) { const int ai = grp >> 1, m0 = 2 * (grp & 1); u32x2 ga[2][2], gb2[2][2]; float f[2];
#pragma unroll
            for (int mm = 0; mm < 2; ++mm) { const int rl = ai * HALF + wr * 64 + (m0 + mm) * 16 + fr;
                f[mm] = *(const PG8_LAS float*)(lds + TAB_OFF + par_cur * TAB_BYTES + rl * 32 + 12) * *(const PG8_LAS float*)(lds + TAB_OFF + par_nxt * TAB_BYTES + rl * 32 + 16);
#pragma unroll
                for (int bj = 0; bj < 2; ++bj) { const size_t off = (size_t)(row0 + ai * HALF + (m0 + mm) * 16) * 1024 + col0 + bj * HALF; ga[mm][bj] = *(const u32x2*)(gates + off); gb2[mm][bj] = *(const u32x2*)(gates + gate_stride + off); } }
#pragma unroll
            for (int mm = 0; mm < 2; ++mm)
#pragma unroll
                for (int bj = 0; bj < 2; ++bj)
#pragma unroll
                    for (int n = 0; n < 2; ++n) { const unsigned wa = n ? ga[mm][bj].y : ga[mm][bj].x, wb = n ? gb2[mm][bj].y : gb2[mm][bj].x; f32x4 v = acc[ai][bj][m0 + mm][n];
#pragma unroll
                        for (int e = 0; e < 4; ++e) v[e] *= f[mm] * ((float)((wa >> (8 * e)) & 0xffu) * __builtin_amdgcn_rcpf((float)((wb >> (8 * e)) & 0xffu)));
                        acc[ai][bj][m0 + mm][n] = v; } }
    }
    __device__ __forceinline__ void operator()(const f32x4 (&acc)[2][2][4][2], const Unit& u, int wr, int wc, int fr, int fq) const {
        const int pm = u.pm - (MTOK / BM), pn = u.pn - 4;
        const int row0 = pm * BM + wr * 64 + fr, col0 = pn * 256 + wc * 32 + 8 * fq;
        const unsigned char* gb = gates + gate_stride;
        u32x2 gv[2][4][2];
#pragma unroll
        for (int ai = 0; ai < 2; ++ai)
#pragma unroll
            for (int m = 0; m < 4; ++m)
#pragma unroll
                for (int bj = 0; bj < 2; ++bj) gv[ai][m][bj] = *(const u32x2*)(gb + (size_t)(row0 + ai * HALF + m * 16) * 1024 + col0 + bj * HALF);
#pragma unroll
        for (int ai = 0; ai < 2; ++ai)
#pragma unroll
            for (int m = 0; m < 4; ++m) { const size_t off = (size_t)(row0 + ai * HALF + m * 16) * 1024 + col0;
                const float rq = *(const PG8_LAS float*)(lds_tab + TAB_OFF + par * TAB_BYTES + (ai * HALF + wr * 64 + m * 16 + fr) * 32 + 12) * (1.f / 255.f);
#pragma unroll
                for (int bj = 0; bj < 2; ++bj) { const u32x2 g = gv[ai][m][bj];
                    f32x4 v0 = acc[ai][bj][m][0] * rq, v1 = acc[ai][bj][m][1] * rq;
                    v0[0] *= (float)((g.x >> 0) & 0xffu); v0[1] *= (float)((g.x >> 8) & 0xffu); v0[2] *= (float)((g.x >> 16) & 0xffu); v0[3] *= (float)((g.x >> 24) & 0xffu);
                    v1[0] *= (float)((g.y >> 0) & 0xffu); v1[1] *= (float)((g.y >> 8) & 0xffu); v1[2] *= (float)((g.y >> 16) & 0xffu); v1[3] *= (float)((g.y >> 24) & 0xffu);
                    u32x4 w; w.x = pkv(v0[0], v0[1]); w.y = pkv(v0[2], v0[3]); w.z = pkv(v1[0], v1[1]); w.w = pkv(v1[2], v1[3]);
                    *(u32x4*)(out + off + bj * HALF) = w; } }
    }
};
struct PairOrder {
    StaticOrder so;
    __device__ __forceinline__ bool next(int i, Unit& u) const { Unit t; if (!so.next(i >> 1, t)) return false; const int br = i & 1; u.pm = t.pm + br * (MTOK / BM); u.pn = t.pn + br * 4; return true; }
    __device__ __forceinline__ void a_ready(const Unit&) const {}
    __device__ __forceinline__ void done(const Unit&) const {}
};
struct SplitOrder {
    StaticOrder so; int first, stride, count, wgm;
    __device__ __forceinline__ bool next(int i, Unit& u) const {
        if (i >= count) return false;
        int wgid = first + i * stride; { const int q = so.nwg / NXCD, r = so.nwg % NXCD, xcd = wgid % NXCD, off = wgid / NXCD; wgid = (xcd < r ? xcd * (q + 1) : r * (q + 1) + (xcd - r) * q) + off; }
        const int nig = wgm * so.nN, gid = wgid / nig, fm = gid * wgm, gsz = (so.nM - fm) < wgm ? (so.nM - fm) : wgm;
        u.pm = fm + ((wgid % nig) % gsz); u.pn = (wgid % nig) / gsz; return true;
    }
    __device__ __forceinline__ void a_ready(const Unit&) const {}
    __device__ __forceinline__ void done(const Unit&) const {}
};
struct GateOrder {
    int pm0, i0, count, xcd, k, pool;
    __device__ __forceinline__ bool next(int i, Unit& u) const { if (i >= count) return false;
        if (pool) { u.pm = pm0 + i * 8 + xcd; u.pn = k; } else { u.pm = pm0 + ((i0 + i) * 8 + xcd) * 2 + (k & 1); u.pn = k >> 1; } return true; }
    __device__ __forceinline__ void a_ready(const Unit&) const {}
    __device__ __forceinline__ void done(const Unit&) const {}
};
struct PanelOrder {
    int pm;
    __device__ __forceinline__ bool next(int i, Unit& u) const { if (i >= 4) return false; u.pm = pm; u.pn = i; return true; }
    __device__ __forceinline__ void a_ready(const Unit&) const {}
    __device__ __forceinline__ void done(const Unit&) const {}
};
struct EpiBf16Sc1 {
    static constexpr bool PERM = true, AFTER_DRAIN = false, HOOK = false;
    bf16_t* O; int ldc;
    __device__ __forceinline__ void operator()(const f32x4 (&acc)[2][2][4][2], const Unit& u, int wr, int wc, int fr, int fq) const {
        const __amdgpu_buffer_rsrc_t rs = __builtin_amdgcn_make_buffer_rsrc((void*)O, (short)0, (int)((size_t)MTOK * 1024 * 2), 0x00020000);
        const int row0 = u.pm * BM + wr * 64 + fr, col0 = u.pn * BM + wc * 32 + 8 * fq;
#pragma unroll
        for (int ai = 0; ai < 2; ++ai)
#pragma unroll
            for (int m = 0; m < 4; ++m) { const unsigned off = (unsigned)(((row0 + ai * HALF + m * 16) * ldc + col0) * 2);
#pragma unroll
                for (int bj = 0; bj < 2; ++bj) { const f32x4 v0 = acc[ai][bj][m][0], v1 = acc[ai][bj][m][1];
                    u32x4 w; w.x = pkv(v0[0], v0[1]); w.y = pkv(v0[2], v0[3]); w.z = pkv(v1[0], v1[1]); w.w = pkv(v1[2], v1[3]);
                    __builtin_amdgcn_raw_buffer_store_b128(w, rs, off + (unsigned)(bj * HALF * 2), 0, 16); } }
    }
};
struct OneUnit {
    Unit u;
    __device__ __forceinline__ bool next(int i, Unit& o) const { if (i != 0) return false; o = u; return true; }
    __device__ __forceinline__ void a_ready(const Unit&) const {}
    __device__ __forceinline__ void done(const Unit&) const {}
};
struct EpiSwiGLU {
    static constexpr bool PERM = true, AFTER_DRAIN = false, HOOK = false;
    bf16_t* act;
    __device__ __forceinline__ void operator()(const f32x4 (&acc)[2][2][4][2], const Unit& u, int wr, int wc, int fr, int fq) const {
        const int row0 = u.pm * BM + wr * 64 + fr, col0 = u.pn * 128 + wc * 32 + 8 * fq;
#pragma unroll
        for (int ai = 0; ai < 2; ++ai)
#pragma unroll
            for (int m = 0; m < 4; ++m) { const int row = row0 + ai * HALF + m * 16;
                float o[8];
#pragma unroll
                for (int n = 0; n < 2; ++n)
#pragma unroll
                    for (int e = 0; e < 4; ++e) { const float g = acc[ai][0][m][n][e], uu = acc[ai][1][m][n][e]; o[n * 4 + e] = g * sigm(g) * uu; }
                u32x4 w; w.x = pkv(o[0], o[1]); w.y = pkv(o[2], o[3]); w.z = pkv(o[4], o[5]); w.w = pkv(o[6], o[7]);
                *(u32x4*)(act + (size_t)row * DFF + col0) = w; }
    }
};

#ifndef PG8_SADDR_ALL
#define PG8_SADDR_ALL 0
#endif
template <class Epi, class Sched, bool ALIGN_EPI = false, bool SP2 = false, bool F8 = false>
__device__ __forceinline__ void gemm_phase(PG8_LAS unsigned char* lds, const Gemm g, const Sched& S, Epi E) {
    int tid_ = threadIdx.x; asm volatile("" : "+v"(tid_));
    const int tid = tid_, wid = __builtin_amdgcn_readfirstlane(tid >> 6), lane = tid & 63, wr = wid >> 2, wc = wid & 3, fr = lane & 15, fq = lane >> 4;
    const int K = g.K, nt = K / BK;
    unsigned voffA[2], voffB[2];
#pragma unroll
    for (int i = 0; i < 2; ++i) { int R, C; stage_rc(tid * 16 + i * 8192, R, C); const int Rb = Epi::PERM ? ((R & ~31) + perm32(R & 31)) : R;
        voffA[i] = (unsigned)(R * K + C) * 2u; voffB[i] = (unsigned)(Rb * K + C) * 2u; }
    const size_t kstep = (size_t)(BK * 2);
    const size_t hstep = (size_t)HALF * K * 2;
    const size_t tstep = 2 * hstep;
    const unsigned ldsw = (unsigned)wid * 1024u;
    const int aoff = lds_byte(wr * 64 + fr, fq * 8), boff = lds_byte(wc * 32 + fr, fq * 8);
#define PG8_SA(b, h) (((b) * 2 + (h)) * HTB)
#define PG8_SB(b, h) ((4 + (b) * 2 + (h)) * HTB)
#define PG8_STAGE(bufoff, gbase, voff) do { _Pragma("unroll") for (int _i = 0; _i < 2; ++_i) { unsigned vo_ = (voff)[_i]; if constexpr (F8 || PG8_SADDR_ALL) asm volatile("" : "+v"(vo_));     \
        __builtin_amdgcn_global_load_lds((const unsigned*)((const char*)(gbase) + vo_), (PG8_LAS unsigned*)(lds + (bufoff) + ldsw + _i * 8192), 16, 0, 0); } } while (0)
#define PG8_LD1(dst, base) do { if constexpr (F8) { const i32x4_ lo_ = *(const PG8_LAS i32x4_*)(base), hi_ = *(const PG8_LAS i32x4_*)((base) + 1024); dst = __builtin_shufflevector(lo_, hi_, 0, 1, 2, 3, 4, 5, 6, 7); } \
        else { dst[0] = *(const PG8_LAS bf16x8*)(base); dst[1] = *(const PG8_LAS bf16x8*)((base) + 1024); } } while (0)
#define PG8_LDA(dst, b, h) do { _Pragma("unroll") for (int m = 0; m < 4; ++m) PG8_LD1(dst[m], lds + PG8_SA(b, h) + aoff + m * 2048); } while (0)
#define PG8_LDB(dst, b, h) do { _Pragma("unroll") for (int n = 0; n < 2; ++n) PG8_LD1(dst[n], lds + PG8_SB(b, h) + boff + n * 2048); } while (0)
#define PG8_MMA(ai, bj, At, Bt) do { __builtin_amdgcn_s_setprio(1); if constexpr (F8) { _Pragma("unroll") for (int m = 0; m < 4; ++m) _Pragma("unroll") for (int n = 0; n < 2; ++n) \
        acc[ai][bj][m][n] = __builtin_amdgcn_mfma_scale_f32_16x16x128_f8f6f4(Bt[n], At[m], acc[ai][bj][m][n], 0, 0, 0, 0, 0, 0); } else { \
        _Pragma("unroll") for (int m = 0; m < 4; ++m) _Pragma("unroll") for (int n = 0; n < 2; ++n) _Pragma("unroll") for (int k = 0; k < 2; ++k) \
        acc[ai][bj][m][n] = __builtin_amdgcn_mfma_f32_16x16x32_bf16(Bt[n][k], At[m][k], acc[ai][bj][m][n], 0, 0, 0); } __builtin_amdgcn_s_setprio(0); } while (0)
#define PG8_WAIT_V(n) asm volatile("s_waitcnt vmcnt(" #n ")" ::: "memory")
#define PG8_WAIT_L(n) asm volatile("s_waitcnt lgkmcnt(" #n ")" ::: "memory")
#define PG8_BAR __builtin_amdgcn_s_barrier()
#define PG8_SCHED __builtin_amdgcn_sched_barrier(0)
    Unit cur, nxt; int ui = 0;
    if (!S.next(0, cur)) return;
    f32x4 acc[2][2][4][2];
#pragma unroll
    for (int a = 0; a < 2; ++a)
#pragma unroll
        for (int b = 0; b < 2; ++b)
#pragma unroll
            for (int m = 0; m < 4; ++m)
#pragma unroll
                for (int n = 0; n < 2; ++n) acc[a][b][m][n] = (f32x4){0.f, 0.f, 0.f, 0.f};
    typename sel_<F8, i32x8_, bf16x8[2]>::type At[4], B0[2], B1[2];
    const char* cA = (const char*)(F8 ? (cur.pm >= g.pm3 ? g.A3 : (cur.pm >= g.pm2 ? g.A2 : g.A)) : g.A) + (size_t)cur.pm * tstep; const char* cB = (const char*)g.Bt + (size_t)cur.pn * tstep;
    S.a_ready(cur);
    if constexpr (Epi::HOOK) { u32x4 hq_[2]; E.hook_prefetch(cur, tid, hq_); E.hook_table(lds, 0, tid, hq_); }
    if constexpr (SP2) {
        PG8_STAGE(PG8_SB(0, 0), cB, voffB); PG8_STAGE(PG8_SB(0, 1), cB + hstep, voffB); PG8_STAGE(PG8_SA(0, 0), cA, voffA); PG8_STAGE(PG8_SA(0, 1), cA + hstep, voffA);
        if (wr == 1) PG8_BAR;
        PG8_WAIT_V(2); PG8_BAR;
        PG8_STAGE(PG8_SB(1, 0), cB + kstep, voffB); PG8_STAGE(PG8_SA(1, 0), cA + kstep, voffA); PG8_STAGE(PG8_SB(1, 1), cB + hstep + kstep, voffB);
        PG8_WAIT_V(6); PG8_BAR;
    } else {
        PG8_STAGE(PG8_SB(0, 0), cB, voffB); PG8_STAGE(PG8_SA(0, 0), cA, voffA); PG8_STAGE(PG8_SB(0, 1), cB + hstep, voffB); PG8_STAGE(PG8_SA(0, 1), cA + hstep, voffA);
        if (wr == 1) PG8_BAR;
        PG8_WAIT_V(4); PG8_BAR;
        PG8_STAGE(PG8_SB(1, 0), cB + kstep, voffB); PG8_STAGE(PG8_SA(1, 0), cA + kstep, voffA); PG8_STAGE(PG8_SB(1, 1), cB + hstep + kstep, voffB);
        PG8_WAIT_V(6); PG8_BAR;
    }
    for (;;) {
        const bool has_next = S.next(ui + 1, nxt);
        const char* nA = has_next ? (const char*)(F8 ? (nxt.pm >= g.pm3 ? g.A3 : (nxt.pm >= g.pm2 ? g.A2 : g.A)) : g.A) + (size_t)nxt.pm * tstep : cA; const char* nB = has_next ? (const char*)g.Bt + (size_t)nxt.pn * tstep : cB;
#pragma nounroll
        for (int t = 0; t < nt; t += 2) {
            if constexpr (Epi::HOOK) { if (t > 0) E.hook_scale(acc, lds, ui & 1, (t >> 1) - 1, wr, fr); }
            const bool last = (t == nt - 2);
            const char* a1 = cA + (size_t)(t + 1) * kstep;
            const char* a2 = last ? nA : cA + (size_t)(t + 2) * kstep; const char* b2 = last ? nB : cB + (size_t)(t + 2) * kstep;
            const char* a3 = a2 + kstep; const char* b3 = b2 + kstep;
            if (last && has_next) S.a_ready(nxt);
            if constexpr (SP2) {
            PG8_LDB(B0, 0, 0); PG8_LDB(B1, 0, 1); PG8_SCHED; PG8_LDA(At, 0, 0); PG8_STAGE(PG8_SA(1, 1), a1 + hstep, voffA);
            PG8_WAIT_V(8); PG8_WAIT_L(0); PG8_BAR; PG8_MMA(0, 0, At, B0); PG8_MMA(0, 1, At, B1); PG8_BAR; PG8_SCHED;
            PG8_LDA(At, 0, 1); PG8_STAGE(PG8_SB(0, 0), b2, voffB); PG8_STAGE(PG8_SB(0, 1), b2 + hstep, voffB); PG8_STAGE(PG8_SA(0, 0), a2, voffA);
            PG8_WAIT_V(8); PG8_WAIT_L(0); PG8_BAR; PG8_MMA(1, 0, At, B0); PG8_MMA(1, 1, At, B1); PG8_BAR; PG8_SCHED;
            PG8_LDB(B0, 1, 0); PG8_LDB(B1, 1, 1); PG8_SCHED; PG8_LDA(At, 1, 0); PG8_STAGE(PG8_SA(0, 1), a2 + hstep, voffA);
            PG8_WAIT_V(8); PG8_WAIT_L(0); PG8_BAR; PG8_MMA(0, 0, At, B0); PG8_MMA(0, 1, At, B1); PG8_BAR; PG8_SCHED;
            PG8_LDA(At, 1, 1); PG8_STAGE(PG8_SB(1, 0), b3, voffB); PG8_STAGE(PG8_SB(1, 1), b3 + hstep, voffB); PG8_STAGE(PG8_SA(1, 0), a3, voffA);
            PG8_WAIT_V(8); PG8_WAIT_L(0); PG8_BAR; PG8_MMA(1, 0, At, B0); PG8_MMA(1, 1, At, B1); PG8_BAR; PG8_SCHED;
            } else {
            PG8_LDB(B0, 0, 0); PG8_SCHED; PG8_LDA(At, 0, 0); PG8_STAGE(PG8_SA(1, 1), a1 + hstep, voffA);
            PG8_WAIT_L(8); PG8_BAR; PG8_WAIT_L(0); PG8_MMA(0, 0, At, B0); PG8_BAR; PG8_SCHED;
            PG8_LDB(B1, 0, 1); PG8_STAGE(PG8_SB(0, 0), b2, voffB);
            PG8_BAR; PG8_WAIT_L(0); PG8_MMA(0, 1, At, B1); PG8_BAR;
            PG8_LDA(At, 0, 1); PG8_STAGE(PG8_SA(0, 0), a2, voffA);
            PG8_BAR; PG8_WAIT_L(0); PG8_MMA(1, 0, At, B0); PG8_BAR; PG8_SCHED;
            PG8_STAGE(PG8_SB(0, 1), b2 + hstep, voffB);
            PG8_WAIT_V(6); PG8_BAR; PG8_MMA(1, 1, At, B1); PG8_BAR;
            PG8_LDB(B0, 1, 0); PG8_SCHED; PG8_LDA(At, 1, 0); PG8_STAGE(PG8_SA(0, 1), a2 + hstep, voffA);
            PG8_WAIT_L(8); PG8_BAR; PG8_WAIT_L(0); PG8_MMA(0, 0, At, B0); PG8_BAR; PG8_SCHED;
            PG8_LDB(B1, 1, 1); PG8_STAGE(PG8_SB(1, 0), b3, voffB);
            PG8_BAR; PG8_WAIT_L(0); PG8_MMA(0, 1, At, B1); PG8_BAR;
            PG8_LDA(At, 1, 1); PG8_STAGE(PG8_SA(1, 0), a3, voffA);
            PG8_BAR; PG8_WAIT_L(0); PG8_MMA(1, 0, At, B0); PG8_BAR; PG8_SCHED;
            PG8_STAGE(PG8_SB(1, 1), b3 + hstep, voffB);
            PG8_WAIT_V(6); PG8_BAR; PG8_MMA(1, 1, At, B1); PG8_BAR;
            }
        }
        if constexpr (ALIGN_EPI) { if (wr == 0) PG8_BAR; }
        u32x4 hq_[2]; bool sw_ = false;
        if constexpr (Epi::HOOK) { sw_ = has_next && E.is_switch(cur); if (has_next) E.hook_prefetch(nxt, tid, hq_); }
        if constexpr (Epi::HOOK) { if (sw_) {
                E.hook_table(lds, (ui + 1) & 1, tid, hq_); PG8_WAIT_L(0); PG8_BAR;
                E.switch_branch(acc, cur, lds, ui & 1, (ui + 1) & 1, wr, wc, fr, fq); S.done(cur); } }
        if (!sw_) { if constexpr (!Epi::AFTER_DRAIN) { if constexpr (Epi::HOOK) E.lds_tab = lds, E.par = ui & 1;
            E(acc, cur, wr, wc, fr, fq); S.done(cur); }
            if constexpr (Epi::HOOK) { if (has_next) E.hook_table(lds, (ui + 1) & 1, tid, hq_); } }
        if (!has_next) break;
        if (!sw_) {
#pragma unroll
        for (int a = 0; a < 2; ++a)
#pragma unroll
            for (int b = 0; b < 2; ++b)
#pragma unroll
                for (int m = 0; m < 4; ++m)
#pragma unroll
                    for (int n = 0; n < 2; ++n) acc[a][b][m][n] = (f32x4){0.f, 0.f, 0.f, 0.f};
        }
        cur = nxt; cA = nA; cB = nB; ++ui;
        if constexpr (ALIGN_EPI) { if (wr == 1) PG8_BAR; }
    }
    PG8_WAIT_V(0);
    if constexpr (!ALIGN_EPI) { if (wr == 0) PG8_BAR; }
    PG8_BAR;
    if constexpr (Epi::AFTER_DRAIN) { E.fused(acc, cur, wr, wc, fr, fq, lds, wid, lane); S.done(cur); }
#undef PG8_SA
#undef PG8_SB
#undef PG8_STAGE
#undef PG8_LDA
#undef PG8_LDB
#undef PG8_MMA
#undef PG8_LD1
#undef PG8_WAIT_V
#undef PG8_WAIT_L
#undef PG8_BAR
#undef PG8_SCHED
}
}

#ifndef PG8_SP2
#define PG8_SP2 true
#endif
#ifndef PG8_ALIGN
#define PG8_ALIGN true
#endif
constexpr int NWAVES = 8;
#ifndef MK_ONE_LAUNCH
#define MK_ONE_LAUNCH 0
#endif
constexpr int N_PHASES = 1 + 11 * DEPTH;

constexpr size_t MiB = 1u << 20;
constexpr size_t WS_CTL = 0, CTL_ZERO_BYTES = 1 * MiB;
constexpr size_t WS_W = 1 * MiB;
constexpr size_t W_INA = 0, W_INB = W_INA + (size_t)N_INA * DM, W_O2 = W_INB + (size_t)N_INB * DM, W_OUT = W_O2 + (size_t)2048 * 512,
                 W_GU = W_OUT + (size_t)DM * DM, W_DN = W_GU + (size_t)2 * DFF * DM, W_LAYER = W_DN + (size_t)DM * DFF;
static_assert(W_LAYER * 2 <= 33 * MiB, "weights per layer");
constexpr size_t WS_RSTD = 67 * MiB;
constexpr size_t WS_AB = 68 * MiB;
constexpr size_t WS_SUMS = 68 * MiB;
constexpr size_t WS_R = 72 * MiB;
constexpr size_t WS_P = 200 * MiB;
constexpr size_t PLANE = (size_t)MTOK * 512;
constexpr size_t WS_X = 712 * MiB;
constexpr size_t WS_GATES = 200 * MiB;
constexpr size_t WS_MERGED = 456 * MiB;
#ifndef WS_SKEW_BYTES
#define WS_SKEW_BYTES 0
#endif
constexpr size_t WS_SKEW = WS_SKEW_BYTES;
constexpr size_t WS_MIX = 584 * MiB + WS_SKEW;
constexpr size_t WS_ACT = 200 * MiB;
constexpr size_t WS_F = 584 * MiB + WS_SKEW;
constexpr size_t WS_W8 = 1004 * MiB, W8_LAYER = (size_t)N_INB * DM;
constexpr float W8_SCALE = 64.f;
constexpr int R8A_TILES = 112, R8A_ROWS = R8A_TILES * 256, R8_TILES = 176, R8_ROWS = R8_TILES * 256;
constexpr size_t R8_OUT_OFF = 100 * MiB, WS_R8B = 1008 * MiB;
constexpr size_t WS_R8C = 328 * MiB;
constexpr size_t WS_END = 1024 * MiB;
constexpr int CW_PANEL = 16384;
constexpr int CW_BAR = 4096;

constexpr int LDS_BYTES = 163840;
constexpr int MISC_OFF = LDS_BYTES - 512;

#define GAS __attribute__((address_space(1)))
#define LAS __attribute__((address_space(3)))
typedef unsigned short bf16;
typedef unsigned v4u __attribute__((ext_vector_type(4)));
typedef unsigned v2u __attribute__((ext_vector_type(2)));
typedef float f32x4 __attribute__((ext_vector_type(4)));
typedef GAS unsigned gu32;
#define RLX_AGENT __ATOMIC_RELAXED, __HIP_MEMORY_SCOPE_AGENT
#define LDS_WAIT() asm volatile("s_waitcnt lgkmcnt(0)" ::: "memory")
#define VM_WAIT() asm volatile("s_waitcnt vmcnt(0)" ::: "memory")
typedef __bf16 bfv2_ __attribute__((ext_vector_type(2)));
typedef float fv2_ __attribute__((ext_vector_type(2)));
__device__ __forceinline__ unsigned pk2(float lo, float hi) { fv2_ v = {lo, hi}; bfv2_ r = __builtin_convertvector(v, bfv2_); return __builtin_bit_cast(unsigned, r); }
__device__ __forceinline__ unsigned pk8(float a, float b, float c, float d) { int w = __builtin_amdgcn_cvt_pk_fp8_f32(a, b, 0, false); w = __builtin_amdgcn_cvt_pk_fp8_f32(c, d, w, true); return (unsigned)w; }
__device__ __forceinline__ unsigned f2bf(float f) { return pk2(f, 0.f) & 0xffffu; }
__device__ __forceinline__ float bflo(unsigned w) { return __builtin_bit_cast(float, w << 16); }
__device__ __forceinline__ float bfhi(unsigned w) { return __builtin_bit_cast(float, w & 0xffff0000u); }
__device__ __forceinline__ float bf1(bf16 b) { return __builtin_bit_cast(float, (unsigned)b << 16); }
__device__ __forceinline__ float sigmf(float x) { return __builtin_amdgcn_rcpf(1.f + __expf(-x)); }
__device__ __forceinline__ float wave_sum(float v) {
    v += __builtin_bit_cast(float, __builtin_amdgcn_update_dpp(0, __builtin_bit_cast(int, v), 0xB1, 0xF, 0xF, true));
    v += __builtin_bit_cast(float, __builtin_amdgcn_update_dpp(0, __builtin_bit_cast(int, v), 0x4E, 0xF, 0xF, true));
    v += __builtin_bit_cast(float, __builtin_amdgcn_update_dpp(0, __builtin_bit_cast(int, v), 0x141, 0xF, 0xF, true));
    v += __builtin_bit_cast(float, __builtin_amdgcn_update_dpp(0, __builtin_bit_cast(int, v), 0x140, 0xF, 0xF, true));
    const int vi = __builtin_bit_cast(int, v);
    return (__builtin_bit_cast(float, __builtin_amdgcn_readlane(vi, 0)) + __builtin_bit_cast(float, __builtin_amdgcn_readlane(vi, 16))) +
           (__builtin_bit_cast(float, __builtin_amdgcn_readlane(vi, 32)) + __builtin_bit_cast(float, __builtin_amdgcn_readlane(vi, 48)));
}
#define XB_TMO      128
#define XB_XCNT(j)  (256  + 64 * (j))
#define XB_XSUB(j)  (1280 + 64 * (j))
#define XB_XGEN(j)  (2304 + 64 * (j))
#define XB_TOP      3328
#define XB_TOPGEN   3392
#define XCD_BAR_WORDS 3456
#define XB_SPIN_CAP (1u << 18)

__device__ __forceinline__ unsigned xb_ld(unsigned* p)              { return __hip_atomic_load(p, __ATOMIC_RELAXED, __HIP_MEMORY_SCOPE_AGENT); }
__device__ __forceinline__ unsigned xb_add(unsigned* p, unsigned v) { return __hip_atomic_fetch_add(p, v, __ATOMIC_RELAXED, __HIP_MEMORY_SCOPE_AGENT); }
__device__ __forceinline__ unsigned xb_xcc_id() { return (unsigned)__builtin_amdgcn_s_getreg((3 << 11) | 20) & 0xFu; }
#define XB_SPIN(cond, bar) do { unsigned _sp = 0; while (cond) { __builtin_amdgcn_s_sleep(1); \
    if ((++_sp & 255u) == 0u) { if (xb_ld(&(bar)[XB_TMO])) break; if (_sp > XB_SPIN_CAP) { atomicAdd(&(bar)[XB_TMO], 1u); break; } } } } while (0)

struct XcdBarrier {
    unsigned* bar; unsigned x;
    volatile LAS unsigned* st;
};

__device__ __forceinline__ XcdBarrier xcd_barrier_post(unsigned* bar, volatile LAS unsigned* st) {
    XcdBarrier b; b.bar = bar; b.x = xb_xcc_id(); b.st = st;
    if (threadIdx.x == 0) (void)xb_add(&bar[XB_XCNT(b.x)], 1u);
    return b;
}
__device__ __forceinline__ void xcd_barrier_complete(unsigned* bar, unsigned x, unsigned& nloc, unsigned& nx) {
    const unsigned G = gridDim.x * gridDim.y * gridDim.z;
    unsigned sum, cnt, mine, sp = 0u;
    for (;;) {
        sum = 0u; cnt = 0u; mine = 0u;
#pragma unroll
        for (unsigned j = 0; j < 16; ++j) { const unsigned c = xb_ld(&bar[XB_XCNT(j)]); sum += c; cnt += (c > 0u) ? 1u : 0u; mine = (j == x) ? c : mine; }
        if (sum == G) break;
        __builtin_amdgcn_s_sleep(1);
        if ((++sp & 255u) == 0u) { if (xb_ld(&bar[XB_TMO])) break; if (sp > XB_SPIN_CAP) { atomicAdd(&bar[XB_TMO], 1u); break; } }
    }
    nloc = mine > 0u ? mine : 1u; nx = cnt > 0u ? cnt : 1u;
}

__device__ __forceinline__ void xcd_barrier(const XcdBarrier& b) {
    asm volatile("s_waitcnt vmcnt(0)" ::: "memory");
    __syncthreads();
    if (threadIdx.x == 0) {
        unsigned* bar = b.bar;
        __builtin_amdgcn_s_waitcnt(0);
        unsigned nloc = b.st[0], nx = b.st[1];
        if (nloc == 0u) { xcd_barrier_complete(bar, b.x, nloc, nx); b.st[0] = nloc; b.st[1] = nx; }
        const unsigned old = xb_add(&bar[XB_XSUB(b.x)], 1u);
        const unsigned gen = old / nloc;
        if (old + 1u == (gen + 1u) * nloc) {
            __builtin_amdgcn_fence(__ATOMIC_RELEASE, "agent");
            asm volatile("s_waitcnt vmcnt(0)" ::: "memory");
            const unsigned og = xb_add(&bar[XB_TOP], 1u);
            const unsigned tg = og / nx;
            if (og + 1u == (tg + 1u) * nx) xb_add(&bar[XB_TOPGEN], 1u);
            else XB_SPIN(xb_ld(&bar[XB_TOPGEN]) == tg, bar);
            __builtin_amdgcn_fence(__ATOMIC_ACQUIRE, "agent");
            xb_add(&bar[XB_XGEN(b.x)], 1u);
            asm volatile("s_waitcnt vmcnt(0)" ::: "memory");
        } else {
            XB_SPIN(xb_ld(&bar[XB_XGEN(b.x)]) == gen, bar);
            __builtin_amdgcn_fence(__ATOMIC_ACQUIRE, "agent");
            asm volatile("s_waitcnt vmcnt(0)" ::: "memory");
        }
    }
    __syncthreads();
}

struct Frame {
    LAS unsigned char* lds;
    volatile LAS unsigned* MISC;
    gu32* ctl;
    int tid, lane, wave, G;
    const float* in[17];
    float* out; unsigned char* ws;
};


typedef short bf16x8 __attribute__((ext_vector_type(8)));
typedef float f32x16 __attribute__((ext_vector_type(16)));
typedef __bf16 bfv2 __attribute__((ext_vector_type(2)));
typedef float fv2 __attribute__((ext_vector_type(2)));
#define MFMA32(a, b, c) __builtin_amdgcn_mfma_f32_32x32x16_bf16((a), (b), (c), 0, 0, 0)
__device__ __forceinline__ unsigned pkc(float a, float b) { fv2 v = {a, b}; bfv2 r = __builtin_convertvector(v, bfv2); return __builtin_bit_cast(unsigned, r); }
__device__ __forceinline__ bf16x8 pack_half(const f32x16& x, int s) {
    v4u p; p.x = pkc(x[8 * s + 0], x[8 * s + 1]); p.y = pkc(x[8 * s + 2], x[8 * s + 3]); p.z = pkc(x[8 * s + 4], x[8 * s + 5]); p.w = pkc(x[8 * s + 6], x[8 * s + 7]);
    return __builtin_bit_cast(bf16x8, p);
}
__device__ __forceinline__ f32x16 zero16() { f32x16 z;
#pragma unroll
    for (int i = 0; i < 16; ++i) z[i] = 0.f; return z; }
__device__ __forceinline__ bf16x8 lds_frag(const LAS unsigned char* p) { return __builtin_bit_cast(bf16x8, *(const LAS v4u*)p); }

constexpr int NUNIT = BATCH * (SEQ / 64) * NHEAD;
constexpr size_t HG1_UNIT = 32768, HG2_UNIT = 25600;
constexpr size_t DN_UNIT = 74752;
constexpr size_t WS_DNB = 712 * MiB;
#ifdef DN_REF
constexpr size_t WS_ORAW = 712 * MiB;
#else
constexpr size_t WS_ORAW = 456 * MiB;
#endif
#ifndef SCAN_DUMMY
#define SCAN_DUMMY 0
#endif
#ifndef SCAN_AUX
#define SCAN_AUX 0
#endif
constexpr int PQ = 272, PT = 144;

struct HgRaw { unsigned q[8], f[8], i[8]; };
__device__ __forceinline__ void hg_raw_load(HgRaw& a, Frame& F, int unit, int lane) {
    const int h = unit & 3, n = (unit >> 2) & 127, b = unit >> 9; const size_t row0 = (size_t)b * SEQ + 64 * n;
    const bf16* P0 = (const bf16*)(F.ws + WS_P); const bf16* P1 = P0 + PLANE; const bf16* P2 = P1 + PLANE;
#pragma unroll
    for (int i = 0; i < 8; ++i) { const size_t off = (row0 + 8 * F.wave + i) * 512 + 128 * h + 2 * lane;
        a.q[i] = *(const GAS unsigned*)(P0 + off); a.f[i] = *(const GAS unsigned*)(P1 + off); a.i[i] = *(const GAS unsigned*)(P2 + off); }
}
constexpr int HGRAW_OFF = 101376;
__device__ __forceinline__ void hg_dma_issue(Frame& F, int unit, int lane) {
    const int h = unit & 3, n = (unit >> 2) & 127, b = unit >> 9; const size_t row0 = (size_t)b * SEQ + 64 * n;
    const bf16* P0 = (const bf16*)(F.ws + WS_P);
#pragma unroll
    for (int i = 0; i < 6; ++i) { const int p = F.wave * 6 + i, pl = p >> 4, r4 = (p & 15) * 4;
        const bf16* src = P0 + (size_t)pl * PLANE + (row0 + r4 + (lane >> 4)) * 512 + 128 * h + 8 * (lane & 15);
        __builtin_amdgcn_global_load_lds((const unsigned*)src, (LAS unsigned*)(F.lds + HGRAW_OFF + p * 1024), 16, 0, 0); }
}
struct HgConst { float lb[2]; };
__device__ __forceinline__ void prep_hg_unit(Frame& F, int l, int unit, int next_unit, const HgConst& hc) {
    const int h = unit & 3, n = (unit >> 2) & 127, b = unit >> 9;
    const size_t row0 = (size_t)b * SEQ + 64 * n;
    LAS unsigned char* L = F.lds;
    LAS float* TOT = (LAS float*)L;
    LAS unsigned char* QT = L + 4096; LAS unsigned char* KT = QT + 64 * PQ; LAS unsigned char* QSR = KT + 64 * PQ;
    LAS unsigned char* KHT = QSR + 64 * PQ; LAS unsigned char* VI = KHT + 128 * PT; LAS unsigned char* ATT = VI + 64 * PQ;
    const bf16* P0 = (const bf16*)(F.ws + WS_P); const bf16* P1 = P0 + PLANE; const bf16* P2 = P1 + PLANE;
    const int blk = (b * 4 + h) * 128 + n;
    unsigned char* part1 = (unsigned char*)F.out + 128 * MiB + (size_t)blk * HG1_UNIT;
    unsigned char* part2 = (unsigned char*)F.out + (size_t)blk * HG2_UNIT;
    const int w = F.wave; int lane = F.lane; asm volatile("" : "+v"(lane));
    const int d0 = 2 * lane;
    const float lb[2] = {hc.lb[0], hc.lb[1]};
    float q[8][2], kk[8][2], cs[8][2];
    {
        float run[2] = {0.f, 0.f};
#pragma unroll
        for (int i = 0; i < 8; ++i) {
            const LAS unsigned char* rp = F.lds + HGRAW_OFF + (8 * w + i) * 256 + 4 * lane;
            const unsigned qv = *(const LAS unsigned*)rp, fv = *(const LAS unsigned*)(rp + 16384), iv = *(const LAS unsigned*)(rp + 32768);
            *(LAS unsigned*)(VI + (8 * w + i) * PQ + 2 * d0) = iv;
            q[i][0] = bflo(qv); q[i][1] = bfhi(qv);
            const float fl[2] = {bflo(fv), bfhi(fv)};
#pragma unroll
            for (int e = 0; e < 2; ++e) { const float sg = sigmf(fl[e]); const float f = lb[e] + (1.f - lb[e]) * sg; kk[i][e] = (1.f - lb[e]) * (1.f - sg);
                run[e] += __logf(fmaxf(f, 1e-30f))  ; cs[i][e] = run[e]; } }
        TOT[w * 128 + d0] = run[0]; TOT[w * 128 + d0 + 1] = run[1];
    }
    __syncthreads();
    if (next_unit >= 0) hg_dma_issue(F, next_unit, lane);
    {
        float off[2] = {0.f, 0.f}, bref[2] = {0.f, 0.f}, blast[2] = {0.f, 0.f};
#pragma unroll
        for (int ww = 0; ww < 8; ++ww) { const float t0 = TOT[ww * 128 + d0], t1 = TOT[ww * 128 + d0 + 1];
            if (ww < w) { off[0] += t0; off[1] += t1; } if (ww < 4) { bref[0] += t0; bref[1] += t1; } blast[0] += t0; blast[1] += t1; }
        unsigned kh[2][4];
#pragma unroll
        for (int i = 0; i < 8; ++i) { float qt[2], kt[2], qs[2], kh_[2];
#pragma unroll
            for (int e = 0; e < 2; ++e) { const float bb = off[e] + cs[i][e];
                qt[e] = q[i][e] * __expf(fminf(bb - bref[e], 80.f)); kt[e] = kk[i][e] * __expf(fminf(bref[e] - bb, 80.f));
                qs[e] = q[i][e] * __expf(bb); kh_[e] = kk[i][e] * __expf(blast[e] - bb); }
            const int t = 8 * w + i;
            *(LAS unsigned*)(QT + t * PQ + 2 * d0) = pk2(qt[0], qt[1]); *(LAS unsigned*)(KT + t * PQ + 2 * d0) = pk2(kt[0], kt[1]); *(LAS unsigned*)(QSR + t * PQ + 2 * d0) = pk2(qs[0], qs[1]);
            if (i & 1) { kh[0][i >> 1] |= f2bf(kh_[0]) << 16; kh[1][i >> 1] |= f2bf(kh_[1]) << 16; } else { kh[0][i >> 1] = f2bf(kh_[0]); kh[1][i >> 1] = f2bf(kh_[1]); } }
        *(LAS v4u*)(KHT + d0 * PT + 16 * w) = (v4u){kh[0][0], kh[0][1], kh[0][2], kh[0][3]};
        *(LAS v4u*)(KHT + (d0 + 1) * PT + 16 * w) = (v4u){kh[1][0], kh[1][1], kh[1][2], kh[1][3]};
        if (w == 0) { *(GAS fv2*)(part2 + 8192 + 4 * d0) = (fv2){__expf(blast[0]), __expf(blast[1])}; }
    }
    __syncthreads();
    const int r = lane & 31, hg = lane >> 5;
    if (w < 3) {
        const int m = w >= 1 ? 1 : 0, mp = w == 2 ? 1 : 0;
        f32x16 acc = zero16();
#pragma unroll
        for (int ks = 0; ks < 8; ++ks) acc = MFMA32(lds_frag(QT + (32 * m + r) * PQ + 32 * ks + 16 * hg), lds_frag(KT + (32 * mp + r) * PQ + 32 * ks + 16 * hg), acc);
#pragma unroll
        for (int i = 0; i < 16; ++i) { const int ii = 32 * m + (i & 3) + 8 * (i >> 2) + 4 * hg, jj = 32 * mp + r;
            *(LAS bf16*)(ATT + ii * PT + 2 * jj) = (bf16)f2bf((jj <= ii ? 1.f : 0.f) * acc[i]); }
    } else if (w == 3) {
#pragma unroll
        for (int i = 0; i < 16; ++i) *(LAS bf16*)(ATT + (2 * i + hg) * PT + 2 * (32 + r)) = 0;
    }
    __syncthreads();
#pragma unroll
    for (int i = 0; i < 2; ++i) { const int f = w + 8 * i, m = f >> 3, kt = f & 7;
        const LAS unsigned char* src = QSR + (32 * m + r) * PQ + 2 * (16 * kt + 4 * hg);
        const v2u a = *(const LAS v2u*)src, c = *(const LAS v2u*)(src + 16);
        *(GAS v4u*)(part1 + f * 1024 + lane * 16) = (v4u){a.x, a.y, c.x, c.y}; }
#pragma unroll
    for (int i = 0; i < 2; ++i) { const int f = w + 8 * i, t4 = f >> 2, ktp = f & 3;
        *(GAS v4u*)(part1 + 16384 + f * 1024 + lane * 16) = *(const LAS v4u*)(KHT + (32 * t4 + r) * PT + 2 * (16 * ktp + 8 * hg)); }
    { const int f = w, m = f >> 2, ktp = f & 3;
        *(GAS v4u*)(part2 + f * 1024 + lane * 16) = *(const LAS v4u*)(ATT + (32 * m + r) * PT + 2 * (16 * ktp + 8 * hg)); }
#pragma unroll
    for (int i = 0; i < 2; ++i) { const int f = w + 8 * i, sl = f >> 2, ktp = f & 3;
        unsigned short e[8];
#pragma unroll
        for (int j = 0; j < 8; ++j) e[j] = *(const LAS bf16*)(VI + (16 * ktp + 8 * hg + j) * PQ + 2 * (32 * sl + r));
        *(GAS v4u*)(part2 + 9216 + f * 1024 + lane * 16) = (v4u){(unsigned)e[0] | ((unsigned)e[1] << 16), (unsigned)e[2] | ((unsigned)e[3] << 16), (unsigned)e[4] | ((unsigned)e[5] << 16), (unsigned)e[6] | ((unsigned)e[7] << 16)}; }
    asm volatile("s_waitcnt vmcnt(7)" ::: "memory");
    __syncthreads();
}


constexpr int OST_OFF = 133120, OST_SLICE = 32 * 136, OST_BUF = 2 * OST_SLICE;
__device__ __forceinline__ void chain_stage_o(LAS unsigned char* st, const f32x16 (&o)[2], int r, int hg) {
#pragma unroll
    for (int m = 0; m < 2; ++m)
#pragma unroll
        for (int q = 0; q < 4; ++q)
            *(LAS v2u*)(st + r * 136 + 2 * (32 * m + 8 * q + 4 * hg)) = (v2u){pk2(o[m][4 * q], o[m][4 * q + 1]), pk2(o[m][4 * q + 2], o[m][4 * q + 3])};
}
#ifndef HELPER_SIMD23
#define HELPER_SIMD23 1
#endif
#if HELPER_SIMD23
#define HELPER_WAVE(w) (((w) & 2) != 0)
#define HELPER_IDX(w) (((w) & 1) | (((w) >> 2) << 1))
#else
#define HELPER_WAVE(w) ((w) >= 4)
#define HELPER_IDX(w) ((w) - 4)
#endif
#ifndef HELPERS_LOAD
#define HELPERS_LOAD 0
#endif
#if HELPERS_LOAD
#define LOADER_WAVE(w) ((w) >= 2)
#define LOADER_F0(w) ((w) - 2)
#define LOADER_STRIDE 6
#else
#define LOADER_WAVE(w) ((w) >= 2 && !HELPER_WAVE(w))
#define LOADER_F0(w) ((w) & 1)
#define LOADER_STRIDE 2
#endif
constexpr int GST_OFF = OST_OFF + 2 * OST_BUF;
__device__ __forceinline__ void chain_g_issue(Frame& F, int br, int b, int h, int sl0, int n, int hx, int lane) {
    const bf16* gp = (const bf16*)(F.ws + WS_P) + (size_t)(br ? 7 : 6) * PLANE + ((size_t)b * SEQ + 64 * n + 16 * hx + 2 * (lane >> 3)) * 512 + 128 * h + 32 * sl0 + 8 * (lane & 7);
    LAS unsigned char* gb = F.lds + GST_OFF + hx * 2048;
    __builtin_amdgcn_global_load_lds((const unsigned*)gp, (LAS unsigned*)gb, 16, 0, 0);
    __builtin_amdgcn_global_load_lds((const unsigned*)(gp + 512), (LAS unsigned*)(gb + 1024), 16, 0, 0);
}
__device__ __forceinline__ void chain_finish_rows(Frame& F, int br, int b, int h, int sl0, int n, const LAS unsigned char* stb  , int hx, int lane, const v4u (&gq)[2]) {
    const int p = lane & 7, c0 = 8 * (p & 3), rowp = 16 * hx + 2 * (lane >> 3);
    const LAS unsigned char* st = stb + (p >> 2) * OST_SLICE + c0 * 136 + 2 * rowp;
    unsigned ow[8];
#pragma unroll
    for (int c = 0; c < 8; ++c) ow[c] = *(const LAS unsigned*)(st + c * 136);
#pragma unroll
    for (int j = 0; j < 2; ++j) {
        const size_t m = (size_t)b * SEQ + 64 * n + rowp + j;
        const unsigned gw[4] = {gq[j].x, gq[j].y, gq[j].z, gq[j].w};
        unsigned w[4]; float ssq = 0.f;
#pragma unroll
        for (int c = 0; c < 4; ++c) { const float o0 = j ? bfhi(ow[2 * c]) : bflo(ow[2 * c]), o1 = j ? bfhi(ow[2 * c + 1]) : bflo(ow[2 * c + 1]);
            const float g0 = bflo(gw[c]), g1 = bfhi(gw[c]);
            ssq += o0 * o0 + o1 * o1;
            w[c] = pk2(o0 * g0, o1 * g1); }
        *(GAS v4u*)((bf16*)(F.ws + WS_ORAW) + (size_t)br * PLANE + m * 512 + 128 * h + 32 * sl0 + 8 * p) = (v4u){w[0], w[1], w[2], w[3]};
        ssq += __builtin_bit_cast(float, __builtin_amdgcn_update_dpp(0, __builtin_bit_cast(int, ssq), 0xB1, 0xF, 0xF, true));
        ssq += __builtin_bit_cast(float, __builtin_amdgcn_update_dpp(0, __builtin_bit_cast(int, ssq), 0x4E, 0xF, 0xF, true));
        if ((lane & 3) == 0) ((GAS bf16*)(F.ws + WS_SUMS))[(m * 8 + br * 4 + h) * 4 + sl0 + (p >> 2)] = (bf16)f2bf(ssq);
    }
}
__device__ __forceinline__ void chain_helper_step(Frame& F, int br, int b, int h, int sl0, int n, int hx, int lane) {
    const LAS unsigned char* gb = F.lds + GST_OFF + hx * 2048 + lane * 16;
    v4u gq[2] = {(v4u){0u, 0u, 0u, 0u}, (v4u){0u, 0u, 0u, 0u}};
    if (n > 0) { gq[0] = *(const LAS v4u*)gb; gq[1] = *(const LAS v4u*)(gb + 1024); LDS_WAIT(); }
    if (n < SEQ / 64) chain_g_issue(F, br, b, h, sl0, n, hx, lane);
    if (n > 0) chain_finish_rows(F, br, b, h, sl0, n - 1, F.lds + OST_OFF + ((n - 1) & 1) * OST_BUF, hx, lane, gq);
}
__device__ __forceinline__ void scan_hg_chain(Frame& F, int bh, int sl0) {
    const int sl = sl0 + (F.wave & 1);
    const int b = bh >> 2, h = bh & 3;
    bf16* oraw = (bf16*)(F.ws + WS_ORAW);
    f32x16 S[4];
#pragma unroll
    for (int t = 0; t < 4; ++t) S[t] = zero16();
#define HG_ISSUE(nn, bufo) do { const int unit_ = (b * 4 + h) * 128 + (nn); \
        const unsigned char* p1_ = (const unsigned char*)F.out + 128 * MiB + (size_t)unit_ * HG1_UNIT; const unsigned char* p2_ = (const unsigned char*)F.out + (size_t)unit_ * HG2_UNIT; \
        for (int f = LOADER_F0(F.wave); f < 49; f += LOADER_STRIDE) { const unsigned char* src = f < 32 ? p1_ + f * 1024 : (f < 41 ? p2_ + (f - 32) * 1024 : p2_ + 9216 + (sl0 + ((f - 41) >> 2)) * 4096 + ((f - 41) & 3) * 1024); \
            __builtin_amdgcn_global_load_lds((const unsigned*)(src + lane * 16), (LAS unsigned*)(F.lds + (bufo) + f * 1024), 16, 0, SCAN_AUX); } } while (0)
#ifdef HG_TRIPLE
    { const int lane = F.lane; if (F.wave >= 2) { HG_ISSUE(0, 0); HG_ISSUE(1, 50176); } }
    int bcur = 0;
    for (int n = 0; n < SEQ / 64; ++n) {
        int lane = F.lane; asm volatile("" : "+v"(lane));
        const int r = lane & 31, hg = lane >> 5;
        LAS unsigned char* L = F.lds + bcur * 50176;
        const int bnx2 = bcur == 0 ? 2 : bcur - 1;
        if (F.wave >= 2) { if (n + 1 >= SEQ / 64) asm volatile("s_waitcnt vmcnt(0)" ::: "memory"); else if (F.wave == 2) asm volatile("s_waitcnt vmcnt(9)" ::: "memory"); else asm volatile("s_waitcnt vmcnt(8)" ::: "memory"); }
        __syncthreads();
        if (F.wave >= 2 && n + 2 < SEQ / 64) HG_ISSUE(n + 2, bnx2 * 50176);
        bcur = bcur == 2 ? 0 : bcur + 1;
#else
    { const int lane = F.lane; if (LOADER_WAVE(F.wave)) HG_ISSUE(0, 0); }
    for (int n = 0; n < SEQ / 64; ++n) {
        int lane = F.lane; asm volatile("" : "+v"(lane));
        const int r = lane & 31, hg = lane >> 5;
        LAS unsigned char* L = F.lds + (n & 1) * 66560;
        if (HELPER_WAVE(F.wave) && n >= 2) asm volatile("s_waitcnt vmcnt(4)" ::: "memory"); else if (F.wave >= 2) asm volatile("s_waitcnt vmcnt(0)" ::: "memory");
        __syncthreads();
        if (LOADER_WAVE(F.wave) && n + 1 < SEQ / 64) HG_ISSUE(n + 1, ((n + 1) & 1) * 66560);
#endif
        if (F.wave < 2) {
            const size_t row0 = (size_t)b * SEQ + 64 * n;
            const LAS unsigned char* Lp = L + lane * 16;
            bf16x8 bs[8];
#pragma unroll
            for (int kt = 0; kt < 8; ++kt) bs[kt] = pack_half(S[kt >> 1], kt & 1);
            bf16x8 bv[4];
#pragma unroll
            for (int kt = 0; kt < 4; ++kt) bv[kt] = lds_frag(Lp + 41984 + (F.wave & 1) * 4096 + kt * 1024);
            f32x16 o[2] = {zero16(), zero16()};
#define HG_DECAY(t4) do { _Pragma("unroll") for (int g = 0; g < 4; ++g) { const f32x4 dc = *(const LAS f32x4*)(L + 40960 + 4 * (32 * (t4) + 8 * g + 4 * hg)); \
                _Pragma("unroll") for (int e = 0; e < 4; ++e) S[t4][4 * g + e] *= dc[e]; } } while (0)
            bf16x8 rg0 = lds_frag(Lp + 0);
            bf16x8 rg1 = lds_frag(Lp + 1024);
            bf16x8 rg2 = lds_frag(Lp + 2048);
            bf16x8 rg3 = lds_frag(Lp + 3072);
            { const bf16x8 a = rg0; rg0 = lds_frag(Lp + 4096);
              o[0] = MFMA32(a, bs[0], o[0]); }
            __builtin_amdgcn_sched_barrier(0); asm volatile("" ::: "memory");
            { const bf16x8 a = rg1; rg1 = lds_frag(Lp + 5120);
              o[0] = MFMA32(a, bs[1], o[0]); }
            __builtin_amdgcn_sched_barrier(0); asm volatile("" ::: "memory");
            { const bf16x8 a = rg2; rg2 = lds_frag(Lp + 6144);
              o[0] = MFMA32(a, bs[2], o[0]); }
            __builtin_amdgcn_sched_barrier(0); asm volatile("" ::: "memory");
            { const bf16x8 a = rg3; rg3 = lds_frag(Lp + 7168);
              o[0] = MFMA32(a, bs[3], o[0]); }
            __builtin_amdgcn_sched_barrier(0); asm volatile("" ::: "memory");
            { const bf16x8 a = rg0; rg0 = lds_frag(Lp + 8192);
              o[0] = MFMA32(a, bs[4], o[0]); }
            __builtin_amdgcn_sched_barrier(0); asm volatile("" ::: "memory");
            { const bf16x8 a = rg1; rg1 = lds_frag(Lp + 9216);
              o[0] = MFMA32(a, bs[5], o[0]); }
            __builtin_amdgcn_sched_barrier(0); asm volatile("" ::: "memory");
            { const bf16x8 a = rg2; rg2 = lds_frag(Lp + 10240);
              o[0] = MFMA32(a, bs[6], o[0]); }
            __builtin_amdgcn_sched_barrier(0); asm volatile("" ::: "memory");
            { const bf16x8 a = rg3; rg3 = lds_frag(Lp + 11264);
              o[0] = MFMA32(a, bs[7], o[0]); }
            __builtin_amdgcn_sched_barrier(0); asm volatile("" ::: "memory");
            { const bf16x8 a = rg0; rg0 = lds_frag(Lp + 12288);
              o[1] = MFMA32(a, bs[0], o[1]); }
            __builtin_amdgcn_sched_barrier(0); asm volatile("" ::: "memory");
            { const bf16x8 a = rg1; rg1 = lds_frag(Lp + 13312);
              o[1] = MFMA32(a, bs[1], o[1]); }
            __builtin_amdgcn_sched_barrier(0); asm volatile("" ::: "memory");
            { const bf16x8 a = rg2; rg2 = lds_frag(Lp + 14336);
              o[1] = MFMA32(a, bs[2], o[1]); }
            __builtin_amdgcn_sched_barrier(0); asm volatile("" ::: "memory");
            { const bf16x8 a = rg3; rg3 = lds_frag(Lp + 15360);
              o[1] = MFMA32(a, bs[3], o[1]); }
            __builtin_amdgcn_sched_barrier(0); asm volatile("" ::: "memory");
            { const bf16x8 a = rg0; rg0 = lds_frag(Lp + 32768);
              o[1] = MFMA32(a, bs[4], o[1]); }
            __builtin_amdgcn_sched_barrier(0); asm volatile("" ::: "memory");
            { const bf16x8 a = rg1; rg1 = lds_frag(Lp + 33792);
              o[1] = MFMA32(a, bs[5], o[1]); }
            __builtin_amdgcn_sched_barrier(0); asm volatile("" ::: "memory");
            { const bf16x8 a = rg2; rg2 = lds_frag(Lp + 36864);
              o[1] = MFMA32(a, bs[6], o[1]); }
            __builtin_amdgcn_sched_barrier(0); asm volatile("" ::: "memory");
            { const bf16x8 a = rg3; rg3 = lds_frag(Lp + 37888);
              o[1] = MFMA32(a, bs[7], o[1]); }
            __builtin_amdgcn_sched_barrier(0); asm volatile("" ::: "memory");
            { const bf16x8 a = rg0; rg0 = lds_frag(Lp + 38912);
              o[0] = MFMA32(a, bv[0], o[0]); }
            __builtin_amdgcn_sched_barrier(0); asm volatile("" ::: "memory");
            { const bf16x8 a = rg1; rg1 = lds_frag(Lp + 39936);
              o[0] = MFMA32(a, bv[1], o[0]); }
            __builtin_amdgcn_sched_barrier(0); asm volatile("" ::: "memory");
            { const bf16x8 a = rg2; rg2 = lds_frag(Lp + 16384);
              o[1] = MFMA32(a, bv[0], o[1]); }
            __builtin_amdgcn_sched_barrier(0); asm volatile("" ::: "memory");
            { const bf16x8 a = rg3; rg3 = lds_frag(Lp + 17408);
              o[1] = MFMA32(a, bv[1], o[1]); }
            __builtin_amdgcn_sched_barrier(0); asm volatile("" ::: "memory");
            { const bf16x8 a = rg0; rg0 = lds_frag(Lp + 18432);
              o[1] = MFMA32(a, bv[2], o[1]); }
            __builtin_amdgcn_sched_barrier(0); asm volatile("" ::: "memory");
            { const bf16x8 a = rg1; rg1 = lds_frag(Lp + 19456);
              o[1] = MFMA32(a, bv[3], o[1]); }
            __builtin_amdgcn_sched_barrier(0); asm volatile("" ::: "memory");
            { const bf16x8 a = rg2; rg2 = lds_frag(Lp + 20480);
              HG_DECAY(0);
              S[0] = MFMA32(a, bv[0], S[0]); }
            __builtin_amdgcn_sched_barrier(0); asm volatile("" ::: "memory");
            { const bf16x8 a = rg3; rg3 = lds_frag(Lp + 21504);
              S[0] = MFMA32(a, bv[1], S[0]); }
            __builtin_amdgcn_sched_barrier(0); asm volatile("" ::: "memory");
            { const bf16x8 a = rg0; rg0 = lds_frag(Lp + 22528);
              S[0] = MFMA32(a, bv[2], S[0]); }
            __builtin_amdgcn_sched_barrier(0); asm volatile("" ::: "memory");
            { const bf16x8 a = rg1; rg1 = lds_frag(Lp + 23552);
              S[0] = MFMA32(a, bv[3], S[0]); }
            __builtin_amdgcn_sched_barrier(0); asm volatile("" ::: "memory");
            { const bf16x8 a = rg2; rg2 = lds_frag(Lp + 24576);
              HG_DECAY(1);
              S[1] = MFMA32(a, bv[0], S[1]); }
            __builtin_amdgcn_sched_barrier(0); asm volatile("" ::: "memory");
            { const bf16x8 a = rg3; rg3 = lds_frag(Lp + 25600);
              S[1] = MFMA32(a, bv[1], S[1]); }
            __builtin_amdgcn_sched_barrier(0); asm volatile("" ::: "memory");
            { const bf16x8 a = rg0; rg0 = lds_frag(Lp + 26624);
              S[1] = MFMA32(a, bv[2], S[1]); }
            __builtin_amdgcn_sched_barrier(0); asm volatile("" ::: "memory");
            { const bf16x8 a = rg1; rg1 = lds_frag(Lp + 27648);
              S[1] = MFMA32(a, bv[3], S[1]); }
            __builtin_amdgcn_sched_barrier(0); asm volatile("" ::: "memory");
            { const bf16x8 a = rg2; rg2 = lds_frag(Lp + 28672);
              HG_DECAY(2);
              S[2] = MFMA32(a, bv[0], S[2]); }
            __builtin_amdgcn_sched_barrier(0); asm volatile("" ::: "memory");
            { const bf16x8 a = rg3; rg3 = lds_frag(Lp + 29696);
              S[2] = MFMA32(a, bv[1], S[2]); }
            __builtin_amdgcn_sched_barrier(0); asm volatile("" ::: "memory");
            { const bf16x8 a = rg0; rg0 = lds_frag(Lp + 30720);
              S[2] = MFMA32(a, bv[2], S[2]); }
            __builtin_amdgcn_sched_barrier(0); asm volatile("" ::: "memory");
            { const bf16x8 a = rg1; rg1 = lds_frag(Lp + 31744);
              S[2] = MFMA32(a, bv[3], S[2]); }
            __builtin_amdgcn_sched_barrier(0); asm volatile("" ::: "memory");
            { const bf16x8 a = rg2;
              HG_DECAY(3);
              S[3] = MFMA32(a, bv[0], S[3]); }
            __builtin_amdgcn_sched_barrier(0); asm volatile("" ::: "memory");
            { const bf16x8 a = rg3;
              S[3] = MFMA32(a, bv[1], S[3]); }
            __builtin_amdgcn_sched_barrier(0); asm volatile("" ::: "memory");
            { const bf16x8 a = rg0;
              S[3] = MFMA32(a, bv[2], S[3]); }
            __builtin_amdgcn_sched_barrier(0); asm volatile("" ::: "memory");
            { const bf16x8 a = rg1;
              S[3] = MFMA32(a, bv[3], S[3]); }
            __builtin_amdgcn_sched_barrier(0); asm volatile("" ::: "memory");
#undef HG_DECAY
            chain_stage_o(F.lds + OST_OFF + (n & 1) * OST_BUF + (F.wave & 1) * OST_SLICE, o, r, hg);
        }
        if (HELPER_WAVE(F.wave)) { const int hx = HELPER_IDX(F.wave); chain_helper_step(F, 0, b, h, sl0, n, hx, lane); }
    }
    if (HELPER_WAVE(F.wave)) asm volatile("s_waitcnt vmcnt(0)" ::: "memory");
    __syncthreads();
    if (HELPER_WAVE(F.wave)) { const int hx = HELPER_IDX(F.wave); chain_helper_step(F, 0, b, h, sl0, SEQ / 64, hx, F.lane); }
    __syncthreads();
}

__device__ __forceinline__ float softplus2(float x) { return x > 20.f ? x : log1pf(__expf(x)); }
#define MFMA16F(a, b, c) __builtin_amdgcn_mfma_f32_16x16x4f32((a), (b), (c), 0, 0, 0)
struct DnRaw { v4u q[3], k[3], v[3]; float a, bl; };
__device__ __forceinline__ void dn_raw_load(DnRaw& r, Frame& F, int unit, int tid, int lane) {
    const int h = unit & 3, n = (unit >> 2) & 127, b = unit >> 9; const size_t row0 = (size_t)b * SEQ + 64 * n;
    const bf16* P4 = (const bf16*)(F.ws + WS_P) + 4 * PLANE; const bf16* P5 = P4 + PLANE; const bf16* P6 = (const bf16*)(F.ws + WS_P) + 3 * PLANE;
#pragma unroll
    for (int i = 0; i < 3; ++i) { const int idx = tid + 512 * i, rr = idx >> 4, d8 = (idx & 15) * 8;
        v4u qv = (v4u){0u, 0u, 0u, 0u}, kv = qv, vv = qv;
        if (idx < 67 * 16 && 64 * n + rr >= 3) { const size_t off = (row0 + rr - 3) * 512 + 128 * h + d8; qv = *(const GAS v4u*)(P4 + off); kv = *(const GAS v4u*)(P5 + off); vv = *(const GAS v4u*)(P6 + off); }
        r.q[i] = qv; r.k[i] = kv; r.v[i] = vv; }
    const float* ab = (const float*)(F.ws + WS_AB);
    r.a = ab[(row0 + lane) * 8 + h]; r.bl = ab[(row0 + lane) * 8 + 4 + h];
}
struct DnConst { float na, dtb; float cwq[4][2], cwk[4][2], cwv[4][2]; };
__device__ __forceinline__ void prep_dn_unit(Frame& F, int l, int unit, const DnRaw& raw, const DnConst& dc) {
    const int h = unit & 3, n = (unit >> 2) & 127, b = unit >> 9;
    const size_t row0 = (size_t)b * SEQ + 64 * n;
    LAS unsigned char* L = F.lds;
    LAS unsigned char* RQ = L; LAS unsigned char* RK = L + 17152; LAS unsigned char* RV = L + 34304;
    LAS float* AM = (LAS float*)L; LAS float* TM = (LAS float*)(L + 17408); LAS unsigned char* TB = L; LAS unsigned char* ATT = L + 34816;
    LAS unsigned char* QN = L + 51456; LAS unsigned char* KN = L + 68864; LAS unsigned char* QG = L + 86272; LAS unsigned char* WN = QN;
    LAS unsigned char* XT = L + 103680; LAS unsigned char* VT = L + 122112; LAS unsigned char* KDT = L + 140544;
    LAS float* GCA = (LAS float*)(L + 158976); LAS float* BEA = (LAS float*)(L + 159232);
    const bf16* P4 = (const bf16*)(F.ws + WS_P) + 4 * PLANE; const bf16* P5 = P4 + PLANE; const bf16* P6 = (const bf16*)(F.ws + WS_P) + 3 * PLANE;
    const float* ab = (const float*)(F.ws + WS_AB);
    unsigned char* ub = F.ws + WS_DNB + (size_t)((b * 4 + h) * 128 + n) * DN_UNIT;
    const int w = F.wave; int lane = F.lane; asm volatile("" : "+v"(lane));
    const int d0 = 2 * lane, r = lane & 31, hg = lane >> 5;
#pragma unroll
    for (int i = 0; i < 3; ++i) { const int idx = F.tid + 512 * i, rr = idx >> 4, d8 = (idx & 15) * 8;
        if (idx < 67 * 16) { *(LAS v4u*)(RQ + rr * 256 + 2 * d8) = raw.q[i]; *(LAS v4u*)(RK + rr * 256 + 2 * d8) = raw.k[i]; *(LAS v4u*)(RV + rr * 256 + 2 * d8) = raw.v[i]; } }
    float gc, beta;
    { const float a = raw.a, bl = raw.bl;
      float x = dc.na * softplus2(a + dc.dtb);
#pragma unroll
      for (int o = 1; o < 64; o <<= 1) { const float y = __shfl_up(x, o); if (lane >= o) x += y; }
      gc = x; beta = sigmf(bl);
      if (w == 0) { GCA[lane] = gc; BEA[lane] = beta; } }
    const float glast = __shfl(gc, 63);
    __syncthreads();
#ifndef DUP_PB
#define DUP_PB 1
#endif
    _Pragma("unroll") for (int rpb_ = 0; rpb_ < DUP_PB; ++rpb_)
    {
        float cwq[4][2], cwk[4][2], cwv[4][2];
#pragma unroll
        for (int j = 0; j < 4; ++j) { cwq[j][0] = dc.cwq[j][0]; cwq[j][1] = dc.cwq[j][1]; cwk[j][0] = dc.cwk[j][0]; cwk[j][1] = dc.cwk[j][1]; cwv[j][0] = dc.cwv[j][0]; cwv[j][1] = dc.cwv[j][1]; }
        unsigned rq[11], rk[11], rv[11];
#pragma unroll
        for (int i = 0; i < 11; ++i) { rq[i] = *(const LAS unsigned*)(RQ + (8 * w + i) * 256 + 2 * d0); rk[i] = *(const LAS unsigned*)(RK + (8 * w + i) * 256 + 2 * d0); rv[i] = *(const LAS unsigned*)(RV + (8 * w + i) * 256 + 2 * d0); }
        unsigned xt[2][4], vt[2][4], kd[2][4];
#pragma unroll
        for (int i = 0; i < 8; ++i) {
            float cq[2] = {0.f, 0.f}, ck[2] = {0.f, 0.f}, cv[2] = {0.f, 0.f};
#pragma unroll
            for (int j = 0; j < 4; ++j) { cq[0] += cwq[j][0] * bflo(rq[i + j]); cq[1] += cwq[j][1] * bfhi(rq[i + j]); ck[0] += cwk[j][0] * bflo(rk[i + j]); ck[1] += cwk[j][1] * bfhi(rk[i + j]);
                cv[0] += cwv[j][0] * bflo(rv[i + j]); cv[1] += cwv[j][1] * bfhi(rv[i + j]); }
#pragma unroll
            for (int e = 0; e < 2; ++e) { cq[e] *= sigmf(cq[e]); ck[e] *= sigmf(ck[e]); cv[e] *= sigmf(cv[e]); }
            const float sq = wave_sum(cq[0] * cq[0] + cq[1] * cq[1]), sk = wave_sum(ck[0] * ck[0] + ck[1] * ck[1]);
            const float rqn = __builtin_amdgcn_rsqf(sq + EPSF) * 0.08838834764831845f, rkn = __builtin_amdgcn_rsqf(sk + EPSF);
            const int t = 8 * w + i;
            const float gci = __shfl(gc, t), bei = __shfl(beta, t);
            const float eg = __expf(gci), ed = __expf(glast - gci);
            const float q0 = cq[0] * rqn, q1 = cq[1] * rqn, k0 = ck[0] * rkn, k1 = ck[1] * rkn;
            *(LAS unsigned*)(QN + t * PQ + 2 * d0) = pk2(q0, q1); *(LAS unsigned*)(KN + t * PQ + 2 * d0) = pk2(k0, k1); *(LAS unsigned*)(QG + t * PQ + 2 * d0) = pk2(q0 * eg, q1 * eg);
            const unsigned x0 = f2bf(k0 * bei * eg), x1 = f2bf(k1 * bei * eg), v0 = f2bf(cv[0] * bei), v1 = f2bf(cv[1] * bei), e0 = f2bf(k0 * ed), e1 = f2bf(k1 * ed);
            if (i & 1) { xt[0][i >> 1] |= x0 << 16; xt[1][i >> 1] |= x1 << 16; vt[0][i >> 1] |= v0 << 16; vt[1][i >> 1] |= v1 << 16; kd[0][i >> 1] |= e0 << 16; kd[1][i >> 1] |= e1 << 16; }
            else { xt[0][i >> 1] = x0; xt[1][i >> 1] = x1; vt[0][i >> 1] = v0; vt[1][i >> 1] = v1; kd[0][i >> 1] = e0; kd[1][i >> 1] = e1; }
        }
#pragma unroll
        for (int e = 0; e < 2; ++e) {
            *(LAS v4u*)(XT + (d0 + e) * PT + 16 * w) = (v4u){xt[e][0], xt[e][1], xt[e][2], xt[e][3]};
            *(LAS v4u*)(VT + (d0 + e) * PT + 16 * w) = (v4u){vt[e][0], vt[e][1], vt[e][2], vt[e][3]};
            *(LAS v4u*)(KDT + (d0 + e) * PT + 16 * w) = (v4u){kd[e][0], kd[e][1], kd[e][2], kd[e][3]}; }
    }
    __syncthreads();
    if (w < 6) {
        const int tsel = w % 3, m = tsel >= 1 ? 1 : 0, mp = tsel == 2 ? 1 : 0;
        const LAS unsigned char* Asrc = w < 3 ? KN : QN;
        f32x16 acc = zero16();
#pragma unroll
        for (int ks = 0; ks < 8; ++ks) acc = MFMA32(lds_frag(Asrc + (32 * m + r) * PQ + 32 * ks + 16 * hg), lds_frag(KN + (32 * mp + r) * PQ + 32 * ks + 16 * hg), acc);
        const int jj = 32 * mp + r; const float gj = GCA[jj];
#pragma unroll
        for (int i = 0; i < 16; ++i) { const int ii = 32 * m + (i & 3) + 8 * (i >> 2) + 4 * hg; const float gi = GCA[ii];
            const float bei = BEA[ii], ex = __expf(fminf(gi - gj, 0.f));
            const float va = (jj < ii ? 1.f : 0.f) * (acc[i] * bei * ex), vq = (jj <= ii ? 1.f : 0.f) * (acc[i] * ex);
            if (w < 3) AM[ii * 68 + jj] = va; else *(LAS bf16*)(ATT + ii * PT + 2 * jj) = (bf16)f2bf(vq); }
    } else if (w == 6) {
#pragma unroll
        for (int i = 0; i < 16; ++i) *(LAS bf16*)(ATT + (2 * i + hg) * PT + 2 * (32 + r)) = 0;
    }
    __syncthreads();
#ifndef DUP_INV
#define DUP_INV 1
#endif
    _Pragma("unroll") for (int rpi_ = 0; rpi_ < DUP_INV; ++rpi_) {
    if (w == 0) {
        const int kb = lane >> 4, c = lane & 15;
        float x[16];
#pragma unroll
        for (int i = 0; i < 16; ++i) { float s = (i == c) ? 1.f : 0.f;
#pragma unroll
            for (int j4 = 0; j4 < (i + 3) / 4; ++j4) { const f32x4 a = *(const LAS f32x4*)(AM + (16 * kb + i) * 68 + 16 * kb + 4 * j4);
#pragma unroll
                for (int e = 0; e < 4; ++e) if (4 * j4 + e < i) s -= a[e] * x[4 * j4 + e]; }
            x[i] = s; }
#pragma unroll
        for (int i = 0; i < 16; ++i) TM[(16 * kb + i) * 68 + 16 * kb + c] = x[i];
    }
    __syncthreads();
#pragma unroll
    for (int lev = 1; lev <= 3; ++lev) {
        if (w < 4 - lev) { const int bi = w + lev, bk = w; const int li = lane & 15, lq = lane >> 4;
            f32x4 Mx = (f32x4){0.f, 0.f, 0.f, 0.f};
            for (int bj = bk; bj < bi; ++bj)
#pragma unroll
                for (int ks = 0; ks < 4; ++ks) Mx = MFMA16F(AM[(16 * bi + li) * 68 + 16 * bj + 4 * ks + lq], TM[(16 * bj + 4 * ks + lq) * 68 + 16 * bk + li], Mx);
            f32x4 Tx = (f32x4){0.f, 0.f, 0.f, 0.f};
#pragma unroll
            for (int e = 0; e < 4; ++e) Tx = MFMA16F(TM[(16 * bi + li) * 68 + 16 * bi + 4 * lq + e], Mx[e], Tx);
#pragma unroll
            for (int e = 0; e < 4; ++e) TM[(16 * bi + 4 * lq + e) * 68 + 16 * bk + li] = -Tx[e];
        }
        __syncthreads();
    }
    }
    { float tv[8];
#pragma unroll
      for (int i = 0; i < 8; ++i) { const int idx = F.tid + 512 * i, ii = idx >> 6, jj = idx & 63; tv[i] = (jj >> 4) > (ii >> 4) ? 0.f : TM[ii * 68 + jj]; }
      __syncthreads();
#pragma unroll
      for (int i = 0; i < 8; ++i) { const int idx = F.tid + 512 * i, ii = idx >> 6, jj = idx & 63; *(LAS bf16*)(TB + ii * PT + 2 * jj) = (bf16)f2bf(tv[i]); } }
    __syncthreads();
    {
        const int nt = w & 3; const LAS unsigned char* Bsrc = w < 4 ? XT : VT;
        f32x16 acc[2] = {zero16(), zero16()};
#pragma unroll
        for (int ks = 0; ks < 4; ++ks) { const bf16x8 bfr = lds_frag(Bsrc + (32 * nt + r) * PT + 32 * ks + 16 * hg);
            if (ks < 2) acc[0] = MFMA32(lds_frag(TB + r * PT + 32 * ks + 16 * hg), bfr, acc[0]);
            acc[1] = MFMA32(lds_frag(TB + (32 + r) * PT + 32 * ks + 16 * hg), bfr, acc[1]); }
        if (w < 4) {
#pragma unroll
            for (int m = 0; m < 2; ++m)
#pragma unroll
                for (int i = 0; i < 16; ++i) *(LAS bf16*)(WN + (32 * m + (i & 3) + 8 * (i >> 2) + 4 * hg) * PQ + 2 * (32 * nt + r)) = (bf16)f2bf(-acc[m][i]);
        } else {
#pragma unroll
            for (int m = 0; m < 2; ++m) { v4u o0, o1;
                o0.x = pk2(acc[m][0], acc[m][1]); o0.y = pk2(acc[m][2], acc[m][3]); o0.z = pk2(acc[m][4], acc[m][5]); o0.w = pk2(acc[m][6], acc[m][7]);
                o1.x = pk2(acc[m][8], acc[m][9]); o1.y = pk2(acc[m][10], acc[m][11]); o1.z = pk2(acc[m][12], acc[m][13]); o1.w = pk2(acc[m][14], acc[m][15]);
                GAS v4u* dst = (GAS v4u*)(ub + 58368 + nt * 4096 + m * 2048 + lane * 32); dst[0] = o0; dst[1] = o1; }
        }
    }
    __syncthreads();
#ifndef DUP_PF
#define DUP_PF 1
#endif
    _Pragma("unroll") for (int rpf_ = 0; rpf_ < DUP_PF; ++rpf_) {
#pragma unroll
    for (int i = 0; i < 2; ++i) { const int f = w + 8 * i, m = f >> 3, kt = f & 7;
        { const LAS unsigned char* src = WN + (32 * m + r) * PQ + 2 * (16 * kt + 4 * hg); const v2u a = *(const LAS v2u*)src, c = *(const LAS v2u*)(src + 16);
          *(GAS v4u*)(ub + f * 1024 + lane * 16) = (v4u){a.x, a.y, c.x, c.y}; }
        { const LAS unsigned char* src = QG + (32 * m + r) * PQ + 2 * (16 * kt + 4 * hg); const v2u a = *(const LAS v2u*)src, c = *(const LAS v2u*)(src + 16);
          *(GAS v4u*)(ub + 16384 + f * 1024 + lane * 16) = (v4u){a.x, a.y, c.x, c.y}; } }
#pragma unroll
    for (int i = 0; i < 2; ++i) { const int f = w + 8 * i, t4 = f >> 2, ktp = f & 3;
        const LAS unsigned char* src = KDT + (32 * t4 + r) * PT + 2 * (16 * ktp + 4 * hg); const v2u a = *(const LAS v2u*)src, c = *(const LAS v2u*)(src + 16);
        *(GAS v4u*)(ub + 32768 + f * 1024 + lane * 16) = (v4u){a.x, a.y, c.x, c.y}; }
    { const int f = w, m = f >> 2, ktp = f & 3;
        const LAS unsigned char* src = ATT + (32 * m + r) * PT + 2 * (16 * ktp + 4 * hg); const v2u a = *(const LAS v2u*)src, c = *(const LAS v2u*)(src + 16);
        *(GAS v4u*)(ub + 49152 + f * 1024 + lane * 16) = (v4u){a.x, a.y, c.x, c.y}; }
    }
    if (F.tid == 0) *(GAS float*)(ub + 57344) = __expf(glast);
    __syncthreads();
}

__device__ __forceinline__ void scan_dn_chain(Frame& F, int bh, int sl0) {
    const int sl = sl0 + (F.wave & 1);
    const int b = bh >> 2, h = bh & 3;
    bf16* oraw = (bf16*)(F.ws + WS_ORAW) + PLANE;
    f32x16 S[4];
#pragma unroll
    for (int t = 0; t < 4; ++t) S[t] = zero16();
#define DN_ISSUE(nn, bufo) do { const int unit_ = (b * 4 + h) * 128 + (nn); const unsigned char* ub_ = F.ws + WS_DNB + (size_t)unit_ * DN_UNIT; \
        for (int f = LOADER_F0(F.wave); f < 65; f += LOADER_STRIDE) { const unsigned char* src = ub_ + f * 1024 + (f >= 57 ? sl0 * 4096 : 0);     \
            __builtin_amdgcn_global_load_lds((const unsigned*)(src + lane * 16), (LAS unsigned*)(F.lds + (bufo) + f * 1024), 16, 0, SCAN_AUX); } } while (0)
    { const int lane = F.lane; if (LOADER_WAVE(F.wave)) DN_ISSUE(0, 0); }
    for (int n = 0; n < SEQ / 64; ++n) {
        int lane = F.lane; asm volatile("" : "+v"(lane));
        const int r = lane & 31, hg = lane >> 5;
        LAS unsigned char* L = F.lds + (n & 1) * 66560;
        if (HELPER_WAVE(F.wave) && n >= 2) asm volatile("s_waitcnt vmcnt(4)" ::: "memory"); else if (F.wave >= 2) asm volatile("s_waitcnt vmcnt(0)" ::: "memory");
        __syncthreads();
        if (LOADER_WAVE(F.wave) && n + 1 < SEQ / 64) DN_ISSUE(n + 1, ((n + 1) & 1) * 66560);
        if (F.wave < 2) {
            const size_t row0 = (size_t)b * SEQ + 64 * n;
            const LAS unsigned char* Lp = L + lane * 16;
            bf16x8 bs[8];
#pragma unroll
            for (int kt = 0; kt < 8; ++kt) bs[kt] = pack_half(S[kt >> 1], kt & 1);
            f32x16 vn[2], o[2] = {zero16(), zero16()};
#pragma unroll
            for (int m = 0; m < 2; ++m) { const v4u u0 = *(const LAS v4u*)(L + 58368 + (F.wave & 1) * 4096 + m * 2048 + lane * 32), u1 = *(const LAS v4u*)(L + 58368 + (F.wave & 1) * 4096 + m * 2048 + lane * 32 + 16);
                vn[m][0] = bflo(u0.x); vn[m][1] = bfhi(u0.x); vn[m][2] = bflo(u0.y); vn[m][3] = bfhi(u0.y); vn[m][4] = bflo(u0.z); vn[m][5] = bfhi(u0.z); vn[m][6] = bflo(u0.w); vn[m][7] = bfhi(u0.w);
                vn[m][8] = bflo(u1.x); vn[m][9] = bfhi(u1.x); vn[m][10] = bflo(u1.y); vn[m][11] = bfhi(u1.y); vn[m][12] = bflo(u1.z); vn[m][13] = bfhi(u1.z); vn[m][14] = bflo(u1.w); vn[m][15] = bfhi(u1.w); }
            const float dl = *(const LAS float*)(L + 57344);
            bf16x8 bv[4];
#if SCAN_DUMMY
            f32x16 dmy = zero16();
#endif
            bf16x8 rg0 = lds_frag(Lp + 0);
            bf16x8 rg1 = lds_frag(Lp + 1024);
            bf16x8 rg2 = lds_frag(Lp + 2048);
            bf16x8 rg3 = lds_frag(Lp + 3072);
            bf16x8 rg4 = lds_frag(Lp + 4096);
            bf16x8 rg5 = lds_frag(Lp + 5120);
            bf16x8 rg6 = lds_frag(Lp + 6144);
            bf16x8 rg7 = lds_frag(Lp + 7168);
            { const bf16x8 a = rg0; rg0 = lds_frag(Lp + 8192);
              vn[0] = MFMA32(a, bs[0], vn[0]); }
            __builtin_amdgcn_sched_barrier(0);
            { const bf16x8 a = rg1; rg1 = lds_frag(Lp + 9216);
              vn[0] = MFMA32(a, bs[1], vn[0]); }
            __builtin_amdgcn_sched_barrier(0);
            { const bf16x8 a = rg2; rg2 = lds_frag(Lp + 10240);
              vn[0] = MFMA32(a, bs[2], vn[0]); }
            __builtin_amdgcn_sched_barrier(0);
            { const bf16x8 a = rg3; rg3 = lds_frag(Lp + 11264);
              vn[0] = MFMA32(a, bs[3], vn[0]); }
            __builtin_amdgcn_sched_barrier(0);
            { const bf16x8 a = rg4; rg4 = lds_frag(Lp + 12288);
              vn[0] = MFMA32(a, bs[4], vn[0]); }
            __builtin_amdgcn_sched_barrier(0);
            { const bf16x8 a = rg5; rg5 = lds_frag(Lp + 13312);
              vn[0] = MFMA32(a, bs[5], vn[0]); }
            __builtin_amdgcn_sched_barrier(0);
            { const bf16x8 a = rg6; rg6 = lds_frag(Lp + 14336);
              vn[0] = MFMA32(a, bs[6], vn[0]); }
            __builtin_amdgcn_sched_barrier(0);
            { const bf16x8 a = rg7; rg7 = lds_frag(Lp + 15360);
              vn[0] = MFMA32(a, bs[7], vn[0]); }
            __builtin_amdgcn_sched_barrier(0);
            { const bf16x8 a = rg0; rg0 = lds_frag(Lp + 16384);
              vn[1] = MFMA32(a, bs[0], vn[1]); }
            __builtin_amdgcn_sched_barrier(0);
            { const bf16x8 a = rg1; rg1 = lds_frag(Lp + 17408);
              vn[1] = MFMA32(a, bs[1], vn[1]); }
            __builtin_amdgcn_sched_barrier(0);
            { const bf16x8 a = rg2; rg2 = lds_frag(Lp + 18432);
              vn[1] = MFMA32(a, bs[2], vn[1]); }
            __builtin_amdgcn_sched_barrier(0);
            { const bf16x8 a = rg3; rg3 = lds_frag(Lp + 19456);
              vn[1] = MFMA32(a, bs[3], vn[1]); }
            __builtin_amdgcn_sched_barrier(0);
            { const bf16x8 a = rg4; rg4 = lds_frag(Lp + 20480);
              vn[1] = MFMA32(a, bs[4], vn[1]); }
            __builtin_amdgcn_sched_barrier(0);
            { const bf16x8 a = rg5; rg5 = lds_frag(Lp + 21504);
              vn[1] = MFMA32(a, bs[5], vn[1]); }
            __builtin_amdgcn_sched_barrier(0);
            { const bf16x8 a = rg6; rg6 = lds_frag(Lp + 22528);
              vn[1] = MFMA32(a, bs[6], vn[1]); }
            __builtin_amdgcn_sched_barrier(0);
            { const bf16x8 a = rg7; rg7 = lds_frag(Lp + 23552);
              vn[1] = MFMA32(a, bs[7], vn[1]); }
            __builtin_amdgcn_sched_barrier(0);
            { const bf16x8 a = rg0; rg0 = lds_frag(Lp + 24576);
              o[0] = MFMA32(a, bs[0], o[0]);
#if SCAN_DUMMY
              dmy = MFMA32(a, bs[0], dmy);
#endif
              }
            __builtin_amdgcn_sched_barrier(0);
            { const bf16x8 a = rg1; rg1 = lds_frag(Lp + 25600);
              o[0] = MFMA32(a, bs[1], o[0]);
#if SCAN_DUMMY
              dmy = MFMA32(a, bs[1], dmy);
#endif
              }
            __builtin_amdgcn_sched_barrier(0);
            { const bf16x8 a = rg2; rg2 = lds_frag(Lp + 26624);
              o[0] = MFMA32(a, bs[2], o[0]);
#if SCAN_DUMMY
              dmy = MFMA32(a, bs[2], dmy);
#endif
              }
            __builtin_amdgcn_sched_barrier(0);
            { const bf16x8 a = rg3; rg3 = lds_frag(Lp + 27648);
              o[0] = MFMA32(a, bs[3], o[0]);
#if SCAN_DUMMY
              dmy = MFMA32(a, bs[3], dmy);
#endif
              }
            __builtin_amdgcn_sched_barrier(0);
            { const bf16x8 a = rg4; rg4 = lds_frag(Lp + 28672);
              o[0] = MFMA32(a, bs[4], o[0]);
#if SCAN_DUMMY
              dmy = MFMA32(a, bs[4], dmy);
#endif
              }
            __builtin_amdgcn_sched_barrier(0);
            { const bf16x8 a = rg5; rg5 = lds_frag(Lp + 29696);
              o[0] = MFMA32(a, bs[5], o[0]);
#if SCAN_DUMMY
              dmy = MFMA32(a, bs[5], dmy);
#endif
              }
            __builtin_amdgcn_sched_barrier(0);
            { const bf16x8 a = rg6; rg6 = lds_frag(Lp + 30720);
              o[0] = MFMA32(a, bs[6], o[0]);
#if SCAN_DUMMY
              dmy = MFMA32(a, bs[6], dmy);
#endif
              }
            __builtin_amdgcn_sched_barrier(0);
            { const bf16x8 a = rg7; rg7 = lds_frag(Lp + 31744);
              o[0] = MFMA32(a, bs[7], o[0]);
#if SCAN_DUMMY
              dmy = MFMA32(a, bs[7], dmy);
#endif
              }
            __builtin_amdgcn_sched_barrier(0);
            { const bf16x8 a = rg0; rg0 = lds_frag(Lp + 49152);
              o[1] = MFMA32(a, bs[0], o[1]);
#if SCAN_DUMMY
              dmy = MFMA32(a, bs[0], dmy);
#endif
              }
            __builtin_amdgcn_sched_barrier(0);
            { const bf16x8 a = rg1; rg1 = lds_frag(Lp + 50176);
              o[1] = MFMA32(a, bs[1], o[1]);
#if SCAN_DUMMY
              dmy = MFMA32(a, bs[1], dmy);
#endif
              }
            __builtin_amdgcn_sched_barrier(0);
            { const bf16x8 a = rg2; rg2 = lds_frag(Lp + 53248);
              o[1] = MFMA32(a, bs[2], o[1]);
#if SCAN_DUMMY
              dmy = MFMA32(a, bs[2], dmy);
#endif
              }
            __builtin_amdgcn_sched_barrier(0);
            { const bf16x8 a = rg3; rg3 = lds_frag(Lp + 54272);
              o[1] = MFMA32(a, bs[3], o[1]);
#if SCAN_DUMMY
              dmy = MFMA32(a, bs[3], dmy);
#endif
              }
            __builtin_amdgcn_sched_barrier(0);
            { const bf16x8 a = rg4; rg4 = lds_frag(Lp + 55296);
              o[1] = MFMA32(a, bs[4], o[1]);
#if SCAN_DUMMY
              dmy = MFMA32(a, bs[4], dmy);
#endif
              }
            __builtin_amdgcn_sched_barrier(0);
            { const bf16x8 a = rg5; rg5 = lds_frag(Lp + 56320);
              o[1] = MFMA32(a, bs[5], o[1]);
#if SCAN_DUMMY
              dmy = MFMA32(a, bs[5], dmy);
#endif
              }
            __builtin_amdgcn_sched_barrier(0);
            { const bf16x8 a = rg6; rg6 = lds_frag(Lp + 32768);
              o[1] = MFMA32(a, bs[6], o[1]);
#if SCAN_DUMMY
              dmy = MFMA32(a, bs[6], dmy);
#endif
              }
            __builtin_amdgcn_sched_barrier(0);
            { const bf16x8 a = rg7; rg7 = lds_frag(Lp + 33792);
              o[1] = MFMA32(a, bs[7], o[1]);
#if SCAN_DUMMY
              dmy = MFMA32(a, bs[7], dmy);
#endif
              }
            __builtin_amdgcn_sched_barrier(0);
            { const bf16x8 a = rg0; rg0 = lds_frag(Lp + 34816);
              bv[0] = pack_half(vn[0], 0); bv[1] = pack_half(vn[0], 1); bv[2] = pack_half(vn[1], 0); bv[3] = pack_half(vn[1], 1);
              o[0] = MFMA32(a, bv[0], o[0]); }
            __builtin_amdgcn_sched_barrier(0);
            { const bf16x8 a = rg1; rg1 = lds_frag(Lp + 35840);
              o[0] = MFMA32(a, bv[1], o[0]); }
            __builtin_amdgcn_sched_barrier(0);
            { const bf16x8 a = rg2; rg2 = lds_frag(Lp + 36864);
              o[1] = MFMA32(a, bv[0], o[1]); }
            __builtin_amdgcn_sched_barrier(0);
            { const bf16x8 a = rg3; rg3 = lds_frag(Lp + 37888);
              o[1] = MFMA32(a, bv[1], o[1]); }
            __builtin_amdgcn_sched_barrier(0);
            { const bf16x8 a = rg4; rg4 = lds_frag(Lp + 38912);
              o[1] = MFMA32(a, bv[2], o[1]); }
            __builtin_amdgcn_sched_barrier(0);
            { const bf16x8 a = rg5; rg5 = lds_frag(Lp + 39936);
              o[1] = MFMA32(a, bv[3], o[1]); }
            __builtin_amdgcn_sched_barrier(0);
            { const bf16x8 a = rg6; rg6 = lds_frag(Lp + 40960);
              S[0] = S[0] * dl;
              S[0] = MFMA32(a, bv[0], S[0]); }
            __builtin_amdgcn_sched_barrier(0);
            { const bf16x8 a = rg7; rg7 = lds_frag(Lp + 41984);
              S[0] = MFMA32(a, bv[1], S[0]); }
            __builtin_amdgcn_sched_barrier(0);
            { const bf16x8 a = rg0; rg0 = lds_frag(Lp + 43008);
              S[0] = MFMA32(a, bv[2], S[0]); }
            __builtin_amdgcn_sched_barrier(0);
            { const bf16x8 a = rg1; rg1 = lds_frag(Lp + 44032);
              S[0] = MFMA32(a, bv[3], S[0]); }
            __builtin_amdgcn_sched_barrier(0);
            { const bf16x8 a = rg2; rg2 = lds_frag(Lp + 45056);
              S[1] = S[1] * dl;
              S[1] = MFMA32(a, bv[0], S[1]); }
            __builtin_amdgcn_sched_barrier(0);
            { const bf16x8 a = rg3; rg3 = lds_frag(Lp + 46080);
              S[1] = MFMA32(a, bv[1], S[1]); }
            __builtin_amdgcn_sched_barrier(0);
            { const bf16x8 a = rg4; rg4 = lds_frag(Lp + 47104);
              S[1] = MFMA32(a, bv[2], S[1]); }
            __builtin_amdgcn_sched_barrier(0);
            { const bf16x8 a = rg5; rg5 = lds_frag(Lp + 48128);
              S[1] = MFMA32(a, bv[3], S[1]); }
            __builtin_amdgcn_sched_barrier(0);
            { const bf16x8 a = rg6;
              S[2] = S[2] * dl;
              S[2] = MFMA32(a, bv[0], S[2]); }
            __builtin_amdgcn_sched_barrier(0);
            { const bf16x8 a = rg7;
              S[2] = MFMA32(a, bv[1], S[2]); }
            __builtin_amdgcn_sched_barrier(0);
            { const bf16x8 a = rg0;
              S[2] = MFMA32(a, bv[2], S[2]); }
            __builtin_amdgcn_sched_barrier(0);
            { const bf16x8 a = rg1;
              S[2] = MFMA32(a, bv[3], S[2]); }
            __builtin_amdgcn_sched_barrier(0);
            { const bf16x8 a = rg2;
              S[3] = S[3] * dl;
              S[3] = MFMA32(a, bv[0], S[3]); }
            __builtin_amdgcn_sched_barrier(0);
            { const bf16x8 a = rg3;
              S[3] = MFMA32(a, bv[1], S[3]); }
            __builtin_amdgcn_sched_barrier(0);
            { const bf16x8 a = rg4;
              S[3] = MFMA32(a, bv[2], S[3]); }
            __builtin_amdgcn_sched_barrier(0);
            { const bf16x8 a = rg5;
              S[3] = MFMA32(a, bv[3], S[3]); }
            __builtin_amdgcn_sched_barrier(0);
#if SCAN_DUMMY
            asm volatile("" :: "v"(dmy));
#endif
            chain_stage_o(F.lds + OST_OFF + (n & 1) * OST_BUF + (F.wave & 1) * OST_SLICE, o, r, hg);
        }
        if (HELPER_WAVE(F.wave)) { const int hx = HELPER_IDX(F.wave); chain_helper_step(F, 1, b, h, sl0, n, hx, lane); }
    }
    if (HELPER_WAVE(F.wave)) asm volatile("s_waitcnt vmcnt(0)" ::: "memory");
    __syncthreads();
    if (HELPER_WAVE(F.wave)) { const int hx = HELPER_IDX(F.wave); chain_helper_step(F, 1, b, h, sl0, SEQ / 64, hx, F.lane); }
    __syncthreads();
}
enum { MAT_INA = 0, MAT_INB, MAT_OHG, MAT_ODN, MAT_OUT, MAT_GU, MAT_DN, MAT_N };
__device__ __forceinline__ int colmap(int mat, int n) {
    switch (mat) {
        case MAT_INA: return n;
        case MAT_INB: return 4104 + n;
        case MAT_GU: { const int pn = n >> 8, r = n & 255; return r < 128 ? 128 * pn + r : DFF + 128 * pn + (r - 128); }
        default: return n;
    }
}
template <bool F8 = false>
__device__ __forceinline__ void transpose_item(const float* W, int K, int Nsrc, bf16* WT, int mat, const float* gain, LAS float* scr, int kb, int nb, int lane, int gmask = -1) {
    const int k0 = 64 * kb, n0 = 32 * nb;
    const int sc = colmap(mat, n0 + (lane & 31));
#pragma unroll 8
    for (int i = 0; i < 32; ++i) { const int kk = 2 * i + (lane >> 5);
        float v = 0.f; if (sc >= 0) { v = W[(size_t)(k0 + kk) * Nsrc + sc]; if (gain) v *= gain[(k0 + kk) & gmask]; }
        scr[kk * 33 + (lane & 31)] = v; }
    LDS_WAIT(); asm volatile("" ::: "memory");
    const int c = lane & 7;
#pragma unroll
    for (int j = 0; j < 4; ++j) { const int n = (lane >> 3) + 8 * j; const LAS float* s = scr + (8 * c) * 33 + n;
        if (F8) { v2u o; o.x = pk8(s[0 * 33] * W8_SCALE, s[1 * 33] * W8_SCALE, s[2 * 33] * W8_SCALE, s[3 * 33] * W8_SCALE); o.y = pk8(s[4 * 33] * W8_SCALE, s[5 * 33] * W8_SCALE, s[6 * 33] * W8_SCALE, s[7 * 33] * W8_SCALE);
            *(GAS v2u*)((unsigned char*)WT + (size_t)(n0 + n) * K + k0 + 8 * c) = o; }
        else { v4u o; o.x = pk2(s[0 * 33], s[1 * 33]); o.y = pk2(s[2 * 33], s[3 * 33]); o.z = pk2(s[4 * 33], s[5 * 33]); o.w = pk2(s[6 * 33], s[7 * 33]);
            *(GAS v4u*)(WT + (size_t)(n0 + n) * K + k0 + 8 * c) = o; } }
    LDS_WAIT(); asm volatile("" ::: "memory");
}
__device__ __forceinline__ void p0_weights(Frame& F) {
    LAS float* scr = (LAS float*)(F.lds + 32768 + F.wave * 8448);
    const int gw = blockIdx.x * NWAVES + F.wave, NGW = F.G * NWAVES;
    constexpr int I_INA = 16 * (N_INA / 32), I_INB = 16 * (N_INB / 32), I_OH = 8 * 32, I_OUT = 16 * 32, I_GU = 16 * (2 * DFF / 32), I_DN = (DFF / 64) * 32;
    constexpr int I_LAYER = I_INA + I_INB + 2 * I_OH + I_OUT + I_GU + I_DN;
    for (int it = gw; it < DEPTH * I_LAYER; it += NGW) {
        const int l = it / I_LAYER; int r = it % I_LAYER;
        bf16* wl = (bf16*)(F.ws + WS_W) + (size_t)l * W_LAYER;
        if (r < I_INA) { const int nblk = N_INA / 32; transpose_item(F.in[3] + (size_t)l * DM * INW, DM, INW, wl + W_INA, MAT_INA, F.in[2] + l * DM, scr, r / nblk, r % nblk, F.lane); continue; } r -= I_INA;
        if (r < I_INB) { const int nblk = N_INB / 32; transpose_item<true>(F.in[3] + (size_t)l * DM * INW, DM, INW, (bf16*)(F.ws + WS_W8 + (size_t)l * W8_LAYER), MAT_INB, F.in[2] + l * DM, scr, r / nblk, r % nblk, F.lane); continue; } r -= I_INB;
        if (r < I_OH) { transpose_item(F.in[9] + (size_t)l * 512 * DM, 512, DM, wl + W_O2, MAT_OHG, F.in[4] + l * HDIM, scr, r / 32, r % 32, F.lane, HDIM - 1); continue; }     r -= I_OH;
        if (r < I_OH) { transpose_item(F.in[10] + (size_t)l * 512 * DM, 512, DM, wl + W_O2 + (size_t)1024 * 512, MAT_ODN, F.in[8] + l * HDIM, scr, r / 32, r % 32, F.lane, HDIM - 1); continue; } r -= I_OH;
        if (r < I_OUT) { transpose_item(F.in[11] + (size_t)l * DM * DM, DM, DM, wl + W_OUT, MAT_OUT, nullptr, scr, r / 32, r % 32, F.lane); continue; } r -= I_OUT;
        if (r < I_GU) { const int nblk = 2 * DFF / 32; transpose_item(F.in[14] + (size_t)l * DM * 2 * DFF, DM, 2 * DFF, wl + W_GU, MAT_GU, F.in[13] + l * DM, scr, r / nblk, r % nblk, F.lane); continue; } r -= I_GU;
        transpose_item(F.in[15] + (size_t)l * DFF * DM, DFF, DM, wl + W_DN, MAT_DN, nullptr, scr, r / 32, r % 32, F.lane);
    }
}
__device__ __forceinline__ void wab_stage(Frame& F, int l) {
    __syncthreads();
    LAS float* W = (LAS float*)F.lds;
    const float* win = F.in[3] + (size_t)l * DM * INW + 4096; const float* gain = F.in[2] + l * DM;
#pragma unroll
    for (int i = 0; i < 2; ++i) { const int k = F.tid + 512 * i; const float g = gain[k];
        const f32x4 a = *(const GAS f32x4*)(win + (size_t)k * INW), c = *(const GAS f32x4*)(win + (size_t)k * INW + 4);
#pragma unroll
        for (int e = 0; e < 4; ++e) { W[e * 1024 + k] = a[e] * g; W[(4 + e) * 1024 + k] = c[e] * g; } }
    __syncthreads();
}
__device__ __forceinline__ void wab_row(Frame& F, const float* hn, int m) {
    const LAS float* W = (const LAS float*)F.lds;
    float r[8];
#pragma unroll
    for (int j = 0; j < 8; ++j) { const LAS f32x4* p = (const LAS f32x4*)(W + j * 1024) + 2 * F.lane; const f32x4 a = p[0], c = p[1], d = p[128], e = p[129];
        float s = 0.f;
#pragma unroll
        for (int t = 0; t < 4; ++t) s += hn[t] * a[t] + hn[4 + t] * c[t] + hn[8 + t] * d[t] + hn[12 + t] * e[t];
        r[j] = wave_sum(s); }
    if (F.lane == 0) { GAS f32x4* o = (GAS f32x4*)((float*)(F.ws + WS_AB) + (size_t)m * 8); o[0] = (f32x4){r[0], r[1], r[2], r[3]}; o[1] = (f32x4){r[4], r[5], r[6], r[7]}; }
}
__device__ __forceinline__ unsigned char* r8_row(Frame& F, int m) { return m < R8A_ROWS ? (unsigned char*)F.out + R8_OUT_OFF + (size_t)m * DM : F.ws + WS_R8B + (size_t)(m - R8A_ROWS) * DM; }
__device__ __forceinline__ void p0_row_load(f32x4 (&q)[4], Frame& F, int m) { const GAS f32x4* xr = (const GAS f32x4*)(F.in[0] + (size_t)m * DM) + 2 * F.lane; q[0] = xr[0]; q[1] = xr[1]; q[2] = xr[128]; q[3] = xr[129]; }
__device__ __forceinline__ void p0_row_finish(Frame& F, f32x4 (&cur)[4], int m, bf16* R, float* rstd) {
    float s = 0.f;
#pragma unroll
    for (int j = 0; j < 4; ++j) s += (cur[j].x * cur[j].x + cur[j].y * cur[j].y) + (cur[j].z * cur[j].z + cur[j].w * cur[j].w);
    const float rs = __builtin_amdgcn_rsqf(wave_sum(s) * (1.f / DM) + EPSF);
    if (F.lane == 0) rstd[m] = rs;
#pragma unroll
    for (int j = 0; j < 4; ++j) cur[j] = cur[j] * rs;
    { float hn[16];
#pragma unroll
      for (int j = 0; j < 4; ++j) { hn[4 * j] = cur[j].x; hn[4 * j + 1] = cur[j].y; hn[4 * j + 2] = cur[j].z; hn[4 * j + 3] = cur[j].w; }
      wab_row(F, hn, m); }
    GAS v4u* o8 = (GAS v4u*)(R + (size_t)m * DM) + F.lane;
    o8[0] = (v4u){pk2(cur[0].x, cur[0].y), pk2(cur[0].z, cur[0].w), pk2(cur[1].x, cur[1].y), pk2(cur[1].z, cur[1].w)};
    o8[64] = (v4u){pk2(cur[2].x, cur[2].y), pk2(cur[2].z, cur[2].w), pk2(cur[3].x, cur[3].y), pk2(cur[3].z, cur[3].w)};
    if (m < R8_ROWS) { GAS v2u* q8 = (GAS v2u*)r8_row(F, m) + F.lane;
        q8[0] = (v2u){pk8(cur[0].x, cur[0].y, cur[0].z, cur[0].w), pk8(cur[1].x, cur[1].y, cur[1].z, cur[1].w)};
        q8[64] = (v2u){pk8(cur[2].x, cur[2].y, cur[2].z, cur[2].w), pk8(cur[3].x, cur[3].y, cur[3].z, cur[3].w)}; }
}
__device__ __forceinline__ void p0_rows(Frame& F0) {
    Frame F = F0; asm volatile("" : "+v"(F.lane));
    const int gw = blockIdx.x * NWAVES + F.wave, NGW = F.G * NWAVES;
    bf16* R = (bf16*)(F.ws + WS_R); float* rstd = (float*)(F.ws + WS_RSTD);
    int m0 = gw;
    for (; m0 + 3 * NGW < MTOK; m0 += 4 * NGW) {
        f32x4 q[4][4];
#pragma unroll
        for (int u = 0; u < 4; ++u) p0_row_load(q[u], F, m0 + u * NGW);
#pragma unroll
        for (int u = 0; u < 4; ++u) p0_row_finish(F, q[u], m0 + u * NGW, R, rstd);
    }
    for (; m0 < MTOK; m0 += NGW) { f32x4 q1[4]; p0_row_load(q1, F, m0); p0_row_finish(F, q1, m0, R, rstd); }
}
struct RowRegs { v4u t[2]; v4u rb[2]; f32x4 rf[4]; float rs; };
template <bool RESID_F32>
__device__ __forceinline__ void row_load(RowRegs& a, const bf16* tin, const float* resid32, const bf16* R, const float* rs_in, int m, int lane) {
    const GAS v4u* tr = (const GAS v4u*)(tin + (size_t)m * DM) + lane; a.t[0] = tr[0]; a.t[1] = tr[64];
    if (RESID_F32) { const GAS f32x4* xr = (const GAS f32x4*)(resid32 + (size_t)m * DM) + 2 * lane; a.rf[0] = xr[0]; a.rf[1] = xr[1]; a.rf[2] = xr[128]; a.rf[3] = xr[129]; }
    else { const GAS v4u* rr = (const GAS v4u*)(R + (size_t)m * DM) + lane; a.rb[0] = rr[0]; a.rb[1] = rr[64]; int mv = m; asm volatile("" : "+v"(mv));
        a.rs = ((const GAS float*)rs_in)[mv]; }
}
__device__ __forceinline__ void unpack8(const v4u q, float* o) { o[0] = bflo(q.x); o[1] = bfhi(q.x); o[2] = bflo(q.y); o[3] = bfhi(q.y); o[4] = bflo(q.z); o[5] = bfhi(q.z); o[6] = bflo(q.w); o[7] = bfhi(q.w); }
template <bool RESID_F32, bool OUT_F32, bool WITH_AB>
__device__ __forceinline__ void row_finish(Frame& F, const RowRegs& cur, int m, const float (&wv)[16], float* out32, bf16* R, float* rstd) {
    float t[16], h[16];
    unpack8(cur.t[0], t); unpack8(cur.t[1], t + 8);
    if (RESID_F32) {
#pragma unroll
        for (int e = 0; e < 4; ++e) { h[e] = cur.rf[0][e]; h[4 + e] = cur.rf[1][e]; h[8 + e] = cur.rf[2][e]; h[12 + e] = cur.rf[3][e]; }
    } else { unpack8(cur.rb[0], h); unpack8(cur.rb[1], h + 8); const float ir = __builtin_amdgcn_rcpf(cur.rs);
#pragma unroll
        for (int e = 0; e < 16; ++e) h[e] *= ir; }
    float s = 0.f;
#pragma unroll
    for (int e = 0; e < 16; ++e) s += t[e] * t[e];
    const float r1 = __builtin_amdgcn_rsqf(wave_sum(s) * (1.f / DM) + EPSF);
    float s2 = 0.f;
#pragma unroll
    for (int e = 0; e < 16; ++e) { h[e] = h[e] + t[e] * r1 * wv[e]; s2 += h[e] * h[e]; }
    if (OUT_F32) {
        GAS f32x4* o = (GAS f32x4*)(out32 + (size_t)m * DM) + 2 * F.lane;
        o[0] = (f32x4){h[0], h[1], h[2], h[3]}; o[1] = (f32x4){h[4], h[5], h[6], h[7]}; o[128] = (f32x4){h[8], h[9], h[10], h[11]}; o[129] = (f32x4){h[12], h[13], h[14], h[15]};
    } else {
        const float rn = __builtin_amdgcn_rsqf(wave_sum(s2) * (1.f / DM) + EPSF);
        if (F.lane == 0) rstd[m] = rn;
#pragma unroll
        for (int e = 0; e < 16; ++e) h[e] *= rn;
        if (WITH_AB) wab_row(F, h, m);
        GAS v4u* o8 = (GAS v4u*)(R + (size_t)m * DM) + F.lane;
        o8[0] = (v4u){pk2(h[0], h[1]), pk2(h[2], h[3]), pk2(h[4], h[5]), pk2(h[6], h[7])};
        o8[64] = (v4u){pk2(h[8], h[9]), pk2(h[10], h[11]), pk2(h[12], h[13]), pk2(h[14], h[15])};
        if (WITH_AB && m < R8_ROWS) { GAS v2u* q8 = (GAS v2u*)r8_row(F, m) + F.lane;
            q8[0] = (v2u){pk8(h[0], h[1], h[2], h[3]), pk8(h[4], h[5], h[6], h[7])}; q8[64] = (v2u){pk8(h[8], h[9], h[10], h[11]), pk8(h[12], h[13], h[14], h[15])}; }
    }
}
template <bool RESID_F32, bool OUT_F32, bool WITH_AB = false>
__device__ __forceinline__ void rowpass(Frame& F0, const bf16* tin, const float* resid32, const float* w, float* out32, int rs_sel, int gw, int NGW, int MEND) {
    Frame F = F0; asm volatile("" : "+v"(F.lane));
    bf16* R = (bf16*)(F.ws + WS_R); const float* rs_in = (const float*)(F.ws + WS_RSTD) + (size_t)rs_sel * MTOK; float* rstd = (float*)(F.ws + WS_RSTD) + (size_t)(rs_sel ^ 1) * MTOK;
    float wv[16];
    { const GAS f32x4* wp = (const GAS f32x4*)w + 2 * F.lane; const f32x4 a = wp[0], b = wp[1], c = wp[128], d = wp[129];
#pragma unroll
      for (int e = 0; e < 4; ++e) { wv[e] = a[e]; wv[4 + e] = b[e]; wv[8 + e] = c[e]; wv[12 + e] = d[e]; } }
    int m0 = gw;
    for (; m0 + 3 * NGW < MEND; m0 += 4 * NGW) {
        RowRegs r[4];
#pragma unroll
        for (int u = 0; u < 4; ++u) row_load<RESID_F32>(r[u], tin, resid32, R, rs_in, m0 + u * NGW, F.lane);
#pragma unroll
        for (int u = 0; u < 4; ++u) row_finish<RESID_F32, OUT_F32, WITH_AB>(F, r[u], m0 + u * NGW, wv, out32, R, rstd);
    }
    for (; m0 < MEND; m0 += NGW) { RowRegs r1; row_load<RESID_F32>(r1, tin, resid32, R, rs_in, m0, F.lane); row_finish<RESID_F32, OUT_F32, WITH_AB>(F, r1, m0, wv, out32, R, rstd); }
}
__device__ __forceinline__ void panel_rendezvous(Frame& F, gu32* cnt) {
    if (F.tid == 0) {
        __hip_atomic_fetch_add(cnt, 1u, RLX_AGENT);
        const unsigned long long t0 = __builtin_amdgcn_s_memrealtime();
        while (__hip_atomic_load(cnt, RLX_AGENT) < 4u) {
            if (__builtin_amdgcn_s_memrealtime() - t0 > 2000000ull) { __hip_atomic_store(F.ctl + 0, 1u, RLX_AGENT); break; }
            __builtin_amdgcn_s_sleep(2); }
        __builtin_amdgcn_fence(__ATOMIC_ACQUIRE, "agent");
        asm volatile("s_waitcnt vmcnt(0)" ::: "memory");
    }
    __syncthreads();
}
__device__ __forceinline__ void post_phase(Frame& F, int l) {
    const int gw = blockIdx.x * NWAVES + F.wave, NGW = F.G * NWAVES;
    const bf16* oraw = (const bf16*)(F.ws + WS_ORAW); bf16* ocat = (bf16*)((unsigned char*)F.out + 128 * MiB);
    const bf16* planes = (const bf16*)(F.ws + WS_P);
    const int d0 = (8 * F.lane) & 127;
#pragma unroll
    for (int br = 0; br < 2; ++br) {
        float nw[8];
#pragma unroll
        for (int j = 0; j < 8; ++j) nw[j] = (br ? F.in[8] : F.in[4])[l * HDIM + d0 + j];
        const bf16* op = oraw + (size_t)br * PLANE; const bf16* gp = planes + (size_t)(br ? 7 : 6) * PLANE;   bf16* cp = ocat + (size_t)br * PLANE;
        for (int m0 = gw; m0 < MTOK; m0 += 4 * NGW) {
            v4u ov[4], gv[4];
#pragma unroll
            for (int u = 0; u < 4; ++u) { const int m = m0 + u * NGW; if (m < MTOK) { ov[u] = *(const GAS v4u*)(op + (size_t)m * 512 + 8 * F.lane); gv[u] = *(const GAS v4u*)(gp + (size_t)m * 512 + 8 * F.lane); } }
#pragma unroll
            for (int u = 0; u < 4; ++u) { const int m = m0 + u * NGW; if (m < MTOK) {
                const float o[8] = {bflo(ov[u].x), bfhi(ov[u].x), bflo(ov[u].y), bfhi(ov[u].y), bflo(ov[u].z), bfhi(ov[u].z), bflo(ov[u].w), bfhi(ov[u].w)};
                const float g[8] = {bflo(gv[u].x), bfhi(gv[u].x), bflo(gv[u].y), bfhi(gv[u].y), bflo(gv[u].z), bfhi(gv[u].z), bflo(gv[u].w), bfhi(gv[u].w)};
                float s = 0.f;
#pragma unroll
                for (int j = 0; j < 8; ++j) s += o[j] * o[j];
                s += __builtin_bit_cast(float, __builtin_amdgcn_update_dpp(0, __builtin_bit_cast(int, s), 0xB1, 0xF, 0xF, true));
                s += __builtin_bit_cast(float, __builtin_amdgcn_update_dpp(0, __builtin_bit_cast(int, s), 0x4E, 0xF, 0xF, true));
                s += __builtin_bit_cast(float, __builtin_amdgcn_update_dpp(0, __builtin_bit_cast(int, s), 0x141, 0xF, 0xF, true));
                s += __builtin_bit_cast(float, __builtin_amdgcn_update_dpp(0, __builtin_bit_cast(int, s), 0x140, 0xF, 0xF, true));
                const float rs = __builtin_amdgcn_rsqf(s * (1.f / HDIM) + EPSF);
                float r[8];
#pragma unroll
                for (int j = 0; j < 8; ++j) r[j] = o[j] * rs * nw[j] * (g[j] * sigmf(g[j]));
                v4u w; w.x = pk2(r[0], r[1]); w.y = pk2(r[2], r[3]); w.z = pk2(r[4], r[5]); w.w = pk2(r[6], r[7]);
                *(GAS v4u*)(cp + (size_t)m * 512 + 8 * F.lane) = w; } }
        }
    }
}

#ifndef DUP_MASK
#define DUP_MASK 0
#endif
#define REP(k) _Pragma("unroll") for (int rep_ = 0; rep_ < (((DUP_MASK >> (k)) & 1) ? 2 : 1); ++rep_)
#define IN(k) (lo <= (k) && (k) < hi)
#ifndef DOUBLE_BAR
#define DOUBLE_BAR 0
#endif
#define SEAM(k) do { if (IN(k) && IN((k) + 1)) { xcd_barrier(bar); if (DOUBLE_BAR) xcd_barrier(bar); } } while (0)
#ifndef SPLIT_WGM
#define SPLIT_WGM 4
#endif
#ifndef G2_ALIGN
#define G2_ALIGN true
#endif
#ifndef GA_HG
#define GA_HG 1
#endif
#ifndef GA_DN
#define GA_DN 1
#endif
template <int l> __device__ __forceinline__ void layer_phases(Frame& F, const XcdBarrier& bar, const int lo, const int hi) {
        const int pb = 1 + 11 * l;
        const pg8::bf16_t* wl = (const pg8::bf16_t*)(F.ws + WS_W) + (size_t)l * W_LAYER;
        pg8::bf16_t* Rb = (pg8::bf16_t*)(F.ws + WS_R);
        REP(0) if (IN(pb + 0)) {
            pg8::Gemm g{Rb, wl + W_INA, MTOK, N_INA, DM}; pg8::StaticOrder S; S.init(MTOK, N_INA, F.G, (int)blockIdx.x);
            pg8::EpiProjA E{(pg8::bf16_t*)(F.ws + WS_P), PLANE};
            pg8::gemm_phase<pg8::EpiProjA, pg8::StaticOrder, PG8_ALIGN, PG8_SP2>(F.lds, g, S, E);
        }
        SEAM(pb + 0);
        REP(1) if (IN(pb + 1)) {
            { int u = blockIdx.x;
              if (u < NUNIT) { hg_dma_issue(F, u, F.lane); asm volatile("s_waitcnt vmcnt(0)" ::: "memory"); }
              __syncthreads();
              HgConst hc; hc.lb[0] = hc.lb[1] = 0.f;
              if (l == 1) { const int h0 = blockIdx.x & 3, d0 = 2 * F.lane; hc.lb[0] = sigmf(F.in[1][512 + 128 * h0 + d0] - F.in[1][128 * h0 + d0]); hc.lb[1] = sigmf(F.in[1][512 + 128 * h0 + d0 + 1] - F.in[1][128 * h0 + d0 + 1]); }
              for (; u < NUNIT; u += F.G) prep_hg_unit(F, l, u, u + F.G < NUNIT ? u + F.G : -1, hc); }
            { DnConst dc; { const int h0 = blockIdx.x & 3, d0 = 2 * F.lane; dc.na = -__expf(F.in[6][l * NHEAD + h0]); dc.dtb = F.in[7][l * NHEAD + h0];
                  const float* cw = F.in[5] + (size_t)l * CONVW * CONVC + 128 * h0 + d0;
#pragma unroll
                  for (int j = 0; j < 4; ++j) { dc.cwq[j][0] = cw[j * CONVC]; dc.cwq[j][1] = cw[j * CONVC + 1]; dc.cwk[j][0] = cw[j * CONVC + 512]; dc.cwk[j][1] = cw[j * CONVC + 513]; dc.cwv[j][0] = cw[j * CONVC + 1024]; dc.cwv[j][1] = cw[j * CONVC + 1025]; } }
              DnRaw ra, rb; int u = blockIdx.x; if (u < NUNIT) dn_raw_load(ra, F, u, F.tid, F.lane);
              for (; u < NUNIT; u += 2 * F.G) {
                  if (u + F.G < NUNIT) dn_raw_load(rb, F, u + F.G, F.tid, F.lane);
                  prep_dn_unit(F, l, u, ra, dc);
                  if (u + F.G < NUNIT) { if (u + 2 * F.G < NUNIT) dn_raw_load(ra, F, u + 2 * F.G, F.tid, F.lane); prep_dn_unit(F, l, u + F.G, rb, dc); } } }
        }
        SEAM(pb + 1);
        if (IN(pb + 1) && IN(pb + 2)) {
            const bf16* R = (const bf16*)(F.ws + WS_R); int lane = F.lane; asm volatile("" : "+v"(lane));
            for (int m = R8_ROWS + blockIdx.x * NWAVES + F.wave; m < MTOK; m += F.G * NWAVES) {
                const GAS v4u* rr = (const GAS v4u*)(R + (size_t)m * DM) + lane; const v4u a = rr[0], c = rr[64];
                GAS v2u* q8 = (GAS v2u*)(F.ws + WS_R8C + (size_t)(m - R8_ROWS) * DM) + lane;
                q8[0] = (v2u){pk8(bflo(a.x), bfhi(a.x), bflo(a.y), bfhi(a.y)), pk8(bflo(a.z), bfhi(a.z), bflo(a.w), bfhi(a.w))};
                q8[64] = (v2u){pk8(bflo(c.x), bfhi(c.x), bflo(c.y), bfhi(c.y)), pk8(bflo(c.z), bfhi(c.z), bflo(c.w), bfhi(c.w))}; }
            xcd_barrier(bar);
        }
        REP(2) if (IN(pb + 2)) {
            const int bid = blockIdx.x; const bool grpA = (bid & 8) == 0; const int j = (bid & 7) | ((bid >> 4) << 3);
            if (F.G == 256) {
                if (grpA) { const int grp = (bid >> 5) * 8 + (bid & 7), sl0 = ((bid >> 4) & 1) * 2;
#ifdef USE_SCAN2R
                    if (grp < 32) scan2r_hg(F, grp, sl0); else scan2r_dn(F, grp - 32, sl0); }
#else
#ifdef PROBE_CHAIN
                    const long long w0_ = wall_clock64();
#endif
                    if (grp < 32) scan_hg_chain(F, grp, sl0); else scan_dn_chain(F, grp - 32, sl0);
#ifdef PROBE_CHAIN
                    if (bid == PROBE_CHAIN && F.tid == 0) { const long long dw = wall_clock64() - w0_; const long long t_ = wall_clock64(); while (wall_clock64() - t_ < dw) __builtin_amdgcn_s_sleep(8); }
                    __syncthreads();
#endif
                    }
#endif

                constexpr int NT = MTOK / 256, B_TILES = NT - 8 * (GA_HG + GA_DN), B_ROUNDS = B_TILES / 16; static_assert(B_TILES >= 0 && B_TILES % 16 == 0, "group B takes whole rounds");
                pg8::Gemm g8{(const pg8::bf16_t*)((unsigned char*)F.out + R8_OUT_OFF), (const pg8::bf16_t*)(F.ws + WS_W8 + (size_t)l * W8_LAYER), MTOK, N_INB, DM / 2,
                             (const pg8::bf16_t*)(F.ws + WS_R8B - (size_t)R8A_ROWS * DM), R8A_TILES, (const pg8::bf16_t*)(F.ws + WS_R8C - (size_t)R8_ROWS * DM), R8_TILES};
                const bool hgw = j < 64;
                pg8::GateOrder S8{grpA ? (hgw ? B_TILES : B_TILES + 8 * GA_HG) : 0, 0, grpA ? (hgw ? GA_HG : GA_DN) : B_ROUNDS, j & 7, grpA ? ((j >> 3) & 7) : (j >> 3), grpA ? 1 : 0};
                pg8::EpiGate E8{F.ws + WS_GATES, (size_t)MTOK * DM, 1.f / W8_SCALE};
                pg8::gemm_phase<pg8::EpiGate, pg8::GateOrder, PG8_ALIGN, PG8_SP2, true>(F.lds, g8, S8, E8);
            }
        }
        SEAM(pb + 2);
        REP(5) if (IN(pb + 5)) {
            pg8::Gemm g{(const pg8::bf16_t*)(F.ws + WS_ORAW), wl + W_O2, 2 * MTOK, 2048, 512};
            pg8::PairOrder S; S.so.init(MTOK, DM, F.G, (int)blockIdx.x);
            pg8::EpiMerge E{(pg8::bf16_t*)((unsigned char*)F.out + 128 * MiB)  , (const unsigned char*)(F.ws + WS_GATES), (size_t)MTOK * DM, (const pg8::bf16_t*)(F.ws + WS_SUMS), nullptr, 0};
            pg8::gemm_phase<pg8::EpiMerge, pg8::PairOrder, G2_ALIGN, PG8_SP2>(F.lds, g, S, E);
        }
        SEAM(pb + 5);
        REP(6) if (IN(pb + 6)) {
            pg8::Gemm g{(const pg8::bf16_t*)((unsigned char*)F.out + 128 * MiB), wl + W_OUT, MTOK, DM, DM}; pg8::StaticOrder S; S.init(MTOK, DM, F.G, (int)blockIdx.x);
            pg8::EpiBf16<0> E{(pg8::bf16_t*)(F.ws + WS_MIX), DM, nullptr, 0, 0, 1.f};
            pg8::gemm_phase<pg8::EpiBf16<0>, pg8::StaticOrder, PG8_ALIGN, PG8_SP2>(F.lds, g, S, E);
        }
        SEAM(pb + 6);
        REP(7) if (IN(pb + 7)) {
#ifdef PROBE_CLK_EW
            const long long c0_ = clock64(), w0_ = wall_clock64();
#endif
            const int gw = blockIdx.x * NWAVES + F.wave, NGW = F.G * NWAVES;
            rowpass<false, false>(F, (const bf16*)(F.ws + WS_MIX), nullptr, F.in[12] + l * DM, nullptr, 0, gw, NGW, MTOK);
#ifdef PROBE_CLK_EW
            if (blockIdx.x == 0 && F.tid == 0) { const long long dc = clock64() - c0_, dw = wall_clock64() - w0_;
                const long long spin = (dc * 50 / dw - 500) * 100; const long long t_ = wall_clock64(); while (wall_clock64() - t_ < spin) __builtin_amdgcn_s_sleep(8); }
#endif
        }
        SEAM(pb + 7);
        REP(8) if (IN(pb + 8)) {
            pg8::Gemm g{Rb, wl + W_GU, MTOK, 2 * DFF, DM}; pg8::StaticOrder S; S.init(MTOK, 2 * DFF, F.G, (int)blockIdx.x);
            pg8::EpiSwiGLU E{(pg8::bf16_t*)(F.ws + WS_ACT)};
            pg8::gemm_phase<pg8::EpiSwiGLU, pg8::StaticOrder, PG8_ALIGN, PG8_SP2>(F.lds, g, S, E);
        }
        SEAM(pb + 8);
        REP(9) if (IN(pb + 9)) {
#ifdef PROBE_CLK
            const long long c0_ = clock64(), w0_ = wall_clock64();
#endif
            pg8::Gemm g{(const pg8::bf16_t*)(F.ws + WS_ACT), wl + W_DN, MTOK, DM, DFF}; pg8::StaticOrder S; S.init(MTOK, DM, F.G, (int)blockIdx.x);
            pg8::EpiBf16<0> E{(pg8::bf16_t*)(F.ws + WS_F), DM, nullptr, 0, 0, 1.f};
            pg8::gemm_phase<pg8::EpiBf16<0>, pg8::StaticOrder, PG8_ALIGN, PG8_SP2>(F.lds, g, S, E);
#ifdef PROBE_CLK
            if (blockIdx.x == 0 && F.tid == 0) { const long long dc = clock64() - c0_, dw = wall_clock64() - w0_;
                const long long spin = (dc * 50 / dw - 500) * 100; const long long t_ = wall_clock64(); while (wall_clock64() - t_ < spin) __builtin_amdgcn_s_sleep(8); }
#endif
        }
        SEAM(pb + 9);
        REP(10) if (IN(pb + 10)) {
            const int gw = blockIdx.x * NWAVES + F.wave, NGW = F.G * NWAVES;
            if (l == DEPTH - 1) rowpass<false, true>(F, (const bf16*)(F.ws + WS_F), nullptr, F.in[16] + l * DM, F.out, 1, gw, NGW, MTOK);
            else { wab_stage(F, l + 1); rowpass<false, false, true>(F, (const bf16*)(F.ws + WS_F), nullptr, F.in[16] + l * DM, nullptr, 1, gw, NGW, MTOK); }
        }
        if (l + 1 < DEPTH) SEAM(pb + 10);
    }
#undef IN
#undef SEAM
struct Args { const float* in[17]; float* out; unsigned char* ws; int ph_lo, ph_hi; };
static_assert(sizeof(Args) == 17 * 8 + 8 + 8 + 8, "Args has no padding");
__global__ void __launch_bounds__(NWAVES * 64, 2) hybrid_fwd(Args args) {
    extern __shared__ __attribute__((aligned(16))) unsigned char lds[];
    Frame F;
    F.lds = (LAS unsigned char*)lds;
    F.MISC = (volatile LAS unsigned*)(F.lds + MISC_OFF);
    F.tid = threadIdx.x; F.lane = F.tid & 63; F.wave = __builtin_amdgcn_readfirstlane(F.tid >> 6);
    F.G = gridDim.x;
    F.ws = args.ws; F.out = args.out; F.ctl = (gu32*)(args.ws + WS_CTL);
#pragma unroll
    for (int i = 0; i < 17; ++i) F.in[i] = args.in[i];
    for (int u = F.tid; u < (LDS_BYTES - MISC_OFF) / 4; u += NWAVES * 64) ((LAS unsigned*)(F.lds + MISC_OFF))[u] = 0u;
    __syncthreads();
    const int lo = args.ph_lo, hi = args.ph_hi;
    XcdBarrier bar; bar.bar = (unsigned*)(F.ctl + CW_BAR); bar.x = 0; bar.st = nullptr;
    if (hi - lo > 1) bar = xcd_barrier_post((unsigned*)(F.ctl + CW_BAR), F.MISC + 8);
#define IN(k) (lo <= (k) && (k) < hi)
#ifndef DOUBLE_BAR
#define DOUBLE_BAR 0
#endif
#define SEAM(k) do { if (IN(k) && IN((k) + 1)) { xcd_barrier(bar); if (DOUBLE_BAR) xcd_barrier(bar); } } while (0)

#ifndef NO_P0
    if (IN(0)) { wab_stage(F, 0);
        if (F.wave & 1) { p0_weights(F); p0_rows(F); } else { p0_rows(F); p0_weights(F); } }
#endif
#ifdef PROBE_XCC
    if (IN(0)) {
        if (F.tid == 0) __hip_atomic_store(F.ctl + 8192 + blockIdx.x, 1u + ((unsigned)__builtin_amdgcn_s_getreg((3 << 11) | 20) & 0xFu), RLX_AGENT);
    }
#endif
#ifdef PROBE_MFMA
    if (IN(0)) {
        typedef short bfx8 __attribute__((ext_vector_type(8)));
        bfx8 a, b; for (int e = 0; e < 8; ++e) { a[e] = (short)(0x3c00 + F.lane + e); b[e] = (short)(0x3b80 + 2 * F.lane + e); }
        asm volatile("" : "+v"(a), "+v"(b));
#if PROBE_MFMA == 16
        f32x4 c[8]; for (int i = 0; i < 8; ++i) c[i] = (f32x4){0.f, 0.f, 0.f, 0.f};
        for (int it = 0; it < 2500; ++it) {
#pragma unroll
            for (int i = 0; i < 8; ++i) c[i] = __builtin_amdgcn_mfma_f32_16x16x32_bf16(a, b, c[i], 0, 0, 0);
        }
        float sum = 0.f; for (int i = 0; i < 8; ++i) sum += c[i][0] + c[i][1] + c[i][2] + c[i][3];
#else
        typedef float f32x16_ __attribute__((ext_vector_type(16)));
        f32x16_ c[4]; for (int i = 0; i < 4; ++i) for (int e = 0; e < 16; ++e) c[i][e] = 0.f;
        for (int it = 0; it < 2500; ++it) {
#pragma unroll
            for (int i = 0; i < 4; ++i) c[i] = __builtin_amdgcn_mfma_f32_32x32x16_bf16(a, b, c[i], 0, 0, 0);
        }
        float sum = 0.f; for (int i = 0; i < 4; ++i) for (int e = 0; e < 16; ++e) sum += c[i][e];
#endif
        if (sum == 12345.678f) __hip_atomic_store(F.ctl + 100, 1u, RLX_AGENT);
    }
#endif
    SEAM(0);
#ifdef PROBE_XCC
    if (blockIdx.x == 0 && F.tid == 0) { int bad = 0;
        for (int i = 0; i < (int)gridDim.x; ++i) bad += __hip_atomic_load(F.ctl + 8192 + i, RLX_AGENT) != __hip_atomic_load(F.ctl + 8192 + (i & 7), RLX_AGENT);
        const long long t_ = wall_clock64(); while (wall_clock64() - t_ < 200ll * bad) __builtin_amdgcn_s_sleep(8); }
#endif

    layer_phases<0>(F, bar, lo, hi);
    layer_phases<1>(F, bar, lo, hi);
#undef IN
#undef SEAM
}

extern "C" void kernel_launch(void* const* d_in, const int* in_sizes, int n_in, void* d_out, int out_size, void* d_ws, size_t ws_size, hipStream_t stream) {
    static int grid = 0;
    if (grid == 0) {
        if (n_in != 17 || in_sizes[0] != MTOK * DM || out_size != MTOK * DM || ws_size < WS_END) {
            fprintf(stderr, "kernel_launch: unexpected shapes: n_in %d in0 %d out %d ws %zu (need %zu)\n", n_in, n_in > 0 ? in_sizes[0] : -1, out_size, ws_size, (size_t)WS_END); grid = -1; return; }
        int dev = 0, cus = 0, per_cu = 0;
        if (hipGetDevice(&dev) != hipSuccess || hipDeviceGetAttribute(&cus, hipDeviceAttributeMultiprocessorCount, dev) != hipSuccess) { grid = -1; return; }
        if (hipFuncSetAttribute((const void*)hybrid_fwd, hipFuncAttributeMaxDynamicSharedMemorySize, LDS_BYTES) != hipSuccess) { fprintf(stderr, "kernel_launch: hipFuncSetAttribute failed\n"); grid = -1; return; }
        if (hipOccupancyMaxActiveBlocksPerMultiprocessor(&per_cu, (const void*)hybrid_fwd, NWAVES * 64, LDS_BYTES) != hipSuccess || per_cu < 1)
            fprintf(stderr, "kernel_launch: note: occupancy query reports %d workgroups per CU\n", per_cu);
        (void)hipGetLastError();
        grid = cus;
    }
    if (grid < 0) return;
    if (hipMemsetAsync((char*)d_ws + WS_CTL, 0, CTL_ZERO_BYTES, stream) != hipSuccess) return;
    Args a{};
    for (int i = 0; i < 17; ++i) a.in[i] = (const float*)d_in[i];
    a.out = (float*)d_out; a.ws = (unsigned char*)d_ws;
#if MK_ONE_LAUNCH
    a.ph_lo = 0; a.ph_hi = N_PHASES;
    hipLaunchKernelGGL(hybrid_fwd, dim3(grid), dim3(NWAVES * 64), LDS_BYTES, stream, a);
#else
    for (int p = 0; p < N_PHASES; ++p) {
        a.ph_lo = p; a.ph_hi = p + 1;
        hipLaunchKernelGGL(hybrid_fwd, dim3(grid), dim3(NWAVES * 64), LDS_BYTES, stream, a);
    }
#endif
}
```

```cpp
#include <hip/hip_runtime.h>
#include <cstdio>
#include <cstdint>

constexpr int DM = 1024, BATCH = 8, SEQ = 8192, MTOK = BATCH * SEQ, DEPTH = 2;
constexpr int NHEAD = 4, HDIM = 128, HWID = 512;
constexpr int DFF = 2816, INW = 6152;
constexpr int N_INA = 4096;
constexpr int N_INB = 2048;
constexpr int CONVW = 4, CONVC = 1536;
constexpr float EPSF = 1e-6f;
#define MK_ONE_LAUNCH 1
#define HELPERS_LOAD 1
namespace pg8 {
#define PG8_LAS __attribute__((address_space(3)))
typedef unsigned short bf16_t;
typedef short bf16x8 __attribute__((ext_vector_type(8)));
typedef float f32x4 __attribute__((ext_vector_type(4)));
typedef unsigned u32x4 __attribute__((ext_vector_type(4)));
typedef int i32x4_ __attribute__((ext_vector_type(4)));
typedef int i32x8_ __attribute__((ext_vector_type(8)));
template <bool C, class A, class B> struct sel_ { using type = A; };
template <class A, class B> struct sel_<false, A, B> { using type = B; };
constexpr int BM = 256, BK = 64, HALF = 128, HTB = HALF * BK * 2  , STAGE_BYTES = 8 * HTB, NXCD = 8, WGM = 8;

__host__ __device__ __forceinline__ int lds_byte(int r, int c) { const int st = (r >> 4) * 2 + (c >> 5), rr = r & 15, cc = c & 31, ob = rr * 64 + cc * 2; return st * 1024 + (ob ^ (((ob >> 9) & 1) << 5)); }
__host__ __device__ __forceinline__ void stage_rc(int b, int& R, int& C) { const int st = b / 1024, sb = b % 1024, swz = sb ^ (((sb >> 9) & 1) << 5); R = (st >> 1) * 16 + swz / 64; C = (st & 1) * 32 + (swz % 64) / 2; }
__host__ __device__ __forceinline__ int perm32(int rho) { const int n = rho >> 4, i = rho & 15; return 8 * (i >> 2) + 4 * n + (i & 3); }

struct Unit { int pm, pn; };
struct Gemm { const bf16_t* A; const bf16_t* Bt; int M, N, K; const bf16_t* A2 = nullptr; int pm2 = 1 << 30; const bf16_t* A3 = nullptr; int pm3 = 1 << 30; };

struct StaticOrder {
    int nM, nN, nwg, G, c;
    __host__ __device__ void init(int M, int N, int G_, int c_) { nM = M / BM; nN = N / BM; nwg = nM * nN; G = G_; c = c_; }
    __host__ __device__ bool next(int i, Unit& u) const {
        const long L = (long)i * G + c; if (L >= nwg) return false;
        int wgid = (int)L; { const int q = nwg / NXCD, r = nwg % NXCD, xcd = wgid % NXCD, off = wgid / NXCD; wgid = (xcd < r ? xcd * (q + 1) : r * (q + 1) + (xcd - r) * q) + off; }
        const int nig = WGM * nN, gid = wgid / nig, fm = gid * WGM, gsz = (nM - fm) < WGM ? (nM - fm) : WGM;
        u.pm = fm + ((wgid % nig) % gsz); u.pn = (wgid % nig) / gsz; return true;
    }
    __device__ __forceinline__ void a_ready(const Unit&) const {}
    __device__ __forceinline__ void done(const Unit&) const {}
};

__device__ __forceinline__ unsigned cvt_pk_bf16(float lo, float hi) { unsigned r; asm volatile("v_cvt_pk_bf16_f32 %0, %1, %2" : "=v"(r) : "v"(lo), "v"(hi)); return r; }
typedef float f32x2 __attribute__((ext_vector_type(2)));
__device__ __forceinline__ f32x2 gelu_pk(f32x2 v) {
    const f32x2 av = __builtin_elementwise_abs(v), d = av * 0.2316418882f + 1.0f;
    f32x2 t; t.x = __builtin_amdgcn_rcpf(d.x); t.y = __builtin_amdgcn_rcpf(d.y);
    f32x2 q = t * 0.5307027145f + (-0.7265760135f); q = q * t + 0.7107068705f; q = q * t + (-0.142248368f); q = q * t + 0.127414796f; q = q * t;
    const f32x2 s = (v * v) * (-0.72134752044f);
    f32x2 e; e.x = __builtin_amdgcn_exp2f(s.x); e.y = __builtin_amdgcn_exp2f(s.y);
    const f32x2 m = v * (q * e), r = v - m;
    f32x2 o; o.x = v.x < 0.f ? m.x : r.x; o.y = v.y < 0.f ? m.y : r.y; return o;
}

template <int ACT  > struct EpiBf16 {
    static constexpr bool PERM = true, AFTER_DRAIN = false, HOOK = false; static_assert(ACT == 0 || ACT == 1, "EpiBf16: ACT is 0 (none) or 1 (gelu_pk)");
    bf16_t* O; int ldc; const float* bias; int split_cols; size_t split_stride; float scale0;
    __device__ __forceinline__ void operator()(const f32x4 (&acc)[2][2][4][2], const Unit& u, int wr, int wc, int fr, int fq) const {
        const int row0 = u.pm * BM + wr * 64 + fr; int colt = u.pn * BM; bf16_t* base = O;
        float sc = 1.f; if (split_cols) { const int t = colt / split_cols; base += (size_t)t * split_stride; colt -= t * split_cols; if (t == 0) sc = scale0; }
        const int col0 = colt + wc * 32 + 8 * fq, bcol0 = u.pn * BM + wc * 32 + 8 * fq;
        f32x4 bv[2][2];
#pragma unroll
        for (int bj = 0; bj < 2; ++bj)
#pragma unroll
            for (int n = 0; n < 2; ++n) bv[bj][n] = bias ? *(const f32x4*)(bias + bcol0 + bj * HALF + 4 * n) : (f32x4){0.f, 0.f, 0.f, 0.f};
#pragma unroll
        for (int ai = 0; ai < 2; ++ai)
#pragma unroll
            for (int m = 0; m < 4; ++m) { bf16_t* rowp = base + (size_t)(row0 + ai * HALF + m * 16) * ldc + col0;
#pragma unroll
                for (int bj = 0; bj < 2; ++bj) { f32x4 v0 = acc[ai][bj][m][0] + bv[bj][0], v1 = acc[ai][bj][m][1] + bv[bj][1];
                    if (ACT == 1) { f32x2 a = gelu_pk((f32x2){v0[0], v0[1]}), b = gelu_pk((f32x2){v0[2], v0[3]}), c = gelu_pk((f32x2){v1[0], v1[1]}), d = gelu_pk((f32x2){v1[2], v1[3]});
                        v0 = (f32x4){a.x, a.y, b.x, b.y}; v1 = (f32x4){c.x, c.y, d.x, d.y}; }
                    v0 = v0 * sc; v1 = v1 * sc; u32x4 w; w.x = cvt_pk_bf16(v0[0], v0[1]); w.y = cvt_pk_bf16(v0[2], v0[3]); w.z = cvt_pk_bf16(v1[0], v1[1]); w.w = cvt_pk_bf16(v1[2], v1[3]);
                    *(u32x4*)(rowp + bj * HALF) = w; } }
    }
};
__device__ __forceinline__ float bf_lo(unsigned w) { return __builtin_bit_cast(float, w << 16); }
__device__ __forceinline__ float bf_hi(unsigned w) { return __builtin_bit_cast(float, w & 0xffff0000u); }
__device__ __forceinline__ float sigm(float x) { return __builtin_amdgcn_rcpf(1.f + __expf(-x)); }
typedef __bf16 bfp2 __attribute__((ext_vector_type(2)));
__device__ __forceinline__ unsigned pkv(float lo, float hi) { f32x2 v = {lo, hi}; bfp2 r = __builtin_convertvector(v, bfp2); return __builtin_bit_cast(unsigned, r); }

struct EpiProjA {
    static constexpr bool PERM = true, AFTER_DRAIN = false, HOOK = false;
    bf16_t* planes; size_t plane_stride;
    __device__ __forceinline__ void operator()(const f32x4 (&acc)[2][2][4][2], const Unit& u, int wr, int wc, int fr, int fq) const {
        const int row0 = u.pm * BM + wr * 64 + fr;
        {
            const int pl = u.pn >> 1, slot = pl == 3 ? 6 : (pl == 6 ? 3 : pl); const bool gate = pl == 3 || pl == 7;
            bf16_t* base = planes + (size_t)slot * plane_stride;
            const int col0 = (u.pn & 1) * 256 + wc * 32 + 8 * fq;
#pragma unroll
            for (int ai = 0; ai < 2; ++ai)
#pragma unroll
                for (int m = 0; m < 4; ++m) { const int row = row0 + ai * HALF + m * 16; bf16_t* rowp = base + (size_t)row * 512 + col0;
#pragma unroll
                    for (int bj = 0; bj < 2; ++bj) { f32x4 v0 = acc[ai][bj][m][0], v1 = acc[ai][bj][m][1];
                        if (gate) {
#pragma unroll
                            for (int e = 0; e < 4; ++e) { v0[e] *= sigm(v0[e]); v1[e] *= sigm(v1[e]); } }
                        u32x4 w; w.x = pkv(v0[0], v0[1]); w.y = pkv(v0[2], v0[3]); w.z = pkv(v1[0], v1[1]); w.w = pkv(v1[2], v1[3]);
                        *(u32x4*)(rowp + bj * HALF) = w; } }
        }
    }
};
struct EpiGate {
    static constexpr bool PERM = true, AFTER_DRAIN = false, HOOK = false;
    unsigned char* gates; size_t plane_stride; float sc;
    __device__ __forceinline__ void operator()(const f32x4 (&acc)[2][2][4][2], const Unit& u, int wr, int wc, int fr, int fq) const {
        const int row0 = u.pm * BM + wr * 64 + fr;
        unsigned char* base = gates + (size_t)(u.pn >> 2) * plane_stride;
        const int col0 = (u.pn & 3) * 256 + wc * 32 + 8 * fq;
#pragma unroll
        for (int ai = 0; ai < 2; ++ai)
#pragma unroll
            for (int m = 0; m < 4; ++m) { const int row = row0 + ai * HALF + m * 16; unsigned char* rowp = base + (size_t)row * 1024 + col0;
#pragma unroll
                for (int bj = 0; bj < 2; ++bj) { f32x4 v0 = acc[ai][bj][m][0], v1 = acc[ai][bj][m][1]; unsigned q[8];
#pragma unroll
                    for (int e = 0; e < 4; ++e) { q[e] = (unsigned)fmaxf(sigm(v0[e] * sc) * 255.f + 0.5f, 1.f); q[4 + e] = (unsigned)fmaxf(sigm(v1[e] * sc) * 255.f + 0.5f, 1.f);     }
                    f32x2 w_; unsigned w0 = q[0] | (q[1] << 8) | (q[2] << 16) | (q[3] << 24), w1 = q[4] | (q[5] << 8) | (q[6] << 16) | (q[7] << 24);
                    typedef unsigned u32x2 __attribute__((ext_vector_type(2)));
                    *(u32x2*)(rowp + bj * HALF) = (u32x2){w0, w1}; (void)w_; } }
    }
};
struct EpiMerge {
    static constexpr bool PERM = true, AFTER_DRAIN = false, HOOK = true;
    bf16_t* out; const unsigned char* gates; size_t gate_stride; const bf16_t* sums;
    PG8_LAS unsigned char* lds_tab; int par;
    static constexpr int TAB_OFF = STAGE_BYTES, TAB_BYTES = 8192;
    typedef unsigned u32x2 __attribute__((ext_vector_type(2)));
    __device__ __forceinline__ bool is_switch(const Unit& u) const { return u.pm < (MTOK / BM); }
    __device__ __forceinline__ void hook_prefetch(const Unit& u, int tid, u32x4 (&q)[2]) const {
        if (tid < 256) { const int br = u.pm >= (MTOK / BM) ? 1 : 0; const size_t m = (size_t)(u.pm - br * (MTOK / BM)) * BM + tid;
            const u32x4* p = (const u32x4*)(sums + (m * 8 + br * 4) * 4); q[0] = p[0]; q[1] = p[1]; }
    }
    __device__ __forceinline__ void hook_table(PG8_LAS unsigned char* lds, int parity, int tid, const u32x4 (&q)[2]) const {
        if (tid < 256) { const unsigned w[8] = {q[0].x, q[0].y, q[0].z, q[0].w, q[1].x, q[1].y, q[1].z, q[1].w}; float rs[4];
#pragma unroll
            for (int h = 0; h < 4; ++h) { const float ss = (bf_lo(w[2 * h]) + bf_hi(w[2 * h])) + (bf_lo(w[2 * h + 1]) + bf_hi(w[2 * h + 1])); rs[h] = __builtin_amdgcn_rsqf(ss * (1.f / HDIM) + EPSF); }
            const f32x4 t = {rs[0] * __builtin_amdgcn_rcpf(rs[1]), rs[1] * __builtin_amdgcn_rcpf(rs[2]), rs[2] * __builtin_amdgcn_rcpf(rs[3]), rs[3]};
            PG8_LAS f32x4* d = (PG8_LAS f32x4*)(lds + TAB_OFF + parity * TAB_BYTES + tid * 32); d[0] = t; d[1] = (f32x4){__builtin_amdgcn_rcpf(rs[0]), 0.f, 0.f, 0.f}; }
    }
    __device__ __forceinline__ void hook_scale(f32x4 (&acc)[2][2][4][2], PG8_LAS unsigned char* lds, int parity, int hidx, int wr, int fr) const {
        float sc[2][4];
        const PG8_LAS unsigned char* tb = lds + TAB_OFF + parity * TAB_BYTES + (wr * 64 + fr) * 32 + hidx * 4;
#pragma unroll
        for (int ai = 0; ai < 2; ++ai)
#pragma unroll
            for (int m = 0; m < 4; ++m) sc[ai][m] = *(const PG8_LAS float*)(tb + (ai * HALF + m * 16) * 32);
        asm volatile("s_waitcnt lgkmcnt(0)" ::: "memory");
#pragma unroll
        for (int ai = 0; ai < 2; ++ai)
#pragma unroll
            for (int m = 0; m < 4; ++m)
#pragma unroll
                for (int bj = 0; bj < 2; ++bj)
#pragma unroll
                    for (int n = 0; n < 2; ++n) acc[ai][bj][m][n] = acc[ai][bj][m][n] * sc[ai][m];
    }
    __device__ __forceinline__ void switch_branch(f32x4 (&acc)[2][2][4][2], const Unit& u, PG8_LAS unsigned char* lds, int par_cur, int par_nxt, int wr, int wc, int fr, int fq) const {
        const int row0 = u.pm * BM + wr * 64 + fr, col0 = u.pn * 256 + wc * 32 + 8 * fq;
#pragma unroll
        for (int ai = 0; ai < 2; ++ai) { u32x2 ga[4][2], gb2[4][2]; float f[4];
#pragma unroll
            for (int m = 0; m < 4; ++m) { const int rl = ai * HALF + wr * 64 + m * 16 + fr;
                f[m] = *(const PG8_LAS float*)(lds + TAB_OFF + par_cur * TAB_BYTES + rl * 32 + 12) * *(const PG8_LAS float*)(lds + TAB_OFF + par_nxt * TAB_BYTES + rl * 32 + 16);
#pragma unroll
                for (int bj = 0; bj < 2; ++bj) { const size_t off = (size_t)(row0 + ai * HALF + m * 16) * 1024 + col0 + bj * HALF; ga[m][bj] = *(const u32x2*)(gates + off); gb2[m][bj] = *(const u32x2*)(gates + gate_stride + off); } }
#pragma unroll
            for (int m = 0; m < 4; ++m)
#pragma unroll
                for (int bj = 0; bj < 2; ++bj)
#pragma unroll
                    for (int n = 0; n < 2; ++n) { const unsigned wa = n ? ga[m][bj].y : ga[m][bj].x, wb = n ? gb2[m][bj].y : gb2[m][bj].x; f32x4 v = acc[ai][bj][m][n];
#pragma unroll
                        for (int e = 0; e < 4; ++e) v[e] *= f[m] * ((float)((wa >> (8 * e)) & 0xffu) * __builtin_amdgcn_rcpf((float)((wb >> (8 * e)) & 0xffu)));
                        acc[ai][bj][m][n] = v; } }
    }
    __device__ __forceinline__ void operator()(const f32x4 (&acc)[2][2][4][2], const Unit& u, int wr, int wc, int fr, int fq) const {
        const int pm = u.pm - (MTOK / BM), pn = u.pn - 4;
        const int row0 = pm * BM + wr * 64 + fr, col0 = pn * 256 + wc * 32 + 8 * fq;
        const unsigned char* gb = gates + gate_stride;
        u32x2 gv[2][4][2];
#pragma unroll
        for (int ai = 0; ai < 2; ++ai)
#pragma unroll
            for (int m = 0; m < 4; ++m)
#pragma unroll
                for (int bj = 0; bj < 2; ++bj) gv[ai][m][bj] = *(const u32x2*)(gb + (size_t)(row0 + ai * HALF + m * 16) * 1024 + col0 + bj * HALF);
#pragma unroll
        for (int ai = 0; ai < 2; ++ai)
#pragma unroll
            for (int m = 0; m < 4; ++m) { const size_t off = (size_t)(row0 + ai * HALF + m * 16) * 1024 + col0;
                const float rq = *(const PG8_LAS float*)(lds_tab + TAB_OFF + par * TAB_BYTES + (ai * HALF + wr * 64 + m * 16 + fr) * 32 + 12) * (1.f / 255.f);
#pragma unroll
                for (int bj = 0; bj < 2; ++bj) { const u32x2 g = gv[ai][m][bj];
                    f32x4 v0 = acc[ai][bj][m][0] * rq, v1 = acc[ai][bj][m][1] * rq;
                    v0[0] *= (float)((g.x >> 0) & 0xffu); v0[1] *= (float)((g.x >> 8) & 0xffu); v0[2] *= (float)((g.x >> 16) & 0xffu); v0[3] *= (float)((g.x >> 24) & 0xffu);
                    v1[0] *= (float)((g.y >> 0) & 0xffu); v1[1] *= (float)((g.y >> 8) & 0xffu); v1[2] *= (float)((g.y >> 16) & 0xffu); v1[3] *= (float)((g.y >> 24) & 0xffu);
                    u32x4 w; w.x = pkv(v0[0], v0[1]); w.y = pkv(v0[2], v0[3]); w.z = pkv(v1[0], v1[1]); w.w = pkv(v1[2], v1[3]);
                    *(u32x4*)(out + off + bj * HALF) = w; } }
    }
};
struct PairOrder {
    StaticOrder so;
    __device__ __forceinline__ bool next(int i, Unit& u) const { Unit t; if (!so.next(i >> 1, t)) return false; const int br = i & 1; u.pm = t.pm + br * (MTOK / BM); u.pn = t.pn + br * 4; return true; }
    __device__ __forceinline__ void a_ready(const Unit&) const {}
    __device__ __forceinline__ void done(const Unit&) const {}
};
struct SplitOrder {
    StaticOrder so; int first, stride, count, wgm;
    __device__ __forceinline__ bool next(int i, Unit& u) const {
        if (i >= count) return false;
        int wgid = first + i * stride; { const int q = so.nwg / NXCD, r = so.nwg % NXCD, xcd = wgid % NXCD, off = wgid / NXCD; wgid = (xcd < r ? xcd * (q + 1) : r * (q + 1) + (xcd - r) * q) + off; }
        const int nig = wgm * so.nN, gid = wgid / nig, fm = gid * wgm, gsz = (so.nM - fm) < wgm ? (so.nM - fm) : wgm;
        u.pm = fm + ((wgid % nig) % gsz); u.pn = (wgid % nig) / gsz; return true;
    }
    __device__ __forceinline__ void a_ready(const Unit&) const {}
    __device__ __forceinline__ void done(const Unit&) const {}
};
struct GateOrder {
    int pm0, i0, count, xcd, k, pool;
    __device__ __forceinline__ bool next(int i, Unit& u) const { if (i >= count) return false;
        if (pool) { u.pm = pm0 + i * 8 + xcd; u.pn = k; } else { u.pm = pm0 + ((i0 + i) * 8 + xcd) * 2 + (k & 1); u.pn = k >> 1; } return true; }
    __device__ __forceinline__ void a_ready(const Unit&) const {}
    __device__ __forceinline__ void done(const Unit&) const {}
};
struct PanelOrder {
    int pm;
    __device__ __forceinline__ bool next(int i, Unit& u) const { if (i >= 4) return false; u.pm = pm; u.pn = i; return true; }
    __device__ __forceinline__ void a_ready(const Unit&) const {}
    __device__ __forceinline__ void done(const Unit&) const {}
};
struct EpiBf16Sc1 {
    static constexpr bool PERM = true, AFTER_DRAIN = false, HOOK = false;
    bf16_t* O; int ldc;
    __device__ __forceinline__ void operator()(const f32x4 (&acc)[2][2][4][2], const Unit& u, int wr, int wc, int fr, int fq) const {
        const __amdgpu_buffer_rsrc_t rs = __builtin_amdgcn_make_buffer_rsrc((void*)O, (short)0, (int)((size_t)MTOK * 1024 * 2), 0x00020000);
        const int row0 = u.pm * BM + wr * 64 + fr, col0 = u.pn * BM + wc * 32 + 8 * fq;
#pragma unroll
        for (int ai = 0; ai < 2; ++ai)
#pragma unroll
            for (int m = 0; m < 4; ++m) { const unsigned off = (unsigned)(((row0 + ai * HALF + m * 16) * ldc + col0) * 2);
#pragma unroll
                for (int bj = 0; bj < 2; ++bj) { const f32x4 v0 = acc[ai][bj][m][0], v1 = acc[ai][bj][m][1];
                    u32x4 w; w.x = pkv(v0[0], v0[1]); w.y = pkv(v0[2], v0[3]); w.z = pkv(v1[0], v1[1]); w.w = pkv(v1[2], v1[3]);
                    __builtin_amdgcn_raw_buffer_store_b128(w, rs, off + (unsigned)(bj * HALF * 2), 0, 16); } }
    }
};
struct OneUnit {
    Unit u;
    __device__ __forceinline__ bool next(int i, Unit& o) const { if (i != 0) return false; o = u; return true; }
    __device__ __forceinline__ void a_ready(const Unit&) const {}
    __device__ __forceinline__ void done(const Unit&) const {}
};
struct EpiSwiGLU {
    static constexpr bool PERM = true, AFTER_DRAIN = false, HOOK = false;
    bf16_t* act;
    __device__ __forceinline__ void operator()(const f32x4 (&acc)[2][2][4][2], const Unit& u, int wr, int wc, int fr, int fq) const {
        const int row0 = u.pm * BM + wr * 64 + fr, col0 = u.pn * 128 + wc * 32 + 8 * fq;
#pragma unroll
        for (int ai = 0; ai < 2; ++ai)
#pragma unroll
            for (int m = 0; m < 4; ++m) { const int row = row0 + ai * HALF + m * 16;
                float o[8];
#pragma unroll
                for (int n = 0; n < 2; ++n)
#pragma unroll
                    for (int e = 0; e < 4; ++e) { const float g = acc[ai][0][m][n][e], uu = acc[ai][1][m][n][e]; o[n * 4 + e] = g * sigm(g) * uu; }
                u32x4 w; w.x = pkv(o[0], o[1]); w.y = pkv(o[2], o[3]); w.z = pkv(o[4], o[5]); w.w = pkv(o[6], o[7]);
                *(u32x4*)(act + (size_t)row * DFF + col0) = w; }
    }
};

#ifndef PG8_SADDR_ALL
#define PG8_SADDR_ALL 0
#endif
template <class Epi, class Sched, bool ALIGN_EPI = false, bool SP2 = false, bool F8 = false>
__device__ __forceinline__ void gemm_phase(PG8_LAS unsigned char* lds, const Gemm g, const Sched& S, Epi E) {
    int tid_ = threadIdx.x; asm volatile("" : "+v"(tid_));
    const int tid = tid_, wid = __builtin_amdgcn_readfirstlane(tid >> 6), lane = tid & 63, wr = wid >> 2, wc = wid & 3, fr = lane & 15, fq = lane >> 4;
    const int K = g.K, nt = K / BK;
    unsigned voffA[2], voffB[2];
#pragma unroll
    for (int i = 0; i < 2; ++i) { int R, C; stage_rc(tid * 16 + i * 8192, R, C); const int Rb = Epi::PERM ? ((R & ~31) + perm32(R & 31)) : R;
        voffA[i] = (unsigned)(R * K + C) * 2u; voffB[i] = (unsigned)(Rb * K + C) * 2u; }
    const size_t kstep = (size_t)(BK * 2);
    const size_t hstep = (size_t)HALF * K * 2;
    const size_t tstep = 2 * hstep;
    const unsigned ldsw = (unsigned)wid * 1024u;
    const int aoff = lds_byte(wr * 64 + fr, fq * 8), boff = lds_byte(wc * 32 + fr, fq * 8);
#define PG8_SA(b, h) (((b) * 2 + (h)) * HTB)
#define PG8_SB(b, h) ((4 + (b) * 2 + (h)) * HTB)
#define PG8_STAGE(bufoff, gbase, voff) do { _Pragma("unroll") for (int _i = 0; _i < 2; ++_i) { unsigned vo_ = (voff)[_i]; if constexpr (F8 || PG8_SADDR_ALL) asm volatile("" : "+v"(vo_));     \
        __builtin_amdgcn_global_load_lds((const unsigned*)((const char*)(gbase) + vo_), (PG8_LAS unsigned*)(lds + (bufoff) + ldsw + _i * 8192), 16, 0, 0); } } while (0)
#define PG8_LD1(dst, base) do { if constexpr (F8) { const i32x4_ lo_ = *(const PG8_LAS i32x4_*)(base), hi_ = *(const PG8_LAS i32x4_*)((base) + 1024); dst = __builtin_shufflevector(lo_, hi_, 0, 1, 2, 3, 4, 5, 6, 7); } \
        else { dst[0] = *(const PG8_LAS bf16x8*)(base); dst[1] = *(const PG8_LAS bf16x8*)((base) + 1024); } } while (0)
#define PG8_LDA(dst, b, h) do { _Pragma("unroll") for (int m = 0; m < 4; ++m) PG8_LD1(dst[m], lds + PG8_SA(b, h) + aoff + m * 2048); } while (0)
#define PG8_LDB(dst, b, h) do { _Pragma("unroll") for (int n = 0; n < 2; ++n) PG8_LD1(dst[n], lds + PG8_SB(b, h) + boff + n * 2048); } while (0)
#define PG8_MMA(ai, bj, At, Bt) do { __builtin_amdgcn_s_setprio(1); if constexpr (F8) { _Pragma("unroll") for (int m = 0; m < 4; ++m) _Pragma("unroll") for (int n = 0; n < 2; ++n) \
        acc[ai][bj][m][n] = __builtin_amdgcn_mfma_scale_f32_16x16x128_f8f6f4(Bt[n], At[m], acc[ai][bj][m][n], 0, 0, 0, 0, 0, 0); } else { \
        _Pragma("unroll") for (int m = 0; m < 4; ++m) _Pragma("unroll") for (int n = 0; n < 2; ++n) _Pragma("unroll") for (int k = 0; k < 2; ++k) \
        acc[ai][bj][m][n] = __builtin_amdgcn_mfma_f32_16x16x32_bf16(Bt[n][k], At[m][k], acc[ai][bj][m][n], 0, 0, 0); } __builtin_amdgcn_s_setprio(0); } while (0)
#define PG8_WAIT_V(n) asm volatile("s_waitcnt vmcnt(" #n ")" ::: "memory")
#define PG8_WAIT_L(n) asm volatile("s_waitcnt lgkmcnt(" #n ")" ::: "memory")
#define PG8_BAR __builtin_amdgcn_s_barrier()
#define PG8_SCHED __builtin_amdgcn_sched_barrier(0)
    Unit cur, nxt; int ui = 0;
    if (!S.next(0, cur)) return;
    f32x4 acc[2][2][4][2];
#pragma unroll
    for (int a = 0; a < 2; ++a)
#pragma unroll
        for (int b = 0; b < 2; ++b)
#pragma unroll
            for (int m = 0; m < 4; ++m)
#pragma unroll
                for (int n = 0; n < 2; ++n) acc[a][b][m][n] = (f32x4){0.f, 0.f, 0.f, 0.f};
    typename sel_<F8, i32x8_, bf16x8[2]>::type At[4], B0[2], B1[2];
    const char* cA = (const char*)(F8 ? (cur.pm >= g.pm3 ? g.A3 : (cur.pm >= g.pm2 ? g.A2 : g.A)) : g.A) + (size_t)cur.pm * tstep; const char* cB = (const char*)g.Bt + (size_t)cur.pn * tstep;
    S.a_ready(cur);
    if constexpr (Epi::HOOK) { u32x4 hq_[2]; E.hook_prefetch(cur, tid, hq_); E.hook_table(lds, 0, tid, hq_); }
    if constexpr (SP2) {
        PG8_STAGE(PG8_SB(0, 0), cB, voffB); PG8_STAGE(PG8_SB(0, 1), cB + hstep, voffB); PG8_STAGE(PG8_SA(0, 0), cA, voffA); PG8_STAGE(PG8_SA(0, 1), cA + hstep, voffA);
        if (wr == 1) PG8_BAR;
        PG8_WAIT_V(2); PG8_BAR;
        PG8_STAGE(PG8_SB(1, 0), cB + kstep, voffB); PG8_STAGE(PG8_SA(1, 0), cA + kstep, voffA); PG8_STAGE(PG8_SB(1, 1), cB + hstep + kstep, voffB);
        PG8_WAIT_V(6); PG8_BAR;
    } else {
        PG8_STAGE(PG8_SB(0, 0), cB, voffB); PG8_STAGE(PG8_SA(0, 0), cA, voffA); PG8_STAGE(PG8_SB(0, 1), cB + hstep, voffB); PG8_STAGE(PG8_SA(0, 1), cA + hstep, voffA);
        if (wr == 1) PG8_BAR;
        PG8_WAIT_V(4); PG8_BAR;
        PG8_STAGE(PG8_SB(1, 0), cB + kstep, voffB); PG8_STAGE(PG8_SA(1, 0), cA + kstep, voffA); PG8_STAGE(PG8_SB(1, 1), cB + hstep + kstep, voffB);
        PG8_WAIT_V(6); PG8_BAR;
    }
    for (;;) {
        const bool has_next = S.next(ui + 1, nxt);
        const char* nA = has_next ? (const char*)(F8 ? (nxt.pm >= g.pm3 ? g.A3 : (nxt.pm >= g.pm2 ? g.A2 : g.A)) : g.A) + (size_t)nxt.pm * tstep : cA; const char* nB = has_next ? (const char*)g.Bt + (size_t)nxt.pn * tstep : cB;
#pragma nounroll
        for (int t = 0; t < nt; t += 2) {
            if constexpr (Epi::HOOK) { if (t > 0) E.hook_scale(acc, lds, ui & 1, (t >> 1) - 1, wr, fr); }
            const bool last = (t == nt - 2);
            const char* a1 = cA + (size_t)(t + 1) * kstep;
            const char* a2 = last ? nA : cA + (size_t)(t + 2) * kstep; const char* b2 = last ? nB : cB + (size_t)(t + 2) * kstep;
            const char* a3 = a2 + kstep; const char* b3 = b2 + kstep;
            if (last && has_next) S.a_ready(nxt);
            if constexpr (SP2) {
            PG8_LDB(B0, 0, 0); PG8_LDB(B1, 0, 1); PG8_SCHED; PG8_LDA(At, 0, 0); PG8_STAGE(PG8_SA(1, 1), a1 + hstep, voffA);
            PG8_WAIT_V(8); PG8_WAIT_L(0); PG8_BAR; PG8_MMA(0, 0, At, B0); PG8_MMA(0, 1, At, B1); PG8_BAR; PG8_SCHED;
            PG8_LDA(At, 0, 1); PG8_STAGE(PG8_SB(0, 0), b2, voffB); PG8_STAGE(PG8_SB(0, 1), b2 + hstep, voffB); PG8_STAGE(PG8_SA(0, 0), a2, voffA);
            PG8_WAIT_V(8); PG8_WAIT_L(0); PG8_BAR; PG8_MMA(1, 0, At, B0); PG8_MMA(1, 1, At, B1); PG8_BAR; PG8_SCHED;
            PG8_LDB(B0, 1, 0); PG8_LDB(B1, 1, 1); PG8_SCHED; PG8_LDA(At, 1, 0); PG8_STAGE(PG8_SA(0, 1), a2 + hstep, voffA);
            PG8_WAIT_V(8); PG8_WAIT_L(0); PG8_BAR; PG8_MMA(0, 0, At, B0); PG8_MMA(0, 1, At, B1); PG8_BAR; PG8_SCHED;
            PG8_LDA(At, 1, 1); PG8_STAGE(PG8_SB(1, 0), b3, voffB); PG8_STAGE(PG8_SB(1, 1), b3 + hstep, voffB); PG8_STAGE(PG8_SA(1, 0), a3, voffA);
            PG8_WAIT_V(8); PG8_WAIT_L(0); PG8_BAR; PG8_MMA(1, 0, At, B0); PG8_MMA(1, 1, At, B1); PG8_BAR; PG8_SCHED;
            } else {
            PG8_LDB(B0, 0, 0); PG8_SCHED; PG8_LDA(At, 0, 0); PG8_STAGE(PG8_SA(1, 1), a1 + hstep, voffA);
            PG8_WAIT_L(8); PG8_BAR; PG8_WAIT_L(0); PG8_MMA(0, 0, At, B0); PG8_BAR; PG8_SCHED;
            PG8_LDB(B1, 0, 1); PG8_STAGE(PG8_SB(0, 0), b2, voffB);
            PG8_BAR; PG8_WAIT_L(0); PG8_MMA(0, 1, At, B1); PG8_BAR;
            PG8_LDA(At, 0, 1); PG8_STAGE(PG8_SA(0, 0), a2, voffA);
            PG8_BAR; PG8_WAIT_L(0); PG8_MMA(1, 0, At, B0); PG8_BAR; PG8_SCHED;
            PG8_STAGE(PG8_SB(0, 1), b2 + hstep, voffB);
            PG8_WAIT_V(6); PG8_BAR; PG8_MMA(1, 1, At, B1); PG8_BAR;
            PG8_LDB(B0, 1, 0); PG8_SCHED; PG8_LDA(At, 1, 0); PG8_STAGE(PG8_SA(0, 1), a2 + hstep, voffA);
            PG8_WAIT_L(8); PG8_BAR; PG8_WAIT_L(0); PG8_MMA(0, 0, At, B0); PG8_BAR; PG8_SCHED;
            PG8_LDB(B1, 1, 1); PG8_STAGE(PG8_SB(1, 0), b3, voffB);
            PG8_BAR; PG8_WAIT_L(0); PG8_MMA(0, 1, At, B1); PG8_BAR;
            PG8_LDA(At, 1, 1); PG8_STAGE(PG8_SA(1, 0), a3, voffA);
            PG8_BAR; PG8_WAIT_L(0); PG8_MMA(1, 0, At, B0); PG8_BAR; PG8_SCHED;
            PG8_STAGE(PG8_SB(1, 1), b3 + hstep, voffB);
            PG8_WAIT_V(6); PG8_BAR; PG8_MMA(1, 1, At, B1); PG8_BAR;
            }
        }
        if constexpr (ALIGN_EPI) { if (wr == 0) PG8_BAR; }
        u32x4 hq_[2]; bool sw_ = false;
        if constexpr (Epi::HOOK) { sw_ = has_next && E.is_switch(cur); if (has_next) E.hook_prefetch(nxt, tid, hq_); }
        if constexpr (Epi::HOOK) { if (sw_) {
                E.hook_table(lds, (ui + 1) & 1, tid, hq_); PG8_WAIT_L(0); PG8_BAR;
                E.switch_branch(acc, cur, lds, ui & 1, (ui + 1) & 1, wr, wc, fr, fq); S.done(cur); } }
        if (!sw_) { if constexpr (!Epi::AFTER_DRAIN) { if constexpr (Epi::HOOK) E.lds_tab = lds, E.par = ui & 1;
            E(acc, cur, wr, wc, fr, fq); S.done(cur); }
            if constexpr (Epi::HOOK) { if (has_next) E.hook_table(lds, (ui + 1) & 1, tid, hq_); } }
        if (!has_next) break;
        if (!sw_) {
#pragma unroll
        for (int a = 0; a < 2; ++a)
#pragma unroll
            for (int b = 0; b < 2; ++b)
#pragma unroll
                for (int m = 0; m < 4; ++m)
#pragma unroll
                    for (int n = 0; n < 2; ++n) acc[a][b][m][n] = (f32x4){0.f, 0.f, 0.f, 0.f};
        }
        cur = nxt; cA = nA; cB = nB; ++ui;
        if constexpr (ALIGN_EPI) { if (wr == 1) PG8_BAR; }
    }
    PG8_WAIT_V(0);
    if constexpr (!ALIGN_EPI) { if (wr == 0) PG8_BAR; }
    PG8_BAR;
    if constexpr (Epi::AFTER_DRAIN) { E.fused(acc, cur, wr, wc, fr, fq, lds, wid, lane); S.done(cur); }
#undef PG8_SA
#undef PG8_SB
#undef PG8_STAGE
#undef PG8_LDA
#undef PG8_LDB
#undef PG8_MMA
#undef PG8_LD1
#undef PG8_WAIT_V
#undef PG8_WAIT_L
#undef PG8_BAR
#undef PG8_SCHED
}
}

#ifndef PG8_SP2
#define PG8_SP2 true
#endif
#ifndef PG8_ALIGN
#define PG8_ALIGN true
#endif
constexpr int NWAVES = 8;
#ifndef MK_ONE_LAUNCH
#define MK_ONE_LAUNCH 0
#endif
constexpr int N_PHASES = 1 + 11 * DEPTH;

constexpr size_t MiB = 1u << 20;
constexpr size_t WS_CTL = 0, CTL_ZERO_BYTES = 1 * MiB;
constexpr size_t WS_W = 1 * MiB;
constexpr size_t W_INA = 0, W_INB = W_INA + (size_t)N_INA * DM, W_O2 = W_INB + (size_t)N_INB * DM, W_OUT = W_O2 + (size_t)2048 * 512,
                 W_GU = W_OUT + (size_t)DM * DM, W_DN = W_GU + (size_t)2 * DFF * DM, W_LAYER = W_DN + (size_t)DM * DFF;
static_assert(W_LAYER * 2 <= 33 * MiB, "weights per layer");
constexpr size_t WS_RSTD = 67 * MiB;
constexpr size_t WS_AB = 68 * MiB;
constexpr size_t WS_SUMS = 68 * MiB;
constexpr size_t WS_R = 72 * MiB;
constexpr size_t WS_P = 200 * MiB;
constexpr size_t PLANE = (size_t)MTOK * 512;
constexpr size_t WS_X = 712 * MiB;
constexpr size_t WS_GATES = 200 * MiB;
constexpr size_t WS_MERGED = 456 * MiB;
#ifndef WS_SKEW_BYTES
#define WS_SKEW_BYTES 0
#endif
constexpr size_t WS_SKEW = WS_SKEW_BYTES;
constexpr size_t WS_MIX = 584 * MiB + WS_SKEW;
constexpr size_t WS_ACT = 200 * MiB;
constexpr size_t WS_F = 584 * MiB + WS_SKEW;
constexpr size_t WS_W8 = 1004 * MiB, W8_LAYER = (size_t)N_INB * DM;
constexpr float W8_SCALE = 64.f;
constexpr int R8A_TILES = 112, R8A_ROWS = R8A_TILES * 256, R8_TILES = 176, R8_ROWS = R8_TILES * 256;
constexpr size_t R8_OUT_OFF = 100 * MiB, WS_R8B = 1008 * MiB;
constexpr size_t WS_R8C = 328 * MiB;
constexpr size_t WS_END = 1024 * MiB;
constexpr int CW_PANEL = 16384;
constexpr int CW_BAR = 4096;

constexpr int LDS_BYTES = 163840;
constexpr int MISC_OFF = LDS_BYTES - 512;

#define GAS __attribute__((address_space(1)))
#define LAS __attribute__((address_space(3)))
typedef unsigned short bf16;
typedef unsigned v4u __attribute__((ext_vector_type(4)));
typedef unsigned v2u __attribute__((ext_vector_type(2)));
typedef float f32x4 __attribute__((ext_vector_type(4)));
typedef GAS unsigned gu32;
#define RLX_AGENT __ATOMIC_RELAXED, __HIP_MEMORY_SCOPE_AGENT
#define LDS_WAIT() asm volatile("s_waitcnt lgkmcnt(0)" ::: "memory")
#define VM_WAIT() asm volatile("s_waitcnt vmcnt(0)" ::: "memory")
typedef __bf16 bfv2_ __attribute__((ext_vector_type(2)));
typedef float fv2_ __attribute__((ext_vector_type(2)));
__device__ __forceinline__ unsigned pk2(float lo, float hi) { fv2_ v = {lo, hi}; bfv2_ r = __builtin_convertvector(v, bfv2_); return __builtin_bit_cast(unsigned, r); }
__device__ __forceinline__ unsigned pk8(float a, float b, float c, float d) { int w = __builtin_amdgcn_cvt_pk_fp8_f32(a, b, 0, false); w = __builtin_amdgcn_cvt_pk_fp8_f32(c, d, w, true); return (unsigned)w; }
__device__ __forceinline__ unsigned f2bf(float f) { return pk2(f, 0.f) & 0xffffu; }
__device__ __forceinline__ float bflo(unsigned w) { return __builtin_bit_cast(float, w << 16); }
__device__ __forceinline__ float bfhi(unsigned w) { return __builtin_bit_cast(float, w & 0xffff0000u); }
__device__ __forceinline__ float bf1(bf16 b) { return __builtin_bit_cast(float, (unsigned)b << 16); }
__device__ __forceinline__ float sigmf(float x) { return __builtin_amdgcn_rcpf(1.f + __expf(-x)); }
__device__ __forceinline__ float wave_sum(float v) {
    v += __builtin_bit_cast(float, __builtin_amdgcn_update_dpp(0, __builtin_bit_cast(int, v), 0xB1, 0xF, 0xF, true));
    v += __builtin_bit_cast(float, __builtin_amdgcn_update_dpp(0, __builtin_bit_cast(int, v), 0x4E, 0xF, 0xF, true));
    v += __builtin_bit_cast(float, __builtin_amdgcn_update_dpp(0, __builtin_bit_cast(int, v), 0x141, 0xF, 0xF, true));
    v += __builtin_bit_cast(float, __builtin_amdgcn_update_dpp(0, __builtin_bit_cast(int, v), 0x140, 0xF, 0xF, true));
    const int vi = __builtin_bit_cast(int, v);
    return (__builtin_bit_cast(float, __builtin_amdgcn_readlane(vi, 0)) + __builtin_bit_cast(float, __builtin_amdgcn_readlane(vi, 16))) +
           (__builtin_bit_cast(float, __builtin_amdgcn_readlane(vi, 32)) + __builtin_bit_cast(float, __builtin_amdgcn_readlane(vi, 48)));
}
#define XB_TMO      128
#define XB_XCNT(j)  (256  + 64 * (j))
#define XB_XSUB(j)  (1280 + 64 * (j))
#define XB_XGEN(j)  (2304 + 64 * (j))
#define XB_TOP      3328
#define XB_TOPGEN   3392
#define XCD_BAR_WORDS 3456
#define XB_SPIN_CAP (1u << 18)

__device__ __forceinline__ unsigned xb_ld(unsigned* p)              { return __hip_atomic_load(p, __ATOMIC_RELAXED, __HIP_MEMORY_SCOPE_AGENT); }
__device__ __forceinline__ unsigned xb_add(unsigned* p, unsigned v) { return __hip_atomic_fetch_add(p, v, __ATOMIC_RELAXED, __HIP_MEMORY_SCOPE_AGENT); }
__device__ __forceinline__ unsigned xb_xcc_id() { return (unsigned)__builtin_amdgcn_s_getreg((3 << 11) | 20) & 0xFu; }
#define XB_SPIN(cond, bar) do { unsigned _sp = 0; while (cond) { __builtin_amdgcn_s_sleep(1); \
    if ((++_sp & 255u) == 0u) { if (xb_ld(&(bar)[XB_TMO])) break; if (_sp > XB_SPIN_CAP) { atomicAdd(&(bar)[XB_TMO], 1u); break; } } } } while (0)

struct XcdBarrier {
    unsigned* bar; unsigned x;
    volatile LAS unsigned* st;
};

__device__ __forceinline__ XcdBarrier xcd_barrier_post(unsigned* bar, volatile LAS unsigned* st) {
    XcdBarrier b; b.bar = bar; b.x = xb_xcc_id(); b.st = st;
    if (threadIdx.x == 0) (void)xb_add(&bar[XB_XCNT(b.x)], 1u);
    return b;
}
__device__ __forceinline__ void xcd_barrier_complete(unsigned* bar, unsigned x, unsigned& nloc, unsigned& nx) {
    const unsigned G = gridDim.x * gridDim.y * gridDim.z;
    unsigned sum, cnt, mine, sp = 0u;
    for (;;) {
        sum = 0u; cnt = 0u; mine = 0u;
#pragma unroll
        for (unsigned j = 0; j < 16; ++j) { const unsigned c = xb_ld(&bar[XB_XCNT(j)]); sum += c; cnt += (c > 0u) ? 1u : 0u; mine = (j == x) ? c : mine; }
        if (sum == G) break;
        __builtin_amdgcn_s_sleep(1);
        if ((++sp & 255u) == 0u) { if (xb_ld(&bar[XB_TMO])) break; if (sp > XB_SPIN_CAP) { atomicAdd(&bar[XB_TMO], 1u); break; } }
    }
    nloc = mine > 0u ? mine : 1u; nx = cnt > 0u ? cnt : 1u;
}

__device__ __forceinline__ void xcd_barrier(const XcdBarrier& b) {
    asm volatile("s_waitcnt vmcnt(0)" ::: "memory");
    __syncthreads();
    if (threadIdx.x == 0) {
        unsigned* bar = b.bar;
        __builtin_amdgcn_s_waitcnt(0);
        unsigned nloc = b.st[0], nx = b.st[1];
        if (nloc == 0u) { xcd_barrier_complete(bar, b.x, nloc, nx); b.st[0] = nloc; b.st[1] = nx; }
        const unsigned old = xb_add(&bar[XB_XSUB(b.x)], 1u);
        const unsigned gen = old / nloc;
        if (old + 1u == (gen + 1u) * nloc) {
            __builtin_amdgcn_fence(__ATOMIC_RELEASE, "agent");
            asm volatile("s_waitcnt vmcnt(0)" ::: "memory");
            const unsigned og = xb_add(&bar[XB_TOP], 1u);
            const unsigned tg = og / nx;
            if (og + 1u == (tg + 1u) * nx) xb_add(&bar[XB_TOPGEN], 1u);
            else XB_SPIN(xb_ld(&bar[XB_TOPGEN]) == tg, bar);
            __builtin_amdgcn_fence(__ATOMIC_ACQUIRE, "agent");
            xb_add(&bar[XB_XGEN(b.x)], 1u);
            asm volatile("s_waitcnt vmcnt(0)" ::: "memory");
        } else {
            XB_SPIN(xb_ld(&bar[XB_XGEN(b.x)]) == gen, bar);
            __builtin_amdgcn_fence(__ATOMIC_ACQUIRE, "agent");
            asm volatile("s_waitcnt vmcnt(0)" ::: "memory");
        }
    }
    __syncthreads();
}

struct Frame {
    LAS unsigned char* lds;
    volatile LAS unsigned* MISC;
    gu32* ctl;
    int tid, lane, wave, G;
    const float* in[17];
    float* out; unsigned char* ws;
};


typedef short bf16x8 __attribute__((ext_vector_type(8)));
typedef float f32x16 __attribute__((ext_vector_type(16)));
typedef __bf16 bfv2 __attribute__((ext_vector_type(2)));
typedef float fv2 __attribute__((ext_vector_type(2)));
#define MFMA32(a, b, c) __builtin_amdgcn_mfma_f32_32x32x16_bf16((a), (b), (c), 0, 0, 0)
__device__ __forceinline__ unsigned pkc(float a, float b) { fv2 v = {a, b}; bfv2 r = __builtin_convertvector(v, bfv2); return __builtin_bit_cast(unsigned, r); }
__device__ __forceinline__ bf16x8 pack_half(const f32x16& x, int s) {
    v4u p; p.x = pkc(x[8 * s + 0], x[8 * s + 1]); p.y = pkc(x[8 * s + 2], x[8 * s + 3]); p.z = pkc(x[8 * s + 4], x[8 * s + 5]); p.w = pkc(x[8 * s + 6], x[8 * s + 7]);
    return __builtin_bit_cast(bf16x8, p);
}
__device__ __forceinline__ f32x16 zero16() { f32x16 z;
#pragma unroll
    for (int i = 0; i < 16; ++i) z[i] = 0.f; return z; }
__device__ __forceinline__ bf16x8 lds_frag(const LAS unsigned char* p) { return __builtin_bit_cast(bf16x8, *(const LAS v4u*)p); }

constexpr int NUNIT = BATCH * (SEQ / 64) * NHEAD;
constexpr size_t HG1_UNIT = 32768, HG2_UNIT = 25600;
constexpr size_t DN_UNIT = 74752;
constexpr size_t WS_DNB = 712 * MiB;
#ifdef DN_REF
constexpr size_t WS_ORAW = 712 * MiB;
#else
constexpr size_t WS_ORAW = 456 * MiB;
#endif
#ifndef SCAN_DUMMY
#define SCAN_DUMMY 0
#endif
#ifndef SCAN_AUX
#define SCAN_AUX 0
#endif
constexpr int PQ = 272, PT = 144;

struct HgRaw { unsigned q[8], f[8], i[8]; };
__device__ __forceinline__ void hg_raw_load(HgRaw& a, Frame& F, int unit, int lane) {
    const int h = unit & 3, n = (unit >> 2) & 127, b = unit >> 9; const size_t row0 = (size_t)b * SEQ + 64 * n;
    const bf16* P0 = (const bf16*)(F.ws + WS_P); const bf16* P1 = P0 + PLANE; const bf16* P2 = P1 + PLANE;
#pragma unroll
    for (int i = 0; i < 8; ++i) { const size_t off = (row0 + 8 * F.wave + i) * 512 + 128 * h + 2 * lane;
        a.q[i] = *(const GAS unsigned*)(P0 + off); a.f[i] = *(const GAS unsigned*)(P1 + off); a.i[i] = *(const GAS unsigned*)(P2 + off); }
}
constexpr int HGRAW_OFF = 101376;
__device__ __forceinline__ void hg_dma_issue(Frame& F, int unit, int lane) {
    const int h = unit & 3, n = (unit >> 2) & 127, b = unit >> 9; const size_t row0 = (size_t)b * SEQ + 64 * n;
    const bf16* P0 = (const bf16*)(F.ws + WS_P);
#pragma unroll
    for (int i = 0; i < 6; ++i) { const int p = F.wave * 6 + i, pl = p >> 4, r4 = (p & 15) * 4;
        const bf16* src = P0 + (size_t)pl * PLANE + (row0 + r4 + (lane >> 4)) * 512 + 128 * h + 8 * (lane & 15);
        __builtin_amdgcn_global_load_lds((const unsigned*)src, (LAS unsigned*)(F.lds + HGRAW_OFF + p * 1024), 16, 0, 0); }
}
struct HgConst { float lb[2]; };
__device__ __forceinline__ void prep_hg_unit(Frame& F, int l, int unit, int next_unit, const HgConst& hc) {
    const int h = unit & 3, n = (unit >> 2) & 127, b = unit >> 9;
    const size_t row0 = (size_t)b * SEQ + 64 * n;
    LAS unsigned char* L = F.lds;
    LAS float* TOT = (LAS float*)L;
    LAS unsigned char* QT = L + 4096; LAS unsigned char* KT = QT + 64 * PQ; LAS unsigned char* QSR = KT + 64 * PQ;
    LAS unsigned char* KHT = QSR + 64 * PQ; LAS unsigned char* VI = KHT + 128 * PT; LAS unsigned char* ATT = VI + 64 * PQ;
    const bf16* P0 = (const bf16*)(F.ws + WS_P); const bf16* P1 = P0 + PLANE; const bf16* P2 = P1 + PLANE;
    const int blk = (b * 4 + h) * 128 + n;
    unsigned char* part1 = (unsigned char*)F.out + 128 * MiB + (size_t)blk * HG1_UNIT;
    unsigned char* part2 = (unsigned char*)F.out + (size_t)blk * HG2_UNIT;
    const int w = F.wave; int lane = F.lane; asm volatile("" : "+v"(lane));
    const int d0 = 2 * lane;
    const float lb[2] = {hc.lb[0], hc.lb[1]};
    float q[8][2], kk[8][2], cs[8][2];
    {
        float run[2] = {0.f, 0.f};
#pragma unroll
        for (int i = 0; i < 8; ++i) {
            const LAS unsigned char* rp = F.lds + HGRAW_OFF + (8 * w + i) * 256 + 4 * lane;
            const unsigned qv = *(const LAS unsigned*)rp, fv = *(const LAS unsigned*)(rp + 16384), iv = *(const LAS unsigned*)(rp + 32768);
            *(LAS unsigned*)(VI + (8 * w + i) * PQ + 2 * d0) = iv;
            q[i][0] = bflo(qv); q[i][1] = bfhi(qv);
            const float fl[2] = {bflo(fv), bfhi(fv)};
#pragma unroll
            for (int e = 0; e < 2; ++e) { const float sg = sigmf(fl[e]); const float f = lb[e] + (1.f - lb[e]) * sg; kk[i][e] = (1.f - lb[e]) * (1.f - sg);
                run[e] += __logf(fmaxf(f, 1e-30f))  ; cs[i][e] = run[e]; } }
        TOT[w * 128 + d0] = run[0]; TOT[w * 128 + d0 + 1] = run[1];
    }
    __syncthreads();
    if (next_unit >= 0) hg_dma_issue(F, next_unit, lane);
    {
        float off[2] = {0.f, 0.f}, bref[2] = {0.f, 0.f}, blast[2] = {0.f, 0.f};
#pragma unroll
        for (int ww = 0; ww < 8; ++ww) { const float t0 = TOT[ww * 128 + d0], t1 = TOT[ww * 128 + d0 + 1];
            if (ww < w) { off[0] += t0; off[1] += t1; } if (ww < 4) { bref[0] += t0; bref[1] += t1; } blast[0] += t0; blast[1] += t1; }
        unsigned kh[2][4];
#pragma unroll
        for (int i = 0; i < 8; ++i) { float qt[2], kt[2], qs[2], kh_[2];
#pragma unroll
            for (int e = 0; e < 2; ++e) { const float bb = off[e] + cs[i][e];
                qt[e] = q[i][e] * __expf(fminf(bb - bref[e], 80.f)); kt[e] = kk[i][e] * __expf(fminf(bref[e] - bb, 80.f));
                qs[e] = q[i][e] * __expf(bb); kh_[e] = kk[i][e] * __expf(blast[e] - bb); }
            const int t = 8 * w + i;
            *(LAS unsigned*)(QT + t * PQ + 2 * d0) = pk2(qt[0], qt[1]); *(LAS unsigned*)(KT + t * PQ + 2 * d0) = pk2(kt[0], kt[1]); *(LAS unsigned*)(QSR + t * PQ + 2 * d0) = pk2(qs[0], qs[1]);
            if (i & 1) { kh[0][i >> 1] |= f2bf(kh_[0]) << 16; kh[1][i >> 1] |= f2bf(kh_[1]) << 16; } else { kh[0][i >> 1] = f2bf(kh_[0]); kh[1][i >> 1] = f2bf(kh_[1]); } }
        *(LAS v4u*)(KHT + d0 * PT + 16 * w) = (v4u){kh[0][0], kh[0][1], kh[0][2], kh[0][3]};
        *(LAS v4u*)(KHT + (d0 + 1) * PT + 16 * w) = (v4u){kh[1][0], kh[1][1], kh[1][2], kh[1][3]};
        if (w == 0) { *(GAS fv2*)(part2 + 8192 + 4 * d0) = (fv2){__expf(blast[0]), __expf(blast[1])}; }
    }
    __syncthreads();
    const int r = lane & 31, hg = lane >> 5;
    if (w < 3) {
        const int m = w >= 1 ? 1 : 0, mp = w == 2 ? 1 : 0;
        f32x16 acc = zero16();
#pragma unroll
        for (int ks = 0; ks < 8; ++ks) acc = MFMA32(lds_frag(QT + (32 * m + r) * PQ + 32 * ks + 16 * hg), lds_frag(KT + (32 * mp + r) * PQ + 32 * ks + 16 * hg), acc);
#pragma unroll
        for (int i = 0; i < 16; ++i) { const int ii = 32 * m + (i & 3) + 8 * (i >> 2) + 4 * hg, jj = 32 * mp + r;
            *(LAS bf16*)(ATT + ii * PT + 2 * jj) = (bf16)f2bf((jj <= ii ? 1.f : 0.f) * acc[i]); }
    } else if (w == 3) {
#pragma unroll
        for (int i = 0; i < 16; ++i) *(LAS bf16*)(ATT + (2 * i + hg) * PT + 2 * (32 + r)) = 0;
    }
    __syncthreads();
#pragma unroll
    for (int i = 0; i < 2; ++i) { const int f = w + 8 * i, m = f >> 3, kt = f & 7;
        const LAS unsigned char* src = QSR + (32 * m + r) * PQ + 2 * (16 * kt + 4 * hg);
        const v2u a = *(const LAS v2u*)src, c = *(const LAS v2u*)(src + 16);
        *(GAS v4u*)(part1 + f * 1024 + lane * 16) = (v4u){a.x, a.y, c.x, c.y}; }
#pragma unroll
    for (int i = 0; i < 2; ++i) { const int f = w + 8 * i, t4 = f >> 2, ktp = f & 3;
        *(GAS v4u*)(part1 + 16384 + f * 1024 + lane * 16) = *(const LAS v4u*)(KHT + (32 * t4 + r) * PT + 2 * (16 * ktp + 8 * hg)); }
    { const int f = w, m = f >> 2, ktp = f & 3;
        *(GAS v4u*)(part2 + f * 1024 + lane * 16) = *(const LAS v4u*)(ATT + (32 * m + r) * PT + 2 * (16 * ktp + 8 * hg)); }
#pragma unroll
    for (int i = 0; i < 2; ++i) { const int f = w + 8 * i, sl = f >> 2, ktp = f & 3;
        unsigned short e[8];
#pragma unroll
        for (int j = 0; j < 8; ++j) e[j] = *(const LAS bf16*)(VI + (16 * ktp + 8 * hg + j) * PQ + 2 * (32 * sl + r));
        *(GAS v4u*)(part2 + 9216 + f * 1024 + lane * 16) = (v4u){(unsigned)e[0] | ((unsigned)e[1] << 16), (unsigned)e[2] | ((unsigned)e[3] << 16), (unsigned)e[4] | ((unsigned)e[5] << 16), (unsigned)e[6] | ((unsigned)e[7] << 16)}; }
    asm volatile("s_waitcnt vmcnt(7)" ::: "memory");
    __syncthreads();
}


constexpr int OST_OFF = 133120, OST_SLICE = 32 * 136, OST_BUF = 2 * OST_SLICE;
__device__ __forceinline__ void chain_stage_o(LAS unsigned char* st, const f32x16 (&o)[2], int r, int hg) {
#pragma unroll
    for (int m = 0; m < 2; ++m)
#pragma unroll
        for (int q = 0; q < 4; ++q)
            *(LAS v2u*)(st + r * 136 + 2 * (32 * m + 8 * q + 4 * hg)) = (v2u){pk2(o[m][4 * q], o[m][4 * q + 1]), pk2(o[m][4 * q + 2], o[m][4 * q + 3])};
}
#ifndef HELPER_SIMD23
#define HELPER_SIMD23 1
#endif
#if HELPER_SIMD23
#define HELPER_WAVE(w) (((w) & 2) != 0)
#define HELPER_IDX(w) (((w) & 1) | (((w) >> 2) << 1))
#else
#define HELPER_WAVE(w) ((w) >= 4)
#define HELPER_IDX(w) ((w) - 4)
#endif
#ifndef HELPERS_LOAD
#define HELPERS_LOAD 0
#endif
#if HELPERS_LOAD
#define LOADER_WAVE(w) ((w) >= 2)
#define LOADER_F0(w) ((w) - 2)
#define LOADER_STRIDE 6
#else
#define LOADER_WAVE(w) ((w) >= 2 && !HELPER_WAVE(w))
#define LOADER_F0(w) ((w) & 1)
#define LOADER_STRIDE 2
#endif
constexpr int GST_OFF = OST_OFF + 2 * OST_BUF;
__device__ __forceinline__ void chain_g_issue(Frame& F, int br, int b, int h, int sl0, int n, int hx, int lane) {
    const bf16* gp = (const bf16*)(F.ws + WS_P) + (size_t)(br ? 7 : 6) * PLANE + ((size_t)b * SEQ + 64 * n + 16 * hx + 2 * (lane >> 3)) * 512 + 128 * h + 32 * sl0 + 8 * (lane & 7);
    LAS unsigned char* gb = F.lds + GST_OFF + hx * 2048;
    __builtin_amdgcn_global_load_lds((const unsigned*)gp, (LAS unsigned*)gb, 16, 0, 0);
    __builtin_amdgcn_global_load_lds((const unsigned*)(gp + 512), (LAS unsigned*)(gb + 1024), 16, 0, 0);
}
__device__ __forceinline__ void chain_finish_rows(Frame& F, int br, int b, int h, int sl0, int n, const LAS unsigned char* stb  , int hx, int lane, const v4u (&gq)[2]) {
    const int p = lane & 7, c0 = 8 * (p & 3), rowp = 16 * hx + 2 * (lane >> 3);
    const LAS unsigned char* st = stb + (p >> 2) * OST_SLICE + c0 * 136 + 2 * rowp;
    unsigned ow[8];
#pragma unroll
    for (int c = 0; c < 8; ++c) ow[c] = *(const LAS unsigned*)(st + c * 136);
#pragma unroll
    for (int j = 0; j < 2; ++j) {
        const size_t m = (size_t)b * SEQ + 64 * n + rowp + j;
        const unsigned gw[4] = {gq[j].x, gq[j].y, gq[j].z, gq[j].w};
        unsigned w[4]; float ssq = 0.f;
#pragma unroll
        for (int c = 0; c < 4; ++c) { const float o0 = j ? bfhi(ow[2 * c]) : bflo(ow[2 * c]), o1 = j ? bfhi(ow[2 * c + 1]) : bflo(ow[2 * c + 1]);
            const float g0 = bflo(gw[c]), g1 = bfhi(gw[c]);
            ssq += o0 * o0 + o1 * o1;
            w[c] = pk2(o0 * g0, o1 * g1); }
        *(GAS v4u*)((bf16*)(F.ws + WS_ORAW) + (size_t)br * PLANE + m * 512 + 128 * h + 32 * sl0 + 8 * p) = (v4u){w[0], w[1], w[2], w[3]};
        ssq += __builtin_bit_cast(float, __builtin_amdgcn_update_dpp(0, __builtin_bit_cast(int, ssq), 0xB1, 0xF, 0xF, true));
        ssq += __builtin_bit_cast(float, __builtin_amdgcn_update_dpp(0, __builtin_bit_cast(int, ssq), 0x4E, 0xF, 0xF, true));
        if ((lane & 3) == 0) ((GAS bf16*)(F.ws + WS_SUMS))[(m * 8 + br * 4 + h) * 4 + sl0 + (p >> 2)] = (bf16)f2bf(ssq);
    }
}
__device__ __forceinline__ void chain_helper_step(Frame& F, int br, int b, int h, int sl0, int n, int hx, int lane) {
    const LAS unsigned char* gb = F.lds + GST_OFF + hx * 2048 + lane * 16;
    v4u gq[2] = {(v4u){0u, 0u, 0u, 0u}, (v4u){0u, 0u, 0u, 0u}};
    if (n > 0) { gq[0] = *(const LAS v4u*)gb; gq[1] = *(const LAS v4u*)(gb + 1024); LDS_WAIT(); }
    if (n < SEQ / 64) chain_g_issue(F, br, b, h, sl0, n, hx, lane);
    if (n > 0) chain_finish_rows(F, br, b, h, sl0, n - 1, F.lds + OST_OFF + ((n - 1) & 1) * OST_BUF, hx, lane, gq);
}
__device__ __forceinline__ void scan_hg_chain(Frame& F, int bh, int sl0) {
    const int sl = sl0 + (F.wave & 1);
    const int b = bh >> 2, h = bh & 3;
    bf16* oraw = (bf16*)(F.ws + WS_ORAW);
    f32x16 S[4];
#pragma unroll
    for (int t = 0; t < 4; ++t) S[t] = zero16();
#define HG_ISSUE(nn, bufo) do { const int unit_ = (b * 4 + h) * 128 + (nn); \
        const unsigned char* p1_ = (const unsigned char*)F.out + 128 * MiB + (size_t)unit_ * HG1_UNIT; const unsigned char* p2_ = (const unsigned char*)F.out + (size_t)unit_ * HG2_UNIT; \
        for (int f = LOADER_F0(F.wave); f < 49; f += LOADER_STRIDE) { const unsigned char* src = f < 32 ? p1_ + f * 1024 : (f < 41 ? p2_ + (f - 32) * 1024 : p2_ + 9216 + (sl0 + ((f - 41) >> 2)) * 4096 + ((f - 41) & 3) * 1024); \
            __builtin_amdgcn_global_load_lds((const unsigned*)(src + lane * 16), (LAS unsigned*)(F.lds + (bufo) + f * 1024), 16, 0, SCAN_AUX); } } while (0)
#ifdef HG_TRIPLE
    { const int lane = F.lane; if (F.wave >= 2) { HG_ISSUE(0, 0); HG_ISSUE(1, 50176); } }
    int bcur = 0;
    for (int n = 0; n < SEQ / 64; ++n) {
        int lane = F.lane; asm volatile("" : "+v"(lane));
        const int r = lane & 31, hg = lane >> 5;
        LAS unsigned char* L = F.lds + bcur * 50176;
        const int bnx2 = bcur == 0 ? 2 : bcur - 1;
        if (F.wave >= 2) { if (n + 1 >= SEQ / 64) asm volatile("s_waitcnt vmcnt(0)" ::: "memory"); else if (F.wave == 2) asm volatile("s_waitcnt vmcnt(9)" ::: "memory"); else asm volatile("s_waitcnt vmcnt(8)" ::: "memory"); }
        __syncthreads();
        if (F.wave >= 2 && n + 2 < SEQ / 64) HG_ISSUE(n + 2, bnx2 * 50176);
        bcur = bcur == 2 ? 0 : bcur + 1;
#else
    { const int lane = F.lane; if (LOADER_WAVE(F.wave)) HG_ISSUE(0, 0); }
    for (int n = 0; n < SEQ / 64; ++n) {
        int lane = F.lane; asm volatile("" : "+v"(lane));
        const int r = lane & 31, hg = lane >> 5;
        LAS unsigned char* L = F.lds + (n & 1) * 66560;
        if (HELPER_WAVE(F.wave) && n >= 2) asm volatile("s_waitcnt vmcnt(4)" ::: "memory"); else if (F.wave >= 2) asm volatile("s_waitcnt vmcnt(0)" ::: "memory");
        __syncthreads();
        if (LOADER_WAVE(F.wave) && n + 1 < SEQ / 64) HG_ISSUE(n + 1, ((n + 1) & 1) * 66560);
#endif
        if (F.wave < 2) {
            const size_t row0 = (size_t)b * SEQ + 64 * n;
            const LAS unsigned char* Lp = L + lane * 16;
            bf16x8 bs[8];
#pragma unroll
            for (int kt = 0; kt < 8; ++kt) bs[kt] = pack_half(S[kt >> 1], kt & 1);
            bf16x8 bv[4];
#pragma unroll
            for (int kt = 0; kt < 4; ++kt) bv[kt] = lds_frag(Lp + 41984 + (F.wave & 1) * 4096 + kt * 1024);
            f32x16 o[2] = {zero16(), zero16()};
#define HG_DECAY(t4) do { _Pragma("unroll") for (int g = 0; g < 4; ++g) { const f32x4 dc = *(const LAS f32x4*)(L + 40960 + 4 * (32 * (t4) + 8 * g + 4 * hg)); \
                _Pragma("unroll") for (int e = 0; e < 4; ++e) S[t4][4 * g + e] *= dc[e]; } } while (0)
            bf16x8 rg0 = lds_frag(Lp + 0);
            bf16x8 rg1 = lds_frag(Lp + 1024);
            bf16x8 rg2 = lds_frag(Lp + 2048);
            bf16x8 rg3 = lds_frag(Lp + 3072);
            { const bf16x8 a = rg0; rg0 = lds_frag(Lp + 4096);
              o[0] = MFMA32(a, bs[0], o[0]); }
            __builtin_amdgcn_sched_barrier(0); asm volatile("" ::: "memory");
            { const bf16x8 a = rg1; rg1 = lds_frag(Lp + 5120);
              o[0] = MFMA32(a, bs[1], o[0]); }
            __builtin_amdgcn_sched_barrier(0); asm volatile("" ::: "memory");
            { const bf16x8 a = rg2; rg2 = lds_frag(Lp + 6144);
              o[0] = MFMA32(a, bs[2], o[0]); }
            __builtin_amdgcn_sched_barrier(0); asm volatile("" ::: "memory");
            { const bf16x8 a = rg3; rg3 = lds_frag(Lp + 7168);
              o[0] = MFMA32(a, bs[3], o[0]); }
            __builtin_amdgcn_sched_barrier(0); asm volatile("" ::: "memory");
            { const bf16x8 a = rg0; rg0 = lds_frag(Lp + 8192);
              o[0] = MFMA32(a, bs[4], o[0]); }
            __builtin_amdgcn_sched_barrier(0); asm volatile("" ::: "memory");
            { const bf16x8 a = rg1; rg1 = lds_frag(Lp + 9216);
              o[0] = MFMA32(a, bs[5], o[0]); }
            __builtin_amdgcn_sched_barrier(0); asm volatile("" ::: "memory");
            { const bf16x8 a = rg2; rg2 = lds_frag(Lp + 10240);
              o[0] = MFMA32(a, bs[6], o[0]); }
            __builtin_amdgcn_sched_barrier(0); asm volatile("" ::: "memory");
            { const bf16x8 a = rg3; rg3 = lds_frag(Lp + 11264);
              o[0] = MFMA32(a, bs[7], o[0]); }
            __builtin_amdgcn_sched_barrier(0); asm volatile("" ::: "memory");
            { const bf16x8 a = rg0; rg0 = lds_frag(Lp + 12288);
              o[1] = MFMA32(a, bs[0], o[1]); }
            __builtin_amdgcn_sched_barrier(0); asm volatile("" ::: "memory");
            { const bf16x8 a = rg1; rg1 = lds_frag(Lp + 13312);
              o[1] = MFMA32(a, bs[1], o[1]); }
            __builtin_amdgcn_sched_barrier(0); asm volatile("" ::: "memory");
            { const bf16x8 a = rg2; rg2 = lds_frag(Lp + 14336);
              o[1] = MFMA32(a, bs[2], o[1]); }
            __builtin_amdgcn_sched_barrier(0); asm volatile("" ::: "memory");
            { const bf16x8 a = rg3; rg3 = lds_frag(Lp + 15360);
              o[1] = MFMA32(a, bs[3], o[1]); }
            __builtin_amdgcn_sched_barrier(0); asm volatile("" ::: "memory");
            { const bf16x8 a = rg0; rg0 = lds_frag(Lp + 32768);
              o[1] = MFMA32(a, bs[4], o[1]); }
            __builtin_amdgcn_sched_barrier(0); asm volatile("" ::: "memory");
            { const bf16x8 a = rg1; rg1 = lds_frag(Lp + 33792);
              o[1] = MFMA32(a, bs[5], o[1]); }
            __builtin_amdgcn_sched_barrier(0); asm volatile("" ::: "memory");
            { const bf16x8 a = rg2; rg2 = lds_frag(Lp + 36864);
              o[1] = MFMA32(a, bs[6], o[1]); }
            __builtin_amdgcn_sched_barrier(0); asm volatile("" ::: "memory");
            { const bf16x8 a = rg3; rg3 = lds_frag(Lp + 37888);
              o[1] = MFMA32(a, bs[7], o[1]); }
            __builtin_amdgcn_sched_barrier(0); asm volatile("" ::: "memory");
            { const bf16x8 a = rg0; rg0 = lds_frag(Lp + 38912);
              o[0] = MFMA32(a, bv[0], o[0]); }
            __builtin_amdgcn_sched_barrier(0); asm volatile("" ::: "memory");
            { const bf16x8 a = rg1; rg1 = lds_frag(Lp + 39936);
              o[0] = MFMA32(a, bv[1], o[0]); }
            __builtin_amdgcn_sched_barrier(0); asm volatile("" ::: "memory");
            { const bf16x8 a = rg2; rg2 = lds_frag(Lp + 16384);
              o[1] = MFMA32(a, bv[0], o[1]); }
            __builtin_amdgcn_sched_barrier(0); asm volatile("" ::: "memory");
            { const bf16x8 a = rg3; rg3 = lds_frag(Lp + 17408);
              o[1] = MFMA32(a, bv[1], o[1]); }
            __builtin_amdgcn_sched_barrier(0); asm volatile("" ::: "memory");
            { const bf16x8 a = rg0; rg0 = lds_frag(Lp + 18432);
              o[1] = MFMA32(a, bv[2], o[1]); }
            __builtin_amdgcn_sched_barrier(0); asm volatile("" ::: "memory");
            { const bf16x8 a = rg1; rg1 = lds_frag(Lp + 19456);
              o[1] = MFMA32(a, bv[3], o[1]); }
            __builtin_amdgcn_sched_barrier(0); asm volatile("" ::: "memory");
            { const bf16x8 a = rg2; rg2 = lds_frag(Lp + 20480);
              HG_DECAY(0);
              S[0] = MFMA32(a, bv[0], S[0]); }
            __builtin_amdgcn_sched_barrier(0); asm volatile("" ::: "memory");
            { const bf16x8 a = rg3; rg3 = lds_frag(Lp + 21504);
              S[0] = MFMA32(a, bv[1], S[0]); }
            __builtin_amdgcn_sched_barrier(0); asm volatile("" ::: "memory");
            { const bf16x8 a = rg0; rg0 = lds_frag(Lp + 22528);
              S[0] = MFMA32(a, bv[2], S[0]); }
            __builtin_amdgcn_sched_barrier(0); asm volatile("" ::: "memory");
            { const bf16x8 a = rg1; rg1 = lds_frag(Lp + 23552);
              S[0] = MFMA32(a, bv[3], S[0]); }
            __builtin_amdgcn_sched_barrier(0); asm volatile("" ::: "memory");
            { const bf16x8 a = rg2; rg2 = lds_frag(Lp + 24576);
              HG_DECAY(1);
              S[1] = MFMA32(a, bv[0], S[1]); }
            __builtin_amdgcn_sched_barrier(0); asm volatile("" ::: "memory");
            { const bf16x8 a = rg3; rg3 = lds_frag(Lp + 25600);
              S[1] = MFMA32(a, bv[1], S[1]); }
            __builtin_amdgcn_sched_barrier(0); asm volatile("" ::: "memory");
            { const bf16x8 a = rg0; rg0 = lds_frag(Lp + 26624);
              S[1] = MFMA32(a, bv[2], S[1]); }
            __builtin_amdgcn_sched_barrier(0); asm volatile("" ::: "memory");
            { const bf16x8 a = rg1; rg1 = lds_frag(Lp + 27648);
              S[1] = MFMA32(a, bv[3], S[1]); }
            __builtin_amdgcn_sched_barrier(0); asm volatile("" ::: "memory");
            { const bf16x8 a = rg2; rg2 = lds_frag(Lp + 28672);
              HG_DECAY(2);
              S[2] = MFMA32(a, bv[0], S[2]); }
            __builtin_amdgcn_sched_barrier(0); asm volatile("" ::: "memory");
            { const bf16x8 a = rg3; rg3 = lds_frag(Lp + 29696);
              S[2] = MFMA32(a, bv[1], S[2]); }
            __builtin_amdgcn_sched_barrier(0); asm volatile("" ::: "memory");
            { const bf16x8 a = rg0; rg0 = lds_frag(Lp + 30720);
              S[2] = MFMA32(a, bv[2], S[2]); }
            __builtin_amdgcn_sched_barrier(0); asm volatile("" ::: "memory");
            { const bf16x8 a = rg1; rg1 = lds_frag(Lp + 31744);
              S[2] = MFMA32(a, bv[3], S[2]); }
            __builtin_amdgcn_sched_barrier(0); asm volatile("" ::: "memory");
            { const bf16x8 a = rg2;
              HG_DECAY(3);
              S[3] = MFMA32(a, bv[0], S[3]); }
            __builtin_amdgcn_sched_barrier(0); asm volatile("" ::: "memory");
            { const bf16x8 a = rg3;
              S[3] = MFMA32(a, bv[1], S[3]); }
            __builtin_amdgcn_sched_barrier(0); asm volatile("" ::: "memory");
            { const bf16x8 a = rg0;
              S[3] = MFMA32(a, bv[2], S[3]); }
            __builtin_amdgcn_sched_barrier(0); asm volatile("" ::: "memory");
            { const bf16x8 a = rg1;
              S[3] = MFMA32(a, bv[3], S[3]); }
            __builtin_amdgcn_sched_barrier(0); asm volatile("" ::: "memory");
#undef HG_DECAY
            chain_stage_o(F.lds + OST_OFF + (n & 1) * OST_BUF + (F.wave & 1) * OST_SLICE, o, r, hg);
        }
        if (HELPER_WAVE(F.wave)) { const int hx = HELPER_IDX(F.wave); chain_helper_step(F, 0, b, h, sl0, n, hx, lane); }
    }
    if (HELPER_WAVE(F.wave)) asm volatile("s_waitcnt vmcnt(0)" ::: "memory");
    __syncthreads();
    if (HELPER_WAVE(F.wave)) { const int hx = HELPER_IDX(F.wave); chain_helper_step(F, 0, b, h, sl0, SEQ / 64, hx, F.lane); }
    __syncthreads();
}

__device__ __forceinline__ float softplus2(float x) { return x > 20.f ? x : log1pf(__expf(x)); }
#define MFMA16F(a, b, c) __builtin_amdgcn_mfma_f32_16x16x4f32((a), (b), (c), 0, 0, 0)
struct DnRaw { v4u q[3], k[3], v[3]; float a, bl; };
__device__ __forceinline__ void dn_raw_load(DnRaw& r, Frame& F, int unit, int tid, int lane) {
    const int h = unit & 3, n = (unit >> 2) & 127, b = unit >> 9; const size_t row0 = (size_t)b * SEQ + 64 * n;
    const bf16* P4 = (const bf16*)(F.ws + WS_P) + 4 * PLANE; const bf16* P5 = P4 + PLANE; const bf16* P6 = (const bf16*)(F.ws + WS_P) + 3 * PLANE;
#pragma unroll
    for (int i = 0; i < 3; ++i) { const int idx = tid + 512 * i, rr = idx >> 4, d8 = (idx & 15) * 8;
        v4u qv = (v4u){0u, 0u, 0u, 0u}, kv = qv, vv = qv;
        if (idx < 67 * 16 && 64 * n + rr >= 3) { const size_t off = (row0 + rr - 3) * 512 + 128 * h + d8; qv = *(const GAS v4u*)(P4 + off); kv = *(const GAS v4u*)(P5 + off); vv = *(const GAS v4u*)(P6 + off); }
        r.q[i] = qv; r.k[i] = kv; r.v[i] = vv; }
    const float* ab = (const float*)(F.ws + WS_AB);
    r.a = ab[(row0 + lane) * 8 + h]; r.bl = ab[(row0 + lane) * 8 + 4 + h];
}
struct DnConst { float na, dtb; float cwq[4][2], cwk[4][2], cwv[4][2]; };
__device__ __forceinline__ void prep_dn_unit(Frame& F, int l, int unit, const DnRaw& raw, const DnConst& dc) {
    const int h = unit & 3, n = (unit >> 2) & 127, b = unit >> 9;
    const size_t row0 = (size_t)b * SEQ + 64 * n;
    LAS unsigned char* L = F.lds;
    LAS unsigned char* RQ = L; LAS unsigned char* RK = L + 17152; LAS unsigned char* RV = L + 34304;
    LAS float* AM = (LAS float*)L; LAS float* TM = (LAS float*)(L + 17408); LAS unsigned char* TB = L; LAS unsigned char* ATT = L + 34816;
    LAS unsigned char* QN = L + 51456; LAS unsigned char* KN = L + 68864; LAS unsigned char* QG = L + 86272; LAS unsigned char* WN = QN;
    LAS unsigned char* XT = L + 103680; LAS unsigned char* VT = L + 122112; LAS unsigned char* KDT = L + 140544;
    LAS float* GCA = (LAS float*)(L + 158976); LAS float* BEA = (LAS float*)(L + 159232);
    const bf16* P4 = (const bf16*)(F.ws + WS_P) + 4 * PLANE; const bf16* P5 = P4 + PLANE; const bf16* P6 = (const bf16*)(F.ws + WS_P) + 3 * PLANE;
    const float* ab = (const float*)(F.ws + WS_AB);
    unsigned char* ub = F.ws + WS_DNB + (size_t)((b * 4 + h) * 128 + n) * DN_UNIT;
    const int w = F.wave; int lane = F.lane; asm volatile("" : "+v"(lane));
    const int d0 = 2 * lane, r = lane & 31, hg = lane >> 5;
#pragma unroll
    for (int i = 0; i < 3; ++i) { const int idx = F.tid + 512 * i, rr = idx >> 4, d8 = (idx & 15) * 8;
        if (idx < 67 * 16) { *(LAS v4u*)(RQ + rr * 256 + 2 * d8) = raw.q[i]; *(LAS v4u*)(RK + rr * 256 + 2 * d8) = raw.k[i]; *(LAS v4u*)(RV + rr * 256 + 2 * d8) = raw.v[i]; } }
    float gc, beta;
    { const float a = raw.a, bl = raw.bl;
      float x = dc.na * softplus2(a + dc.dtb);
#pragma unroll
      for (int o = 1; o < 64; o <<= 1) { const float y = __shfl_up(x, o); if (lane >= o) x += y; }
      gc = x; beta = sigmf(bl);
      if (w == 0) { GCA[lane] = gc; BEA[lane] = beta; } }
    const float glast = __shfl(gc, 63);
    __syncthreads();
#ifndef DUP_PB
#define DUP_PB 1
#endif
    _Pragma("unroll") for (int rpb_ = 0; rpb_ < DUP_PB; ++rpb_)
    {
        float cwq[4][2], cwk[4][2], cwv[4][2];
#pragma unroll
        for (int j = 0; j < 4; ++j) { cwq[j][0] = dc.cwq[j][0]; cwq[j][1] = dc.cwq[j][1]; cwk[j][0] = dc.cwk[j][0]; cwk[j][1] = dc.cwk[j][1]; cwv[j][0] = dc.cwv[j][0]; cwv[j][1] = dc.cwv[j][1]; }
        unsigned rq[11], rk[11], rv[11];
#pragma unroll
        for (int i = 0; i < 11; ++i) { rq[i] = *(const LAS unsigned*)(RQ + (8 * w + i) * 256 + 2 * d0); rk[i] = *(const LAS unsigned*)(RK + (8 * w + i) * 256 + 2 * d0); rv[i] = *(const LAS unsigned*)(RV + (8 * w + i) * 256 + 2 * d0); }
        unsigned xt[2][4], vt[2][4], kd[2][4];
#pragma unroll
        for (int i = 0; i < 8; ++i) {
            float cq[2] = {0.f, 0.f}, ck[2] = {0.f, 0.f}, cv[2] = {0.f, 0.f};
#pragma unroll
            for (int j = 0; j < 4; ++j) { cq[0] += cwq[j][0] * bflo(rq[i + j]); cq[1] += cwq[j][1] * bfhi(rq[i + j]); ck[0] += cwk[j][0] * bflo(rk[i + j]); ck[1] += cwk[j][1] * bfhi(rk[i + j]);
                cv[0] += cwv[j][0] * bflo(rv[i + j]); cv[1] += cwv[j][1] * bfhi(rv[i + j]); }
#pragma unroll
            for (int e = 0; e < 2; ++e) { cq[e] *= sigmf(cq[e]); ck[e] *= sigmf(ck[e]); cv[e] *= sigmf(cv[e]); }
            const float sq = wave_sum(cq[0] * cq[0] + cq[1] * cq[1]), sk = wave_sum(ck[0] * ck[0] + ck[1] * ck[1]);
            const float rqn = __builtin_amdgcn_rsqf(sq + EPSF) * 0.08838834764831845f, rkn = __builtin_amdgcn_rsqf(sk + EPSF);
            const int t = 8 * w + i;
            const float gci = __shfl(gc, t), bei = __shfl(beta, t);
            const float eg = __expf(gci), ed = __expf(glast - gci);
            const float q0 = cq[0] * rqn, q1 = cq[1] * rqn, k0 = ck[0] * rkn, k1 = ck[1] * rkn;
            *(LAS unsigned*)(QN + t * PQ + 2 * d0) = pk2(q0, q1); *(LAS unsigned*)(KN + t * PQ + 2 * d0) = pk2(k0, k1); *(LAS unsigned*)(QG + t * PQ + 2 * d0) = pk2(q0 * eg, q1 * eg);
            const unsigned x0 = f2bf(k0 * bei * eg), x1 = f2bf(k1 * bei * eg), v0 = f2bf(cv[0] * bei), v1 = f2bf(cv[1] * bei), e0 = f2bf(k0 * ed), e1 = f2bf(k1 * ed);
            if (i & 1) { xt[0][i >> 1] |= x0 << 16; xt[1][i >> 1] |= x1 << 16; vt[0][i >> 1] |= v0 << 16; vt[1][i >> 1] |= v1 << 16; kd[0][i >> 1] |= e0 << 16; kd[1][i >> 1] |= e1 << 16; }
            else { xt[0][i >> 1] = x0; xt[1][i >> 1] = x1; vt[0][i >> 1] = v0; vt[1][i >> 1] = v1; kd[0][i >> 1] = e0; kd[1][i >> 1] = e1; }
        }
#pragma unroll
        for (int e = 0; e < 2; ++e) {
            *(LAS v4u*)(XT + (d0 + e) * PT + 16 * w) = (v4u){xt[e][0], xt[e][1], xt[e][2], xt[e][3]};
            *(LAS v4u*)(VT + (d0 + e) * PT + 16 * w) = (v4u){vt[e][0], vt[e][1], vt[e][2], vt[e][3]};
            *(LAS v4u*)(KDT + (d0 + e) * PT + 16 * w) = (v4u){kd[e][0], kd[e][1], kd[e][2], kd[e][3]}; }
    }
    __syncthreads();
    if (w < 6) {
        const int tsel = w % 3, m = tsel >= 1 ? 1 : 0, mp = tsel == 2 ? 1 : 0;
        const LAS unsigned char* Asrc = w < 3 ? KN : QN;
        f32x16 acc = zero16();
#pragma unroll
        for (int ks = 0; ks < 8; ++ks) acc = MFMA32(lds_frag(Asrc + (32 * m + r) * PQ + 32 * ks + 16 * hg), lds_frag(KN + (32 * mp + r) * PQ + 32 * ks + 16 * hg), acc);
        const int jj = 32 * mp + r; const float gj = GCA[jj];
#pragma unroll
        for (int i = 0; i < 16; ++i) { const int ii = 32 * m + (i & 3) + 8 * (i >> 2) + 4 * hg; const float gi = GCA[ii];
            const float bei = BEA[ii], ex = __expf(fminf(gi - gj, 0.f));
            const float va = (jj < ii ? 1.f : 0.f) * (acc[i] * bei * ex), vq = (jj <= ii ? 1.f : 0.f) * (acc[i] * ex);
            if (w < 3) AM[ii * 68 + jj] = va; else *(LAS bf16*)(ATT + ii * PT + 2 * jj) = (bf16)f2bf(vq); }
    } else if (w == 6) {
#pragma unroll
        for (int i = 0; i < 16; ++i) *(LAS bf16*)(ATT + (2 * i + hg) * PT + 2 * (32 + r)) = 0;
    }
    __syncthreads();
#ifndef DUP_INV
#define DUP_INV 1
#endif
    _Pragma("unroll") for (int rpi_ = 0; rpi_ < DUP_INV; ++rpi_) {
    if (w == 0) {
        const int kb = lane >> 4, c = lane & 15;
        float x[16];
#pragma unroll
        for (int i = 0; i < 16; ++i) { float s = (i == c) ? 1.f : 0.f;
#pragma unroll
            for (int j4 = 0; j4 < (i + 3) / 4; ++j4) { const f32x4 a = *(const LAS f32x4*)(AM + (16 * kb + i) * 68 + 16 * kb + 4 * j4);
#pragma unroll
                for (int e = 0; e < 4; ++e) if (4 * j4 + e < i) s -= a[e] * x[4 * j4 + e]; }
            x[i] = s; }
#pragma unroll
        for (int i = 0; i < 16; ++i) TM[(16 * kb + i) * 68 + 16 * kb + c] = x[i];
    }
    __syncthreads();
#pragma unroll
    for (int lev = 1; lev <= 3; ++lev) {
        if (w < 4 - lev) { const int bi = w + lev, bk = w; const int li = lane & 15, lq = lane >> 4;
            f32x4 Mx = (f32x4){0.f, 0.f, 0.f, 0.f};
            for (int bj = bk; bj < bi; ++bj)
#pragma unroll
                for (int ks = 0; ks < 4; ++ks) Mx = MFMA16F(AM[(16 * bi + li) * 68 + 16 * bj + 4 * ks + lq], TM[(16 * bj + 4 * ks + lq) * 68 + 16 * bk + li], Mx);
            f32x4 Tx = (f32x4){0.f, 0.f, 0.f, 0.f};
#pragma unroll
            for (int e = 0; e < 4; ++e) Tx = MFMA16F(TM[(16 * bi + li) * 68 + 16 * bi + 4 * lq + e], Mx[e], Tx);
#pragma unroll
            for (int e = 0; e < 4; ++e) TM[(16 * bi + 4 * lq + e) * 68 + 16 * bk + li] = -Tx[e];
        }
        __syncthreads();
    }
    }
    { float tv[8];
#pragma unroll
      for (int i = 0; i < 8; ++i) { const int idx = F.tid + 512 * i, ii = idx >> 6, jj = idx & 63; tv[i] = (jj >> 4) > (ii >> 4) ? 0.f : TM[ii * 68 + jj]; }
      __syncthreads();
#pragma unroll
      for (int i = 0; i < 8; ++i) { const int idx = F.tid + 512 * i, ii = idx >> 6, jj = idx & 63; *(LAS bf16*)(TB + ii * PT + 2 * jj) = (bf16)f2bf(tv[i]); } }
    __syncthreads();
    {
        const int nt = w & 3; const LAS unsigned char* Bsrc = w < 4 ? XT : VT;
        f32x16 acc[2] = {zero16(), zero16()};
#pragma unroll
        for (int ks = 0; ks < 4; ++ks) { const bf16x8 bfr = lds_frag(Bsrc + (32 * nt + r) * PT + 32 * ks + 16 * hg);
            if (ks < 2) acc[0] = MFMA32(lds_frag(TB + r * PT + 32 * ks + 16 * hg), bfr, acc[0]);
            acc[1] = MFMA32(lds_frag(TB + (32 + r) * PT + 32 * ks + 16 * hg), bfr, acc[1]); }
        if (w < 4) {
#pragma unroll
            for (int m = 0; m < 2; ++m)
#pragma unroll
                for (int i = 0; i < 16; ++i) *(LAS bf16*)(WN + (32 * m + (i & 3) + 8 * (i >> 2) + 4 * hg) * PQ + 2 * (32 * nt + r)) = (bf16)f2bf(-acc[m][i]);
        } else {
#pragma unroll
            for (int m = 0; m < 2; ++m) { v4u o0, o1;
                o0.x = pk2(acc[m][0], acc[m][1]); o0.y = pk2(acc[m][2], acc[m][3]); o0.z = pk2(acc[m][4], acc[m][5]); o0.w = pk2(acc[m][6], acc[m][7]);
                o1.x = pk2(acc[m][8], acc[m][9]); o1.y = pk2(acc[m][10], acc[m][11]); o1.z = pk2(acc[m][12], acc[m][13]); o1.w = pk2(acc[m][14], acc[m][15]);
                GAS v4u* dst = (GAS v4u*)(ub + 58368 + nt * 4096 + m * 2048 + lane * 32); dst[0] = o0; dst[1] = o1; }
        }
    }
    __syncthreads();
#ifndef DUP_PF
#define DUP_PF 1
#endif
    _Pragma("unroll") for (int rpf_ = 0; rpf_ < DUP_PF; ++rpf_) {
#pragma unroll
    for (int i = 0; i < 2; ++i) { const int f = w + 8 * i, m = f >> 3, kt = f & 7;
        { const LAS unsigned char* src = WN + (32 * m + r) * PQ + 2 * (16 * kt + 4 * hg); const v2u a = *(const LAS v2u*)src, c = *(const LAS v2u*)(src + 16);
          *(GAS v4u*)(ub + f * 1024 + lane * 16) = (v4u){a.x, a.y, c.x, c.y}; }
        { const LAS unsigned char* src = QG + (32 * m + r) * PQ + 2 * (16 * kt + 4 * hg); const v2u a = *(const LAS v2u*)src, c = *(const LAS v2u*)(src + 16);
          *(GAS v4u*)(ub + 16384 + f * 1024 + lane * 16) = (v4u){a.x, a.y, c.x, c.y}; } }
#pragma unroll
    for (int i = 0; i < 2; ++i) { const int f = w + 8 * i, t4 = f >> 2, ktp = f & 3;
        const LAS unsigned char* src = KDT + (32 * t4 + r) * PT + 2 * (16 * ktp + 4 * hg); const v2u a = *(const LAS v2u*)src, c = *(const LAS v2u*)(src + 16);
        *(GAS v4u*)(ub + 32768 + f * 1024 + lane * 16) = (v4u){a.x, a.y, c.x, c.y}; }
    { const int f = w, m = f >> 2, ktp = f & 3;
        const LAS unsigned char* src = ATT + (32 * m + r) * PT + 2 * (16 * ktp + 4 * hg); const v2u a = *(const LAS v2u*)src, c = *(const LAS v2u*)(src + 16);
        *(GAS v4u*)(ub + 49152 + f * 1024 + lane * 16) = (v4u){a.x, a.y, c.x, c.y}; }
    }
    if (F.tid == 0) *(GAS float*)(ub + 57344) = __expf(glast);
    __syncthreads();
}

__device__ __forceinline__ void scan_dn_chain(Frame& F, int bh, int sl0) {
    const int sl = sl0 + (F.wave & 1);
    const int b = bh >> 2, h = bh & 3;
    bf16* oraw = (bf16*)(F.ws + WS_ORAW) + PLANE;
    f32x16 S[4];
#pragma unroll
    for (int t = 0; t < 4; ++t) S[t] = zero16();
#define DN_ISSUE(nn, bufo) do { const int unit_ = (b * 4 + h) * 128 + (nn); const unsigned char* ub_ = F.ws + WS_DNB + (size_t)unit_ * DN_UNIT; \
        for (int f = LOADER_F0(F.wave); f < 65; f += LOADER_STRIDE) { const unsigned char* src = ub_ + f * 1024 + (f >= 57 ? sl0 * 4096 : 0);     \
            __builtin_amdgcn_global_load_lds((const unsigned*)(src + lane * 16), (LAS unsigned*)(F.lds + (bufo) + f * 1024), 16, 0, SCAN_AUX); } } while (0)
    { const int lane = F.lane; if (LOADER_WAVE(F.wave)) DN_ISSUE(0, 0); }
    for (int n = 0; n < SEQ / 64; ++n) {
        int lane = F.lane; asm volatile("" : "+v"(lane));
        const int r = lane & 31, hg = lane >> 5;
        LAS unsigned char* L = F.lds + (n & 1) * 66560;
        if (HELPER_WAVE(F.wave) && n >= 2) asm volatile("s_waitcnt vmcnt(4)" ::: "memory"); else if (F.wave >= 2) asm volatile("s_waitcnt vmcnt(0)" ::: "memory");
        __syncthreads();
        if (LOADER_WAVE(F.wave) && n + 1 < SEQ / 64) DN_ISSUE(n + 1, ((n + 1) & 1) * 66560);
        if (F.wave < 2) {
            const size_t row0 = (size_t)b * SEQ + 64 * n;
            const LAS unsigned char* Lp = L + lane * 16;
            bf16x8 bs[8];
#pragma unroll
            for (int kt = 0; kt < 8; ++kt) bs[kt] = pack_half(S[kt >> 1], kt & 1);
            f32x16 vn[2], o[2] = {zero16(), zero16()};
#pragma unroll
            for (int m = 0; m < 2; ++m) { const v4u u0 = *(const LAS v4u*)(L + 58368 + (F.wave & 1) * 4096 + m * 2048 + lane * 32), u1 = *(const LAS v4u*)(L + 58368 + (F.wave & 1) * 4096 + m * 2048 + lane * 32 + 16);
                vn[m][0] = bflo(u0.x); vn[m][1] = bfhi(u0.x); vn[m][2] = bflo(u0.y); vn[m][3] = bfhi(u0.y); vn[m][4] = bflo(u0.z); vn[m][5] = bfhi(u0.z); vn[m][6] = bflo(u0.w); vn[m][7] = bfhi(u0.w);
                vn[m][8] = bflo(u1.x); vn[m][9] = bfhi(u1.x); vn[m][10] = bflo(u1.y); vn[m][11] = bfhi(u1.y); vn[m][12] = bflo(u1.z); vn[m][13] = bfhi(u1.z); vn[m][14] = bflo(u1.w); vn[m][15] = bfhi(u1.w); }
            const float dl = *(const LAS float*)(L + 57344);
            bf16x8 bv[4];
#if SCAN_DUMMY
            f32x16 dmy = zero16();
#endif
            bf16x8 rg0 = lds_frag(Lp + 0);
            bf16x8 rg1 = lds_frag(Lp + 1024);
            bf16x8 rg2 = lds_frag(Lp + 2048);
            bf16x8 rg3 = lds_frag(Lp + 3072);
            bf16x8 rg4 = lds_frag(Lp + 4096);
            bf16x8 rg5 = lds_frag(Lp + 5120);
            bf16x8 rg6 = lds_frag(Lp + 6144);
            bf16x8 rg7 = lds_frag(Lp + 7168);
            { const bf16x8 a = rg0; rg0 = lds_frag(Lp + 8192);
              vn[0] = MFMA32(a, bs[0], vn[0]); }
            __builtin_amdgcn_sched_barrier(0);
            { const bf16x8 a = rg1; rg1 = lds_frag(Lp + 9216);
              vn[0] = MFMA32(a, bs[1], vn[0]); }
            __builtin_amdgcn_sched_barrier(0);
            { const bf16x8 a = rg2; rg2 = lds_frag(Lp + 10240);
              vn[0] = MFMA32(a, bs[2], vn[0]); }
            __builtin_amdgcn_sched_barrier(0);
            { const bf16x8 a = rg3; rg3 = lds_frag(Lp + 11264);
              vn[0] = MFMA32(a, bs[3], vn[0]); }
            __builtin_amdgcn_sched_barrier(0);
            { const bf16x8 a = rg4; rg4 = lds_frag(Lp + 12288);
              vn[0] = MFMA32(a, bs[4], vn[0]); }
            __builtin_amdgcn_sched_barrier(0);
            { const bf16x8 a = rg5; rg5 = lds_frag(Lp + 13312);
              vn[0] = MFMA32(a, bs[5], vn[0]); }
            __builtin_amdgcn_sched_barrier(0);
            { const bf16x8 a = rg6; rg6 = lds_frag(Lp + 14336);
              vn[0] = MFMA32(a, bs[6], vn[0]); }
            __builtin_amdgcn_sched_barrier(0);
            { const bf16x8 a = rg7; rg7 = lds_frag(Lp + 15360);
              vn[0] = MFMA32(a, bs[7], vn[0]); }
            __builtin_amdgcn_sched_barrier(0);
            { const bf16x8 a = rg0; rg0 = lds_frag(Lp + 16384);
              vn[1] = MFMA32(a, bs[0], vn[1]); }
            __builtin_amdgcn_sched_barrier(0);
            { const bf16x8 a = rg1; rg1 = lds_frag(Lp + 17408);
              vn[1] = MFMA32(a, bs[1], vn[1]); }
            __builtin_amdgcn_sched_barrier(0);
            { const bf16x8 a = rg2; rg2 = lds_frag(Lp + 18432);
              vn[1] = MFMA32(a, bs[2], vn[1]); }
            __builtin_amdgcn_sched_barrier(0);
            { const bf16x8 a = rg3; rg3 = lds_frag(Lp + 19456);
              vn[1] = MFMA32(a, bs[3], vn[1]); }
            __builtin_amdgcn_sched_barrier(0);
            { const bf16x8 a = rg4; rg4 = lds_frag(Lp + 20480);
              vn[1] = MFMA32(a, bs[4], vn[1]); }
            __builtin_amdgcn_sched_barrier(0);
            { const bf16x8 a = rg5; rg5 = lds_frag(Lp + 21504);
              vn[1] = MFMA32(a, bs[5], vn[1]); }
            __builtin_amdgcn_sched_barrier(0);
            { const bf16x8 a = rg6; rg6 = lds_frag(Lp + 22528);
              vn[1] = MFMA32(a, bs[6], vn[1]); }
            __builtin_amdgcn_sched_barrier(0);
            { const bf16x8 a = rg7; rg7 = lds_frag(Lp + 23552);
              vn[1] = MFMA32(a, bs[7], vn[1]); }
            __builtin_amdgcn_sched_barrier(0);
            { const bf16x8 a = rg0; rg0 = lds_frag(Lp + 24576);
              o[0] = MFMA32(a, bs[0], o[0]);
#if SCAN_DUMMY
              dmy = MFMA32(a, bs[0], dmy);
#endif
              }
            __builtin_amdgcn_sched_barrier(0);
            { const bf16x8 a = rg1; rg1 = lds_frag(Lp + 25600);
              o[0] = MFMA32(a, bs[1], o[0]);
#if SCAN_DUMMY
              dmy = MFMA32(a, bs[1], dmy);
#endif
              }
            __builtin_amdgcn_sched_barrier(0);
            { const bf16x8 a = rg2; rg2 = lds_frag(Lp + 26624);
              o[0] = MFMA32(a, bs[2], o[0]);
#if SCAN_DUMMY
              dmy = MFMA32(a, bs[2], dmy);
#endif
              }
            __builtin_amdgcn_sched_barrier(0);
            { const bf16x8 a = rg3; rg3 = lds_frag(Lp + 27648);
              o[0] = MFMA32(a, bs[3], o[0]);
#if SCAN_DUMMY
              dmy = MFMA32(a, bs[3], dmy);
#endif
              }
            __builtin_amdgcn_sched_barrier(0);
            { const bf16x8 a = rg4; rg4 = lds_frag(Lp + 28672);
              o[0] = MFMA32(a, bs[4], o[0]);
#if SCAN_DUMMY
              dmy = MFMA32(a, bs[4], dmy);
#endif
              }
            __builtin_amdgcn_sched_barrier(0);
            { const bf16x8 a = rg5; rg5 = lds_frag(Lp + 29696);
              o[0] = MFMA32(a, bs[5], o[0]);
#if SCAN_DUMMY
              dmy = MFMA32(a, bs[5], dmy);
#endif
              }
            __builtin_amdgcn_sched_barrier(0);
            { const bf16x8 a = rg6; rg6 = lds_frag(Lp + 30720);
              o[0] = MFMA32(a, bs[6], o[0]);
#if SCAN_DUMMY
              dmy = MFMA32(a, bs[6], dmy);
#endif
              }
            __builtin_amdgcn_sched_barrier(0);
            { const bf16x8 a = rg7; rg7 = lds_frag(Lp + 31744);
              o[0] = MFMA32(a, bs[7], o[0]);
#if SCAN_DUMMY
              dmy = MFMA32(a, bs[7], dmy);
#endif
              }
            __builtin_amdgcn_sched_barrier(0);
            { const bf16x8 a = rg0; rg0 = lds_frag(Lp + 49152);
              o[1] = MFMA32(a, bs[0], o[1]);
#if SCAN_DUMMY
              dmy = MFMA32(a, bs[0], dmy);
#endif
              }
            __builtin_amdgcn_sched_barrier(0);
            { const bf16x8 a = rg1; rg1 = lds_frag(Lp + 50176);
              o[1] = MFMA32(a, bs[1], o[1]);
#if SCAN_DUMMY
              dmy = MFMA32(a, bs[1], dmy);
#endif
              }
            __builtin_amdgcn_sched_barrier(0);
            { const bf16x8 a = rg2; rg2 = lds_frag(Lp + 53248);
              o[1] = MFMA32(a, bs[2], o[1]);
#if SCAN_DUMMY
              dmy = MFMA32(a, bs[2], dmy);
#endif
              }
            __builtin_amdgcn_sched_barrier(0);
            { const bf16x8 a = rg3; rg3 = lds_frag(Lp + 54272);
              o[1] = MFMA32(a, bs[3], o[1]);
#if SCAN_DUMMY
              dmy = MFMA32(a, bs[3], dmy);
#endif
              }
            __builtin_amdgcn_sched_barrier(0);
            { const bf16x8 a = rg4; rg4 = lds_frag(Lp + 55296);
              o[1] = MFMA32(a, bs[4], o[1]);
#if SCAN_DUMMY
              dmy = MFMA32(a, bs[4], dmy);
#endif
              }
            __builtin_amdgcn_sched_barrier(0);
            { const bf16x8 a = rg5; rg5 = lds_frag(Lp + 56320);
              o[1] = MFMA32(a, bs[5], o[1]);
#if SCAN_DUMMY
              dmy = MFMA32(a, bs[5], dmy);
#endif
              }
            __builtin_amdgcn_sched_barrier(0);
            { const bf16x8 a = rg6; rg6 = lds_frag(Lp + 32768);
              o[1] = MFMA32(a, bs[6], o[1]);
#if SCAN_DUMMY
              dmy = MFMA32(a, bs[6], dmy);
#endif
              }
            __builtin_amdgcn_sched_barrier(0);
            { const bf16x8 a = rg7; rg7 = lds_frag(Lp + 33792);
              o[1] = MFMA32(a, bs[7], o[1]);
#if SCAN_DUMMY
              dmy = MFMA32(a, bs[7], dmy);
#endif
              }
            __builtin_amdgcn_sched_barrier(0);
            { const bf16x8 a = rg0; rg0 = lds_frag(Lp + 34816);
              bv[0] = pack_half(vn[0], 0); bv[1] = pack_half(vn[0], 1); bv[2] = pack_half(vn[1], 0); bv[3] = pack_half(vn[1], 1);
              o[0] = MFMA32(a, bv[0], o[0]); }
            __builtin_amdgcn_sched_barrier(0);
            { const bf16x8 a = rg1; rg1 = lds_frag(Lp + 35840);
              o[0] = MFMA32(a, bv[1], o[0]); }
            __builtin_amdgcn_sched_barrier(0);
            { const bf16x8 a = rg2; rg2 = lds_frag(Lp + 36864);
              o[1] = MFMA32(a, bv[0], o[1]); }
            __builtin_amdgcn_sched_barrier(0);
            { const bf16x8 a = rg3; rg3 = lds_frag(Lp + 37888);
              o[1] = MFMA32(a, bv[1], o[1]); }
            __builtin_amdgcn_sched_barrier(0);
            { const bf16x8 a = rg4; rg4 = lds_frag(Lp + 38912);
              o[1] = MFMA32(a, bv[2], o[1]); }
            __builtin_amdgcn_sched_barrier(0);
            { const bf16x8 a = rg5; rg5 = lds_frag(Lp + 39936);
              o[1] = MFMA32(a, bv[3], o[1]); }
            __builtin_amdgcn_sched_barrier(0);
            { const bf16x8 a = rg6; rg6 = lds_frag(Lp + 40960);
              S[0] = S[0] * dl;
              S[0] = MFMA32(a, bv[0], S[0]); }
            __builtin_amdgcn_sched_barrier(0);
            { const bf16x8 a = rg7; rg7 = lds_frag(Lp + 41984);
              S[0] = MFMA32(a, bv[1], S[0]); }
            __builtin_amdgcn_sched_barrier(0);
            { const bf16x8 a = rg0; rg0 = lds_frag(Lp + 43008);
              S[0] = MFMA32(a, bv[2], S[0]); }
            __builtin_amdgcn_sched_barrier(0);
            { const bf16x8 a = rg1; rg1 = lds_frag(Lp + 44032);
              S[0] = MFMA32(a, bv[3], S[0]); }
            __builtin_amdgcn_sched_barrier(0);
            { const bf16x8 a = rg2; rg2 = lds_frag(Lp + 45056);
              S[1] = S[1] * dl;
              S[1] = MFMA32(a, bv[0], S[1]); }
            __builtin_amdgcn_sched_barrier(0);
            { const bf16x8 a = rg3; rg3 = lds_frag(Lp + 46080);
              S[1] = MFMA32(a, bv[1], S[1]); }
            __builtin_amdgcn_sched_barrier(0);
            { const bf16x8 a = rg4; rg4 = lds_frag(Lp + 47104);
              S[1] = MFMA32(a, bv[2], S[1]); }
            __builtin_amdgcn_sched_barrier(0);
            { const bf16x8 a = rg5; rg5 = lds_frag(Lp + 48128);
              S[1] = MFMA32(a, bv[3], S[1]); }
            __builtin_amdgcn_sched_barrier(0);
            { const bf16x8 a = rg6;
              S[2] = S[2] * dl;
              S[2] = MFMA32(a, bv[0], S[2]); }
            __builtin_amdgcn_sched_barrier(0);
            { const bf16x8 a = rg7;
              S[2] = MFMA32(a, bv[1], S[2]); }
            __builtin_amdgcn_sched_barrier(0);
            { const bf16x8 a = rg0;
              S[2] = MFMA32(a, bv[2], S[2]); }
            __builtin_amdgcn_sched_barrier(0);
            { const bf16x8 a = rg1;
              S[2] = MFMA32(a, bv[3], S[2]); }
            __builtin_amdgcn_sched_barrier(0);
            { const bf16x8 a = rg2;
              S[3] = S[3] * dl;
              S[3] = MFMA32(a, bv[0], S[3]); }
            __builtin_amdgcn_sched_barrier(0);
            { const bf16x8 a = rg3;
              S[3] = MFMA32(a, bv[1], S[3]); }
            __builtin_amdgcn_sched_barrier(0);
            { const bf16x8 a = rg4;
              S[3] = MFMA32(a, bv[2], S[3]); }
            __builtin_amdgcn_sched_barrier(0);
            { const bf16x8 a = rg5;
              S[3] = MFMA32(a, bv[3], S[3]); }
            __builtin_amdgcn_sched_barrier(0);
#if SCAN_DUMMY
            asm volatile("" :: "v"(dmy));
#endif
            chain_stage_o(F.lds + OST_OFF + (n & 1) * OST_BUF + (F.wave & 1) * OST_SLICE, o, r, hg);
        }
        if (HELPER_WAVE(F.wave)) { const int hx = HELPER_IDX(F.wave); chain_helper_step(F, 1, b, h, sl0, n, hx, lane); }
    }
    if (HELPER_WAVE(F.wave)) asm volatile("s_waitcnt vmcnt(0)" ::: "memory");
    __syncthreads();
    if (HELPER_WAVE(F.wave)) { const int hx = HELPER_IDX(F.wave); chain_helper_step(F, 1, b, h, sl0, SEQ / 64, hx, F.lane); }
    __syncthreads();
}
enum { MAT_INA = 0, MAT_INB, MAT_OHG, MAT_ODN, MAT_OUT, MAT_GU, MAT_DN, MAT_N };
__device__ __forceinline__ int colmap(int mat, int n) {
    switch (mat) {
        case MAT_INA: return n;
        case MAT_INB: return 4104 + n;
        case MAT_GU: { const int pn = n >> 8, r = n & 255; return r < 128 ? 128 * pn + r : DFF + 128 * pn + (r - 128); }
        default: return n;
    }
}
template <bool F8 = false>
__device__ __forceinline__ void transpose_item(const float* W, int K, int Nsrc, bf16* WT, int mat, const float* gain, LAS float* scr, int kb, int nb, int lane, int gmask = -1) {
    const int k0 = 64 * kb, n0 = 32 * nb;
    const int sc = colmap(mat, n0 + (lane & 31));
#pragma unroll 8
    for (int i = 0; i < 32; ++i) { const int kk = 2 * i + (lane >> 5);
        float v = 0.f; if (sc >= 0) { v = W[(size_t)(k0 + kk) * Nsrc + sc]; if (gain) v *= gain[(k0 + kk) & gmask]; }
        scr[kk * 33 + (lane & 31)] = v; }
    LDS_WAIT(); asm volatile("" ::: "memory");
    const int c = lane & 7;
#pragma unroll
    for (int j = 0; j < 4; ++j) { const int n = (lane >> 3) + 8 * j; const LAS float* s = scr + (8 * c) * 33 + n;
        if (F8) { v2u o; o.x = pk8(s[0 * 33] * W8_SCALE, s[1 * 33] * W8_SCALE, s[2 * 33] * W8_SCALE, s[3 * 33] * W8_SCALE); o.y = pk8(s[4 * 33] * W8_SCALE, s[5 * 33] * W8_SCALE, s[6 * 33] * W8_SCALE, s[7 * 33] * W8_SCALE);
            *(GAS v2u*)((unsigned char*)WT + (size_t)(n0 + n) * K + k0 + 8 * c) = o; }
        else { v4u o; o.x = pk2(s[0 * 33], s[1 * 33]); o.y = pk2(s[2 * 33], s[3 * 33]); o.z = pk2(s[4 * 33], s[5 * 33]); o.w = pk2(s[6 * 33], s[7 * 33]);
            *(GAS v4u*)(WT + (size_t)(n0 + n) * K + k0 + 8 * c) = o; } }
    LDS_WAIT(); asm volatile("" ::: "memory");
}
__device__ __forceinline__ void p0_weights(Frame& F) {
    LAS float* scr = (LAS float*)(F.lds + 32768 + F.wave * 8448);
    const int gw = blockIdx.x * NWAVES + F.wave, NGW = F.G * NWAVES;
    constexpr int I_INA = 16 * (N_INA / 32), I_INB = 16 * (N_INB / 32), I_OH = 8 * 32, I_OUT = 16 * 32, I_GU = 16 * (2 * DFF / 32), I_DN = (DFF / 64) * 32;
    constexpr int I_LAYER = I_INA + I_INB + 2 * I_OH + I_OUT + I_GU + I_DN;
    for (int it = gw; it < DEPTH * I_LAYER; it += NGW) {
        const int l = it / I_LAYER; int r = it % I_LAYER;
        bf16* wl = (bf16*)(F.ws + WS_W) + (size_t)l * W_LAYER;
        if (r < I_INA) { const int nblk = N_INA / 32; transpose_item(F.in[3] + (size_t)l * DM * INW, DM, INW, wl + W_INA, MAT_INA, F.in[2] + l * DM, scr, r / nblk, r % nblk, F.lane); continue; } r -= I_INA;
        if (r < I_INB) { const int nblk = N_INB / 32; transpose_item<true>(F.in[3] + (size_t)l * DM * INW, DM, INW, (bf16*)(F.ws + WS_W8 + (size_t)l * W8_LAYER), MAT_INB, F.in[2] + l * DM, scr, r / nblk, r % nblk, F.lane); continue; } r -= I_INB;
        if (r < I_OH) { transpose_item(F.in[9] + (size_t)l * 512 * DM, 512, DM, wl + W_O2, MAT_OHG, F.in[4] + l * HDIM, scr, r / 32, r % 32, F.lane, HDIM - 1); continue; }     r -= I_OH;
        if (r < I_OH) { transpose_item(F.in[10] + (size_t)l * 512 * DM, 512, DM, wl + W_O2 + (size_t)1024 * 512, MAT_ODN, F.in[8] + l * HDIM, scr, r / 32, r % 32, F.lane, HDIM - 1); continue; } r -= I_OH;
        if (r < I_OUT) { transpose_item(F.in[11] + (size_t)l * DM * DM, DM, DM, wl + W_OUT, MAT_OUT, nullptr, scr, r / 32, r % 32, F.lane); continue; } r -= I_OUT;
        if (r < I_GU) { const int nblk = 2 * DFF / 32; transpose_item(F.in[14] + (size_t)l * DM * 2 * DFF, DM, 2 * DFF, wl + W_GU, MAT_GU, F.in[13] + l * DM, scr, r / nblk, r % nblk, F.lane); continue; } r -= I_GU;
        transpose_item(F.in[15] + (size_t)l * DFF * DM, DFF, DM, wl + W_DN, MAT_DN, nullptr, scr, r / 32, r % 32, F.lane);
    }
}
__device__ __forceinline__ void wab_stage(Frame& F, int l) {
    __syncthreads();
    LAS float* W = (LAS float*)F.lds;
    const float* win = F.in[3] + (size_t)l * DM * INW + 4096; const float* gain = F.in[2] + l * DM;
#pragma unroll
    for (int i = 0; i < 2; ++i) { const int k = F.tid + 512 * i; const float g = gain[k];
        const f32x4 a = *(const GAS f32x4*)(win + (size_t)k * INW), c = *(const GAS f32x4*)(win + (size_t)k * INW + 4);
#pragma unroll
        for (int e = 0; e < 4; ++e) { W[e * 1024 + k] = a[e] * g; W[(4 + e) * 1024 + k] = c[e] * g; } }
    __syncthreads();
}
__device__ __forceinline__ void wab_row(Frame& F, const float* hn, int m) {
    const LAS float* W = (const LAS float*)F.lds;
    float r[8];
#pragma unroll
    for (int j = 0; j < 8; ++j) { const LAS f32x4* p = (const LAS f32x4*)(W + j * 1024) + 2 * F.lane; const f32x4 a = p[0], c = p[1], d = p[128], e = p[129];
        float s = 0.f;
#pragma unroll
        for (int t = 0; t < 4; ++t) s += hn[t] * a[t] + hn[4 + t] * c[t] + hn[8 + t] * d[t] + hn[12 + t] * e[t];
        r[j] = wave_sum(s); }
    if (F.lane == 0) { GAS f32x4* o = (GAS f32x4*)((float*)(F.ws + WS_AB) + (size_t)m * 8); o[0] = (f32x4){r[0], r[1], r[2], r[3]}; o[1] = (f32x4){r[4], r[5], r[6], r[7]}; }
}
__device__ __forceinline__ unsigned char* r8_row(Frame& F, int m) { return m < R8A_ROWS ? (unsigned char*)F.out + R8_OUT_OFF + (size_t)m * DM : F.ws + WS_R8B + (size_t)(m - R8A_ROWS) * DM; }
__device__ __forceinline__ void p0_row_load(f32x4 (&q)[4], Frame& F, int m) { const GAS f32x4* xr = (const GAS f32x4*)(F.in[0] + (size_t)m * DM) + 2 * F.lane; q[0] = xr[0]; q[1] = xr[1]; q[2] = xr[128]; q[3] = xr[129]; }
__device__ __forceinline__ void p0_row_finish(Frame& F, f32x4 (&cur)[4], int m, bf16* R, float* rstd) {
    float s = 0.f;
#pragma unroll
    for (int j = 0; j < 4; ++j) s += (cur[j].x * cur[j].x + cur[j].y * cur[j].y) + (cur[j].z * cur[j].z + cur[j].w * cur[j].w);
    const float rs = __builtin_amdgcn_rsqf(wave_sum(s) * (1.f / DM) + EPSF);
    if (F.lane == 0) rstd[m] = rs;
#pragma unroll
    for (int j = 0; j < 4; ++j) cur[j] = cur[j] * rs;
    { float hn[16];
#pragma unroll
      for (int j = 0; j < 4; ++j) { hn[4 * j] = cur[j].x; hn[4 * j + 1] = cur[j].y; hn[4 * j + 2] = cur[j].z; hn[4 * j + 3] = cur[j].w; }
      wab_row(F, hn, m); }
    GAS v4u* o8 = (GAS v4u*)(R + (size_t)m * DM) + F.lane;
    o8[0] = (v4u){pk2(cur[0].x, cur[0].y), pk2(cur[0].z, cur[0].w), pk2(cur[1].x, cur[1].y), pk2(cur[1].z, cur[1].w)};
    o8[64] = (v4u){pk2(cur[2].x, cur[2].y), pk2(cur[2].z, cur[2].w), pk2(cur[3].x, cur[3].y), pk2(cur[3].z, cur[3].w)};
    if (m < R8_ROWS) { GAS v2u* q8 = (GAS v2u*)r8_row(F, m) + F.lane;
        q8[0] = (v2u){pk8(cur[0].x, cur[0].y, cur[0].z, cur[0].w), pk8(cur[1].x, cur[1].y, cur[1].z, cur[1].w)};
        q8[64] = (v2u){pk8(cur[2].x, cur[2].y, cur[2].z, cur[2].w), pk8(cur[3].x, cur[3].y, cur[3].z, cur[3].w)}; }
}
__device__ __forceinline__ void p0_rows(Frame& F0) {
    Frame F = F0; asm volatile("" : "+v"(F.lane));
    const int gw = blockIdx.x * NWAVES + F.wave, NGW = F.G * NWAVES;
    bf16* R = (bf16*)(F.ws + WS_R); float* rstd = (float*)(F.ws + WS_RSTD);
    int m0 = gw;
    for (; m0 + 3 * NGW < MTOK; m0 += 4 * NGW) {
        f32x4 q[4][4];
#pragma unroll
        for (int u = 0; u < 4; ++u) p0_row_load(q[u], F, m0 + u * NGW);
#pragma unroll
        for (int u = 0; u < 4; ++u) p0_row_finish(F, q[u], m0 + u * NGW, R, rstd);
    }
    for (; m0 < MTOK; m0 += NGW) { f32x4 q1[4]; p0_row_load(q1, F, m0); p0_row_finish(F, q1, m0, R, rstd); }
}
struct RowRegs { v4u t[2]; v4u rb[2]; f32x4 rf[4]; float rs; };
template <bool RESID_F32>
__device__ __forceinline__ void row_load(RowRegs& a, const bf16* tin, const float* resid32, const bf16* R, const float* rs_in, int m, int lane) {
    const GAS v4u* tr = (const GAS v4u*)(tin + (size_t)m * DM) + lane; a.t[0] = tr[0]; a.t[1] = tr[64];
    if (RESID_F32) { const GAS f32x4* xr = (const GAS f32x4*)(resid32 + (size_t)m * DM) + 2 * lane; a.rf[0] = xr[0]; a.rf[1] = xr[1]; a.rf[2] = xr[128]; a.rf[3] = xr[129]; }
    else { const GAS v4u* rr = (const GAS v4u*)(R + (size_t)m * DM) + lane; a.rb[0] = rr[0]; a.rb[1] = rr[64]; int mv = m; asm volatile("" : "+v"(mv));
        a.rs = ((const GAS float*)rs_in)[mv]; }
}
__device__ __forceinline__ void unpack8(const v4u q, float* o) { o[0] = bflo(q.x); o[1] = bfhi(q.x); o[2] = bflo(q.y); o[3] = bfhi(q.y); o[4] = bflo(q.z); o[5] = bfhi(q.z); o[6] = bflo(q.w); o[7] = bfhi(q.w); }
template <bool RESID_F32, bool OUT_F32, bool WITH_AB>
__device__ __forceinline__ void row_finish(Frame& F, const RowRegs& cur, int m, const float (&wv)[16], float* out32, bf16* R, float* rstd) {
    float t[16], h[16];
    unpack8(cur.t[0], t); unpack8(cur.t[1], t + 8);
    if (RESID_F32) {
#pragma unroll
        for (int e = 0; e < 4; ++e) { h[e] = cur.rf[0][e]; h[4 + e] = cur.rf[1][e]; h[8 + e] = cur.rf[2][e]; h[12 + e] = cur.rf[3][e]; }
    } else { unpack8(cur.rb[0], h); unpack8(cur.rb[1], h + 8); const float ir = __builtin_amdgcn_rcpf(cur.rs);
#pragma unroll
        for (int e = 0; e < 16; ++e) h[e] *= ir; }
    float s = 0.f;
#pragma unroll
    for (int e = 0; e < 16; ++e) s += t[e] * t[e];
    const float r1 = __builtin_amdgcn_rsqf(wave_sum(s) * (1.f / DM) + EPSF);
    float s2 = 0.f;
#pragma unroll
    for (int e = 0; e < 16; ++e) { h[e] = h[e] + t[e] * r1 * wv[e]; s2 += h[e] * h[e]; }
    if (OUT_F32) {
        GAS f32x4* o = (GAS f32x4*)(out32 + (size_t)m * DM) + 2 * F.lane;
        o[0] = (f32x4){h[0], h[1], h[2], h[3]}; o[1] = (f32x4){h[4], h[5], h[6], h[7]}; o[128] = (f32x4){h[8], h[9], h[10], h[11]}; o[129] = (f32x4){h[12], h[13], h[14], h[15]};
    } else {
        const float rn = __builtin_amdgcn_rsqf(wave_sum(s2) * (1.f / DM) + EPSF);
        if (F.lane == 0) rstd[m] = rn;
#pragma unroll
        for (int e = 0; e < 16; ++e) h[e] *= rn;
        if (WITH_AB) wab_row(F, h, m);
        GAS v4u* o8 = (GAS v4u*)(R + (size_t)m * DM) + F.lane;
        o8[0] = (v4u){pk2(h[0], h[1]), pk2(h[2], h[3]), pk2(h[4], h[5]), pk2(h[6], h[7])};
        o8[64] = (v4u){pk2(h[8], h[9]), pk2(h[10], h[11]), pk2(h[12], h[13]), pk2(h[14], h[15])};
        if (WITH_AB && m < R8_ROWS) { GAS v2u* q8 = (GAS v2u*)r8_row(F, m) + F.lane;
            q8[0] = (v2u){pk8(h[0], h[1], h[2], h[3]), pk8(h[4], h[5], h[6], h[7])}; q8[64] = (v2u){pk8(h[8], h[9], h[10], h[11]), pk8(h[12], h[13], h[14], h[15])}; }
    }
}
template <bool RESID_F32, bool OUT_F32, bool WITH_AB = false>
__device__ __forceinline__ void rowpass(Frame& F0, const bf16* tin, const float* resid32, const float* w, float* out32, int rs_sel, int gw, int NGW, int MEND) {
    Frame F = F0; asm volatile("" : "+v"(F.lane));
    bf16* R = (bf16*)(F.ws + WS_R); const float* rs_in = (const float*)(F.ws + WS_RSTD) + (size_t)rs_sel * MTOK; float* rstd = (float*)(F.ws + WS_RSTD) + (size_t)(rs_sel ^ 1) * MTOK;
    float wv[16];
    { const GAS f32x4* wp = (const GAS f32x4*)w + 2 * F.lane; const f32x4 a = wp[0], b = wp[1], c = wp[128], d = wp[129];
#pragma unroll
      for (int e = 0; e < 4; ++e) { wv[e] = a[e]; wv[4 + e] = b[e]; wv[8 + e] = c[e]; wv[12 + e] = d[e]; } }
    int m0 = gw;
    for (; m0 + 3 * NGW < MEND; m0 += 4 * NGW) {
        RowRegs r[4];
#pragma unroll
        for (int u = 0; u < 4; ++u) row_load<RESID_F32>(r[u], tin, resid32, R, rs_in, m0 + u * NGW, F.lane);
#pragma unroll
        for (int u = 0; u < 4; ++u) row_finish<RESID_F32, OUT_F32, WITH_AB>(F, r[u], m0 + u * NGW, wv, out32, R, rstd);
    }
    for (; m0 < MEND; m0 += NGW) { RowRegs r1; row_load<RESID_F32>(r1, tin, resid32, R, rs_in, m0, F.lane); row_finish<RESID_F32, OUT_F32, WITH_AB>(F, r1, m0, wv, out32, R, rstd); }
}
__device__ __forceinline__ void panel_rendezvous(Frame& F, gu32* cnt) {
    if (F.tid == 0) {
        __hip_atomic_fetch_add(cnt, 1u, RLX_AGENT);
        const unsigned long long t0 = __builtin_amdgcn_s_memrealtime();
        while (__hip_atomic_load(cnt, RLX_AGENT) < 4u) {
            if (__builtin_amdgcn_s_memrealtime() - t0 > 2000000ull) { __hip_atomic_store(F.ctl + 0, 1u, RLX_AGENT); break; }
            __builtin_amdgcn_s_sleep(2); }
        __builtin_amdgcn_fence(__ATOMIC_ACQUIRE, "agent");
        asm volatile("s_waitcnt vmcnt(0)" ::: "memory");
    }
    __syncthreads();
}
__device__ __forceinline__ void post_phase(Frame& F, int l) {
    const int gw = blockIdx.x * NWAVES + F.wave, NGW = F.G * NWAVES;
    const bf16* oraw = (const bf16*)(F.ws + WS_ORAW); bf16* ocat = (bf16*)((unsigned char*)F.out + 128 * MiB);
    const bf16* planes = (const bf16*)(F.ws + WS_P);
    const int d0 = (8 * F.lane) & 127;
#pragma unroll
    for (int br = 0; br < 2; ++br) {
        float nw[8];
#pragma unroll
        for (int j = 0; j < 8; ++j) nw[j] = (br ? F.in[8] : F.in[4])[l * HDIM + d0 + j];
        const bf16* op = oraw + (size_t)br * PLANE; const bf16* gp = planes + (size_t)(br ? 7 : 6) * PLANE;   bf16* cp = ocat + (size_t)br * PLANE;
        for (int m0 = gw; m0 < MTOK; m0 += 4 * NGW) {
            v4u ov[4], gv[4];
#pragma unroll
            for (int u = 0; u < 4; ++u) { const int m = m0 + u * NGW; if (m < MTOK) { ov[u] = *(const GAS v4u*)(op + (size_t)m * 512 + 8 * F.lane); gv[u] = *(const GAS v4u*)(gp + (size_t)m * 512 + 8 * F.lane); } }
#pragma unroll
            for (int u = 0; u < 4; ++u) { const int m = m0 + u * NGW; if (m < MTOK) {
                const float o[8] = {bflo(ov[u].x), bfhi(ov[u].x), bflo(ov[u].y), bfhi(ov[u].y), bflo(ov[u].z), bfhi(ov[u].z), bflo(ov[u].w), bfhi(ov[u].w)};
                const float g[8] = {bflo(gv[u].x), bfhi(gv[u].x), bflo(gv[u].y), bfhi(gv[u].y), bflo(gv[u].z), bfhi(gv[u].z), bflo(gv[u].w), bfhi(gv[u].w)};
                float s = 0.f;
#pragma unroll
                for (int j = 0; j < 8; ++j) s += o[j] * o[j];
                s += __builtin_bit_cast(float, __builtin_amdgcn_update_dpp(0, __builtin_bit_cast(int, s), 0xB1, 0xF, 0xF, true));
                s += __builtin_bit_cast(float, __builtin_amdgcn_update_dpp(0, __builtin_bit_cast(int, s), 0x4E, 0xF, 0xF, true));
                s += __builtin_bit_cast(float, __builtin_amdgcn_update_dpp(0, __builtin_bit_cast(int, s), 0x141, 0xF, 0xF, true));
                s += __builtin_bit_cast(float, __builtin_amdgcn_update_dpp(0, __builtin_bit_cast(int, s), 0x140, 0xF, 0xF, true));
                const float rs = __builtin_amdgcn_rsqf(s * (1.f / HDIM) + EPSF);
                float r[8];
#pragma unroll
                for (int j = 0; j < 8; ++j) r[j] = o[j] * rs * nw[j] * (g[j] * sigmf(g[j]));
                v4u w; w.x = pk2(r[0], r[1]); w.y = pk2(r[2], r[3]); w.z = pk2(r[4], r[5]); w.w = pk2(r[6], r[7]);
                *(GAS v4u*)(cp + (size_t)m * 512 + 8 * F.lane) = w; } }
        }
    }
}

#ifndef DUP_MASK
#define DUP_MASK 0
#endif
#define REP(k) _Pragma("unroll") for (int rep_ = 0; rep_ < (((DUP_MASK >> (k)) & 1) ? 2 : 1); ++rep_)
#define IN(k) (lo <= (k) && (k) < hi)
#ifndef DOUBLE_BAR
#define DOUBLE_BAR 0
#endif
#define SEAM(k) do { if (IN(k) && IN((k) + 1)) { xcd_barrier(bar); if (DOUBLE_BAR) xcd_barrier(bar); } } while (0)
#ifndef SPLIT_WGM
#define SPLIT_WGM 4
#endif
#ifndef G2_ALIGN
#define G2_ALIGN true
#endif
#ifndef GA_HG
#define GA_HG 1
#endif
#ifndef GA_DN
#define GA_DN 1
#endif
template <int l> __device__ __forceinline__ void layer_phases(Frame& F, const XcdBarrier& bar, const int lo, const int hi) {
        const int pb = 1 + 11 * l;
        const pg8::bf16_t* wl = (const pg8::bf16_t*)(F.ws + WS_W) + (size_t)l * W_LAYER;
        pg8::bf16_t* Rb = (pg8::bf16_t*)(F.ws + WS_R);
        REP(0) if (IN(pb + 0)) {
            pg8::Gemm g{Rb, wl + W_INA, MTOK, N_INA, DM}; pg8::StaticOrder S; S.init(MTOK, N_INA, F.G, (int)blockIdx.x);
            pg8::EpiProjA E{(pg8::bf16_t*)(F.ws + WS_P), PLANE};
            pg8::gemm_phase<pg8::EpiProjA, pg8::StaticOrder, PG8_ALIGN, PG8_SP2>(F.lds, g, S, E);
        }
        SEAM(pb + 0);
        REP(1) if (IN(pb + 1)) {
            { int u = blockIdx.x;
              if (u < NUNIT) { hg_dma_issue(F, u, F.lane); asm volatile("s_waitcnt vmcnt(0)" ::: "memory"); }
              __syncthreads();
              HgConst hc; hc.lb[0] = hc.lb[1] = 0.f;
              if (l == 1) { const int h0 = blockIdx.x & 3, d0 = 2 * F.lane; hc.lb[0] = sigmf(F.in[1][512 + 128 * h0 + d0] - F.in[1][128 * h0 + d0]); hc.lb[1] = sigmf(F.in[1][512 + 128 * h0 + d0 + 1] - F.in[1][128 * h0 + d0 + 1]); }
              for (; u < NUNIT; u += F.G) prep_hg_unit(F, l, u, u + F.G < NUNIT ? u + F.G : -1, hc); }
            { DnConst dc; { const int h0 = blockIdx.x & 3, d0 = 2 * F.lane; dc.na = -__expf(F.in[6][l * NHEAD + h0]); dc.dtb = F.in[7][l * NHEAD + h0];
                  const float* cw = F.in[5] + (size_t)l * CONVW * CONVC + 128 * h0 + d0;
#pragma unroll
                  for (int j = 0; j < 4; ++j) { dc.cwq[j][0] = cw[j * CONVC]; dc.cwq[j][1] = cw[j * CONVC + 1]; dc.cwk[j][0] = cw[j * CONVC + 512]; dc.cwk[j][1] = cw[j * CONVC + 513]; dc.cwv[j][0] = cw[j * CONVC + 1024]; dc.cwv[j][1] = cw[j * CONVC + 1025]; } }
              DnRaw ra, rb; int u = blockIdx.x; if (u < NUNIT) dn_raw_load(ra, F, u, F.tid, F.lane);
              for (; u < NUNIT; u += 2 * F.G) {
                  if (u + F.G < NUNIT) dn_raw_load(rb, F, u + F.G, F.tid, F.lane);
                  prep_dn_unit(F, l, u, ra, dc);
                  if (u + F.G < NUNIT) { if (u + 2 * F.G < NUNIT) dn_raw_load(ra, F, u + 2 * F.G, F.tid, F.lane); prep_dn_unit(F, l, u + F.G, rb, dc); } } }
        }
        SEAM(pb + 1);
        if (IN(pb + 1) && IN(pb + 2)) {
            const bf16* R = (const bf16*)(F.ws + WS_R); int lane = F.lane; asm volatile("" : "+v"(lane));
            for (int m = R8_ROWS + blockIdx.x * NWAVES + F.wave; m < MTOK; m += F.G * NWAVES) {
                const GAS v4u* rr = (const GAS v4u*)(R + (size_t)m * DM) + lane; const v4u a = rr[0], c = rr[64];
                GAS v2u* q8 = (GAS v2u*)(F.ws + WS_R8C + (size_t)(m - R8_ROWS) * DM) + lane;
                q8[0] = (v2u){pk8(bflo(a.x), bfhi(a.x), bflo(a.y), bfhi(a.y)), pk8(bflo(a.z), bfhi(a.z), bflo(a.w), bfhi(a.w))};
                q8[64] = (v2u){pk8(bflo(c.x), bfhi(c.x), bflo(c.y), bfhi(c.y)), pk8(bflo(c.z), bfhi(c.z), bflo(c.w), bfhi(c.w))}; }
            xcd_barrier(bar);
        }
        REP(2) if (IN(pb + 2)) {
            const int bid = blockIdx.x; const bool grpA = (bid & 8) == 0; const int j = (bid & 7) | ((bid >> 4) << 3);
            if (F.G == 256) {
                if (grpA) { const int grp = (bid >> 5) * 8 + (bid & 7), sl0 = ((bid >> 4) & 1) * 2;
#ifdef USE_SCAN2R
                    if (grp < 32) scan2r_hg(F, grp, sl0); else scan2r_dn(F, grp - 32, sl0); }
#else
#ifdef PROBE_CHAIN
                    const long long w0_ = wall_clock64();
#endif
                    if (grp < 32) scan_hg_chain(F, grp, sl0); else scan_dn_chain(F, grp - 32, sl0);
#ifdef PROBE_CHAIN
                    if (bid == PROBE_CHAIN && F.tid == 0) { const long long dw = wall_clock64() - w0_; const long long t_ = wall_clock64(); while (wall_clock64() - t_ < dw) __builtin_amdgcn_s_sleep(8); }
                    __syncthreads();
#endif
                    }
#endif

                constexpr int NT = MTOK / 256, B_TILES = NT - 8 * (GA_HG + GA_DN), B_ROUNDS = B_TILES / 16; static_assert(B_TILES >= 0 && B_TILES % 16 == 0, "group B takes whole rounds");
                pg8::Gemm g8{(const pg8::bf16_t*)((unsigned char*)F.out + R8_OUT_OFF), (const pg8::bf16_t*)(F.ws + WS_W8 + (size_t)l * W8_LAYER), MTOK, N_INB, DM / 2,
                             (const pg8::bf16_t*)(F.ws + WS_R8B - (size_t)R8A_ROWS * DM), R8A_TILES, (const pg8::bf16_t*)(F.ws + WS_R8C - (size_t)R8_ROWS * DM), R8_TILES};
                const bool hgw = j < 64;
                pg8::GateOrder S8{grpA ? (hgw ? B_TILES : B_TILES + 8 * GA_HG) : 0, 0, grpA ? (hgw ? GA_HG : GA_DN) : B_ROUNDS, j & 7, grpA ? ((j >> 3) & 7) : (j >> 3), grpA ? 1 : 0};
                pg8::EpiGate E8{F.ws + WS_GATES, (size_t)MTOK * DM, 1.f / W8_SCALE};
                pg8::gemm_phase<pg8::EpiGate, pg8::GateOrder, PG8_ALIGN, PG8_SP2, true>(F.lds, g8, S8, E8);
            }
        }
        SEAM(pb + 2);
        REP(5) if (IN(pb + 5)) {
            pg8::Gemm g{(const pg8::bf16_t*)(F.ws + WS_ORAW), wl + W_O2, 2 * MTOK, 2048, 512};
            pg8::PairOrder S; S.so.init(MTOK, DM, F.G, (int)blockIdx.x);
            pg8::EpiMerge E{(pg8::bf16_t*)((unsigned char*)F.out + 128 * MiB)  , (const unsigned char*)(F.ws + WS_GATES), (size_t)MTOK * DM, (const pg8::bf16_t*)(F.ws + WS_SUMS), nullptr, 0};
            pg8::gemm_phase<pg8::EpiMerge, pg8::PairOrder, G2_ALIGN, PG8_SP2>(F.lds, g, S, E);
        }
        SEAM(pb + 5);
        REP(6) if (IN(pb + 6)) {
            pg8::Gemm g{(const pg8::bf16_t*)((unsigned char*)F.out + 128 * MiB), wl + W_OUT, MTOK, DM, DM}; pg8::StaticOrder S; S.init(MTOK, DM, F.G, (int)blockIdx.x);
            pg8::EpiBf16<0> E{(pg8::bf16_t*)(F.ws + WS_MIX), DM, nullptr, 0, 0, 1.f};
            pg8::gemm_phase<pg8::EpiBf16<0>, pg8::StaticOrder, PG8_ALIGN, PG8_SP2>(F.lds, g, S, E);
        }
        SEAM(pb + 6);
        REP(7) if (IN(pb + 7)) {
#ifdef PROBE_CLK_EW
            const long long c0_ = clock64(), w0_ = wall_clock64();
#endif
            const int gw = blockIdx.x * NWAVES + F.wave, NGW = F.G * NWAVES;
            rowpass<false, false>(F, (const bf16*)(F.ws + WS_MIX), nullptr, F.in[12] + l * DM, nullptr, 0, gw, NGW, MTOK);
#ifdef PROBE_CLK_EW
            if (blockIdx.x == 0 && F.tid == 0) { const long long dc = clock64() - c0_, dw = wall_clock64() - w0_;
                const long long spin = (dc * 50 / dw - 500) * 100; const long long t_ = wall_clock64(); while (wall_clock64() - t_ < spin) __builtin_amdgcn_s_sleep(8); }
#endif
        }
        SEAM(pb + 7);
        REP(8) if (IN(pb + 8)) {
            pg8::Gemm g{Rb, wl + W_GU, MTOK, 2 * DFF, DM}; pg8::StaticOrder S; S.init(MTOK, 2 * DFF, F.G, (int)blockIdx.x);
            pg8::EpiSwiGLU E{(pg8::bf16_t*)(F.ws + WS_ACT)};
            pg8::gemm_phase<pg8::EpiSwiGLU, pg8::StaticOrder, PG8_ALIGN, PG8_SP2>(F.lds, g, S, E);
        }
        SEAM(pb + 8);
        REP(9) if (IN(pb + 9)) {
#ifdef PROBE_CLK
            const long long c0_ = clock64(), w0_ = wall_clock64();
#endif
            pg8::Gemm g{(const pg8::bf16_t*)(F.ws + WS_ACT), wl + W_DN, MTOK, DM, DFF}; pg8::StaticOrder S; S.init(MTOK, DM, F.G, (int)blockIdx.x);
            pg8::EpiBf16<0> E{(pg8::bf16_t*)(F.ws + WS_F), DM, nullptr, 0, 0, 1.f};
            pg8::gemm_phase<pg8::EpiBf16<0>, pg8::StaticOrder, PG8_ALIGN, PG8_SP2>(F.lds, g, S, E);
#ifdef PROBE_CLK
            if (blockIdx.x == 0 && F.tid == 0) { const long long dc = clock64() - c0_, dw = wall_clock64() - w0_;
                const long long spin = (dc * 50 / dw - 500) * 100; const long long t_ = wall_clock64(); while (wall_clock64() - t_ < spin) __builtin_amdgcn_s_sleep(8); }
#endif
        }
        SEAM(pb + 9);
        REP(10) if (IN(pb + 10)) {
            const int gw = blockIdx.x * NWAVES + F.wave, NGW = F.G * NWAVES;
            if (l == DEPTH - 1) rowpass<false, true>(F, (const bf16*)(F.ws + WS_F), nullptr, F.in[16] + l * DM, F.out, 1, gw, NGW, MTOK);
            else { wab_stage(F, l + 1); rowpass<false, false, true>(F, (const bf16*)(F.ws + WS_F), nullptr, F.in[16] + l * DM, nullptr, 1, gw, NGW, MTOK); }
        }
        if (l + 1 < DEPTH) SEAM(pb + 10);
    }
#undef IN
#undef SEAM
struct Args { const float* in[17]; float* out; unsigned char* ws; int ph_lo, ph_hi; };
static_assert(sizeof(Args) == 17 * 8 + 8 + 8 + 8, "Args has no padding");
__global__ void __launch_bounds__(NWAVES * 64, 2) hybrid_fwd(Args args) {
    extern __shared__ __attribute__((aligned(16))) unsigned char lds[];
    Frame F;
    F.lds = (LAS unsigned char*)lds;
    F.MISC = (volatile LAS unsigned*)(F.lds + MISC_OFF);
    F.tid = threadIdx.x; F.lane = F.tid & 63; F.wave = __builtin_amdgcn_readfirstlane(F.tid >> 6);
    F.G = gridDim.x;
    F.ws = args.ws; F.out = args.out; F.ctl = (gu32*)(args.ws + WS_CTL);
#pragma unroll
    for (int i = 0; i < 17; ++i) F.in[i] = args.in[i];
    for (int u = F.tid; u < (LDS_BYTES - MISC_OFF) / 4; u += NWAVES * 64) ((LAS unsigned*)(F.lds + MISC_OFF))[u] = 0u;
    __syncthreads();
    const int lo = args.ph_lo, hi = args.ph_hi;
    XcdBarrier bar; bar.bar = (unsigned*)(F.ctl + CW_BAR); bar.x = 0; bar.st = nullptr;
    if (hi - lo > 1) bar = xcd_barrier_post((unsigned*)(F.ctl + CW_BAR), F.MISC + 8);
#define IN(k) (lo <= (k) && (k) < hi)
#ifndef DOUBLE_BAR
#define DOUBLE_BAR 0
#endif
#define SEAM(k) do { if (IN(k) && IN((k) + 1)) { xcd_barrier(bar); if (DOUBLE_BAR) xcd_barrier(bar); } } while (0)

#ifndef NO_P0
    if (IN(0)) { wab_stage(F, 0);
        if (F.wave & 1) { p0_weights(F); p0_rows(F); } else { p0_rows(F); p0_weights(F); } }
#endif
#ifdef PROBE_XCC
    if (IN(0)) {
        if (F.tid == 0) __hip_atomic_store(F.ctl + 8192 + blockIdx.x, 1u + ((unsigned)__builtin_amdgcn_s_getreg((3 << 11) | 20) & 0xFu), RLX_AGENT);
    }
#endif
#ifdef PROBE_MFMA
    if (IN(0)) {
        typedef short bfx8 __attribute__((ext_vector_type(8)));
        bfx8 a, b; for (int e = 0; e < 8; ++e) { a[e] = (short)(0x3c00 + F.lane + e); b[e] = (short)(0x3b80 + 2 * F.lane + e); }
        asm volatile("" : "+v"(a), "+v"(b));
#if PROBE_MFMA == 16
        f32x4 c[8]; for (int i = 0; i < 8; ++i) c[i] = (f32x4){0.f, 0.f, 0.f, 0.f};
        for (int it = 0; it < 2500; ++it) {
#pragma unroll
            for (int i = 0; i < 8; ++i) c[i] = __builtin_amdgcn_mfma_f32_16x16x32_bf16(a, b, c[i], 0, 0, 0);
        }
        float sum = 0.f; for (int i = 0; i < 8; ++i) sum += c[i][0] + c[i][1] + c[i][2] + c[i][3];
#else
        typedef float f32x16_ __attribute__((ext_vector_type(16)));
        f32x16_ c[4]; for (int i = 0; i < 4; ++i) for (int e = 0; e < 16; ++e) c[i][e] = 0.f;
        for (int it = 0; it < 2500; ++it) {
#pragma unroll
            for (int i = 0; i < 4; ++i) c[i] = __builtin_amdgcn_mfma_f32_32x32x16_bf16(a, b, c[i], 0, 0, 0);
        }
        float sum = 0.f; for (int i = 0; i < 4; ++i) for (int e = 0; e < 16; ++e) sum += c[i][e];
#endif
        if (sum == 12345.678f) __hip_atomic_store(F.ctl + 100, 1u, RLX_AGENT);
    }
#endif
    SEAM(0);
#ifdef PROBE_XCC
    if (blockIdx.x == 0 && F.tid == 0) { int bad = 0;
        for (int i = 0; i < (int)gridDim.x; ++i) bad += __hip_atomic_load(F.ctl + 8192 + i, RLX_AGENT) != __hip_atomic_load(F.ctl + 8192 + (i & 7), RLX_AGENT);
        const long long t_ = wall_clock64(); while (wall_clock64() - t_ < 200ll * bad) __builtin_amdgcn_s_sleep(8); }
#endif

    layer_phases<0>(F, bar, lo, hi);
    layer_phases<1>(F, bar, lo, hi);
#undef IN
#undef SEAM
}

extern "C" void kernel_launch(void* const* d_in, const int* in_sizes, int n_in, void* d_out, int out_size, void* d_ws, size_t ws_size, hipStream_t stream) {
    static int grid = 0;
    if (grid == 0) {
        if (n_in != 17 || in_sizes[0] != MTOK * DM || out_size != MTOK * DM || ws_size < WS_END) {
            fprintf(stderr, "kernel_launch: unexpected shapes: n_in %d in0 %d out %d ws %zu (need %zu)\n", n_in, n_in > 0 ? in_sizes[0] : -1, out_size, ws_size, (size_t)WS_END); grid = -1; return; }
        int dev = 0, cus = 0, per_cu = 0;
        if (hipGetDevice(&dev) != hipSuccess || hipDeviceGetAttribute(&cus, hipDeviceAttributeMultiprocessorCount, dev) != hipSuccess) { grid = -1; return; }
        if (hipFuncSetAttribute((const void*)hybrid_fwd, hipFuncAttributeMaxDynamicSharedMemorySize, LDS_BYTES) != hipSuccess) { fprintf(stderr, "kernel_launch: hipFuncSetAttribute failed\n"); grid = -1; return; }
        if (hipOccupancyMaxActiveBlocksPerMultiprocessor(&per_cu, (const void*)hybrid_fwd, NWAVES * 64, LDS_BYTES) != hipSuccess || per_cu < 1)
            fprintf(stderr, "kernel_launch: note: occupancy query reports %d workgroups per CU\n", per_cu);
        (void)hipGetLastError();
        grid = cus;
    }
    if (grid < 0) return;
    if (hipMemsetAsync((char*)d_ws + WS_CTL, 0, CTL_ZERO_BYTES, stream) != hipSuccess) return;
    Args a{};
    for (int i = 0; i < 17; ++i) a.in[i] = (const float*)d_in[i];
    a.out = (float*)d_out; a.ws = (unsigned char*)d_ws;
#if MK_ONE_LAUNCH
    a.ph_lo = 0; a.ph_hi = N_PHASES;
    hipLaunchKernelGGL(hybrid_fwd, dim3(grid), dim3(NWAVES * 64), LDS_BYTES, stream, a);
#else
    for (int p = 0; p < N_PHASES; ++p) {
        a.ph_lo = p; a.ph_hi = p + 1;
        hipLaunchKernelGGL(hybrid_fwd, dim3(grid), dim3(NWAVES * 64), LDS_BYTES, stream, a);
    }
#endif
}
```
